# Optimizing an MI355X kernel written in HIP

```python
import math
import jax
import jax.numpy as jnp
from jax import lax
import numpy as np

D_MODEL = 1024
BATCH = 4
SEQ = 8192
DEPTH = 2

PLE_DIM = 256
NORM_EPS = 1e-6
N_EVEN = (DEPTH + 1) // 2
N_ODD = DEPTH // 2
CHUNK = 64
MIX_WIDTH = D_MODEL
GLA_HEADS = 4
GLA_DV = MIX_WIDTH // (2 * GLA_HEADS)
GLA_DK = GLA_DV // 2
GLA_GATE_RANK = 16
GLA_GATE_NORM = 16.0
RET_HEADS = 4
RET_DV = MIX_WIDTH // (2 * RET_HEADS)
RET_DK = RET_DV // 2
ROPE_BASE = 10000.0
EVEN_SPLIT_SIZES = (GLA_HEADS * GLA_DK, GLA_HEADS * GLA_DK, GLA_HEADS * GLA_DV, GLA_HEADS * GLA_DV, GLA_GATE_RANK, RET_HEADS * RET_DK, RET_HEADS * RET_DK, RET_HEADS * RET_DV, RET_HEADS * RET_DV)
EVEN_PROJ = sum(EVEN_SPLIT_SIZES)
POOL_WINDOWS = (2, 4, 8, 16)
POOL_GROUPS = 4
POOL_WIDTH = MIX_WIDTH // 2
POOL_GROUP_WIDTH = POOL_WIDTH // POOL_GROUPS
S5_H = 16
S5_P = 64
S5_WIDTH = MIX_WIDTH - POOL_WIDTH
S5_GROUPS = S5_WIDTH // S5_H
DT_MIN = 1e-3
DT_MAX = 1e-1
PEER_HEADS = 8
PEER_NKEYS = 128
PEER_EXPERTS = PEER_NKEYS * PEER_NKEYS
PEER_TOPK = 16
PEER_DKEY = 256
PEER_BLOCK = 128

kernel_name = 'hybrid_gla_retnet_pool_s5_peer'


def rms_norm(x, w):
    xf = x.astype(jnp.float32)
    y = xf * lax.rsqrt(jnp.mean(xf * xf, axis=-1, keepdims=True) + NORM_EPS)
    return (y * w.astype(jnp.float32)).astype(x.dtype)


def group_norm(x):
    xf = x.astype(jnp.float32)
    mu = jnp.mean(xf, axis=-1, keepdims=True)
    var = jnp.mean(jnp.square(xf - mu), axis=-1, keepdims=True)
    return (xf - mu) * lax.rsqrt(var + NORM_EPS)


def to_heads(t, n_heads):
    b, s, _ = t.shape
    return t.reshape(b, s, n_heads, -1).transpose(0, 2, 1, 3)


def from_heads(t):
    b, h, s, d = t.shape
    return t.transpose(0, 2, 1, 3).reshape(b, s, h * d)


def rotary(x, positions):
    half = x.shape[-1] // 2
    freqs = ROPE_BASE ** (-jnp.arange(half, dtype=jnp.float32) / half)
    ang = positions.astype(jnp.float32)[:, None] * freqs[None, :]
    cos, sin = jnp.cos(ang), jnp.sin(ang)
    xf = x.astype(jnp.float32)
    x1, x2 = xf[..., :half], xf[..., half:]
    return jnp.concatenate([x1 * cos - x2 * sin, x2 * cos + x1 * sin], axis=-1).astype(x.dtype)


def to_chunks(t):
    b, h, s, d = t.shape
    return t.astype(jnp.float32).reshape(b, h, s // CHUNK, CHUNK, d)


def scan_chunk_states(kv, decay):
    decay = jnp.broadcast_to(decay, kv.shape)

    def step(state, inp):
        kv_n, d_n = inp
        return d_n * state + kv_n, state

    init = jnp.zeros(kv.shape[:2] + kv.shape[3:], kv.dtype)
    _, prev = lax.scan(step, init, (jnp.moveaxis(kv, 2, 0), jnp.moveaxis(decay, 2, 0)))
    return jnp.moveaxis(prev, 0, 2)


def gla_chunked(q, k, v, log_a):
    b, h, s, _ = q.shape
    q, k, v, log_a = to_chunks(q), to_chunks(k), to_chunks(v), to_chunks(log_a)
    g = jnp.cumsum(log_a, axis=3)
    g_last = g[:, :, :, -1:, :]
    ref = 0.5 * g_last
    causal = jnp.tril(jnp.ones((CHUNK, CHUNK), dtype=bool))
    scores = jnp.einsum('bhnid,bhnjd->bhnij', q * jnp.exp(g - ref), k * jnp.exp(ref - g))
    scores = jnp.where(causal, scores, 0.0)
    o_intra = jnp.einsum('bhnij,bhnje->bhnie', scores, v)
    kv = jnp.einsum('bhncd,bhnce->bhnde', k * jnp.exp(g_last - g), v)
    prev = scan_chunk_states(kv, jnp.exp(g_last[:, :, :, 0, :])[..., None])
    o_inter = jnp.einsum('bhncd,bhnde->bhnce', q * jnp.exp(g), prev)
    return (o_intra + o_inter).reshape(b, h, s, -1)


def retention_chunked(q, k, v, log_gamma):
    b, h, s, _ = q.shape
    q, k, v = to_chunks(q), to_chunks(k), to_chunks(v)
    idx = jnp.arange(CHUNK, dtype=jnp.float32)
    diff = idx[:, None] - idx[None, :]
    lg = log_gamma[:, None, None]
    decay_mask = jnp.where(diff >= 0, jnp.exp(lg * jnp.maximum(diff, 0.0)), 0.0)
    scores = jnp.einsum('bhnid,bhnjd->bhnij', q, k) * decay_mask[None, :, None]
    o_intra = jnp.einsum('bhnij,bhnje->bhnie', scores, v)
    q_dec = jnp.exp(log_gamma[:, None] * (idx + 1.0))
    k_dec = jnp.exp(log_gamma[:, None] * (CHUNK - 1.0 - idx))
    kv = jnp.einsum('bhncd,bhnce->bhnde', k * k_dec[None, :, None, :, None], v)
    prev = scan_chunk_states(kv, jnp.exp(log_gamma * CHUNK)[None, :, None, None, None])
    o_inter = jnp.einsum('bhncd,bhnde->bhnce', q, prev) * q_dec[None, :, None, :, None]
    return (o_intra + o_inter).reshape(b, h, s, -1)


def even_mixer(xn, positions, log_gamma, w_in, gla_w_up, gla_b_up, gla_norm_w, ret_norm_w, w_out):
    split_at = np.cumsum(EVEN_SPLIT_SIZES)[:-1].tolist()
    qa, ka, va, ga, ra, qb, kb, vb, gb = jnp.split(xn @ w_in, split_at, axis=-1)
    log_a = jax.nn.log_sigmoid((ra @ gla_w_up + gla_b_up).astype(jnp.float32)) / GLA_GATE_NORM
    o_a = gla_chunked(to_heads(qa, GLA_HEADS) * GLA_DK ** -0.5, to_heads(ka, GLA_HEADS),
                      to_heads(va, GLA_HEADS), to_heads(log_a, GLA_HEADS))
    o_a = from_heads(rms_norm(o_a, gla_norm_w)).astype(xn.dtype) * jax.nn.silu(ga)
    qb = rotary(to_heads(qb, RET_HEADS), positions)
    kb = rotary(to_heads(kb, RET_HEADS), positions) * RET_DK ** -0.5
    o_b = retention_chunked(qb, kb, to_heads(vb, RET_HEADS), log_gamma)
    o_b = (from_heads(group_norm(o_b)) * ret_norm_w).astype(xn.dtype) * jax.nn.silu(gb)
    return jnp.concatenate([o_a, o_b], axis=-1) @ w_out


def pool_mixer(u, pool_w, pool_scale):
    b, s, _ = u.shape
    ug = u.reshape(b, s, POOL_GROUPS, POOL_GROUP_WIDTH).astype(jnp.float32)
    cs = jnp.cumsum(ug, axis=1)
    t = jnp.arange(s)
    outs = []
    for g, win in enumerate(POOL_WINDOWS):
        c_g = cs[:, :, g]
        lagged = jnp.pad(c_g, ((0, 0), (win, 0), (0, 0)))[:, :s]
        count = jnp.minimum(t + 1, win).astype(jnp.float32)[None, :, None]
        outs.append((c_g - lagged) / count - ug[:, :, g])
    pooled = jnp.stack(outs, axis=2).astype(u.dtype)
    mixed = jnp.einsum('bsgc,gcd->bsgd', pooled, pool_w)
    return mixed.reshape(b, s, POOL_WIDTH) * pool_scale


def s5_mixer(u, a_re, a_im, log_dt, b_re, b_im, c_re, c_im, d_skip, w_glu, b_glu):
    b, s, _ = u.shape
    ug = u.reshape(b, s, S5_GROUPS, S5_H).astype(jnp.float32)
    dt = jnp.exp(log_dt.astype(jnp.float32))[:, None]
    a_re = a_re.astype(jnp.float32)
    a_im = a_im.astype(jnp.float32)
    mag = jnp.exp(a_re * dt)
    abar_re, abar_im = mag * jnp.cos(a_im * dt), mag * jnp.sin(a_im * dt)
    den = a_re * a_re + a_im * a_im
    nr, ni = abar_re - 1.0, abar_im
    coef_re = (nr * a_re + ni * a_im) / den
    coef_im = (ni * a_re - nr * a_im) / den
    bbar_re = coef_re[..., None] * b_re - coef_im[..., None] * b_im
    bbar_im = coef_re[..., None] * b_im + coef_im[..., None] * b_re
    bu_re = jnp.einsum('bsgh,gph->bsgp', ug, bbar_re)
    bu_im = jnp.einsum('bsgh,gph->bsgp', ug, bbar_im)
    lam_re = jnp.broadcast_to(abar_re, (1, s) + abar_re.shape)
    lam_im = jnp.broadcast_to(abar_im, (1, s) + abar_im.shape)

    def combine(e1, e2):
        a1r, a1i, b1r, b1i = e1
        a2r, a2i, b2r, b2i = e2
        return (a2r * a1r - a2i * a1i, a2r * a1i + a2i * a1r,
                a2r * b1r - a2i * b1i + b2r, a2r * b1i + a2i * b1r + b2i)

    _, _, x_re, x_im = lax.associative_scan(combine, (lam_re, lam_im, bu_re, bu_im), axis=1)
    y = (jnp.einsum('bsgp,ghp->bsgh', x_re, c_re) - jnp.einsum('bsgp,ghp->bsgh', x_im, c_im)
         + d_skip * ug)
    z = jax.nn.gelu(y.reshape(b, s, S5_WIDTH).astype(u.dtype), approximate=False)
    return z * jax.nn.sigmoid(z @ w_glu + b_glu)


def odd_mixer(xn, w_in, pool_w, pool_scale, a_re, a_im, log_dt, b_re, b_im, c_re, c_im, d_skip, w_glu, b_glu, w_out):
    u_c, u_d = jnp.split(xn @ w_in, [POOL_WIDTH], axis=-1)
    y_c = pool_mixer(u_c, pool_w, pool_scale)
    y_d = s5_mixer(u_d, a_re, a_im, log_dt, b_re, b_im, c_re, c_im, d_skip, w_glu, b_glu)
    return jnp.concatenate([y_c, y_d], axis=-1) @ w_out


def peer(xn, w_q, sub_keys, u_tab, v_tab):
    b, s, d = xn.shape
    t = b * s
    xf = xn.reshape(t, d)
    q = (xf @ w_q).reshape(t, PEER_HEADS, 2, PEER_DKEY // 2)
    scores = jnp.einsum('thpc,hpkc->thpk', q, sub_keys).astype(jnp.float32)
    s_top, i_top = lax.top_k(scores, PEER_TOPK)
    cand = (s_top[:, :, 0, :, None] + s_top[:, :, 1, None, :]).reshape(t, PEER_HEADS, PEER_TOPK * PEER_TOPK)
    s_best, flat = lax.top_k(cand, PEER_TOPK)
    e_a = jnp.take_along_axis(i_top[:, :, 0], flat // PEER_TOPK, axis=-1)
    e_b = jnp.take_along_axis(i_top[:, :, 1], flat % PEER_TOPK, axis=-1)
    n_blk = t // PEER_BLOCK
    experts = (e_a * PEER_NKEYS + e_b).reshape(n_blk, PEER_BLOCK, PEER_HEADS * PEER_TOPK)
    gates = jax.nn.softmax(s_best, axis=-1).astype(xn.dtype).reshape(n_blk, PEER_BLOCK, PEER_HEADS * PEER_TOPK)

    def expert_block(args):
        x_blk, e_blk, g_blk = args
        u_sel = jnp.take(u_tab, e_blk, axis=0)
        hid = jax.nn.gelu(jnp.einsum('tkd,td->tk', u_sel, x_blk), approximate=False)
        return jnp.einsum('tk,tkd->td', g_blk * hid, jnp.take(v_tab, e_blk, axis=0))

    out = lax.map(expert_block, (xf.reshape(n_blk, PEER_BLOCK, d), experts, gates))
    return out.reshape(b, s, d)


def setup_inputs(seed: int = 0) -> dict:
    key = jax.random.key(seed)
    ks = iter(jax.random.split(key, 48))
    f32 = jnp.float32

    def nrm(shape, scale):
        return jax.random.normal(next(ks), shape, f32) * scale

    def gain(shape):
        return 1.0 + nrm(shape, 0.02)

    x = nrm((BATCH, SEQ, D_MODEL), 1.0)
    p = nrm((DEPTH, BATCH, SEQ, PLE_DIM), 1.0)
    positions = jnp.arange(SEQ, dtype=jnp.int32)
    norm_mix_w = gain((DEPTH, D_MODEL))
    norm_ffn_w = gain((DEPTH, D_MODEL))
    norm_ple_w = gain((DEPTH, D_MODEL))
    final_norm_w = gain((D_MODEL,))
    ev_w_in = nrm((N_EVEN, D_MODEL, EVEN_PROJ), D_MODEL ** -0.5)
    ev_gla_w_up = nrm((N_EVEN, GLA_GATE_RANK, GLA_HEADS * GLA_DK), GLA_GATE_RANK ** -0.5)
    ev_gla_b_up = nrm((N_EVEN, GLA_HEADS * GLA_DK), 0.1)
    ev_gla_norm_w = gain((N_EVEN, GLA_DV))
    ev_ret_norm_w = gain((N_EVEN, RET_HEADS * RET_DV))
    ev_w_out = nrm((N_EVEN, MIX_WIDTH, D_MODEL), MIX_WIDTH ** -0.5)
    od_w_in = nrm((N_ODD, D_MODEL, MIX_WIDTH), D_MODEL ** -0.5)
    od_pool_w = nrm((N_ODD, POOL_GROUPS, POOL_GROUP_WIDTH, POOL_GROUP_WIDTH), POOL_GROUP_WIDTH ** -0.5)
    od_pool_scale = 1.0 + nrm((N_ODD, POOL_WIDTH), 0.1)
    od_s5_a_re = -0.5 + nrm((N_ODD, S5_GROUPS, S5_P), 0.01)
    od_s5_a_im = math.pi * jnp.arange(S5_P, dtype=f32) + nrm((N_ODD, S5_GROUPS, S5_P), 0.01)
    od_s5_log_dt = jax.random.uniform(next(ks), (N_ODD, S5_GROUPS), f32, math.log(DT_MIN), math.log(DT_MAX))
    od_s5_b_re = nrm((N_ODD, S5_GROUPS, S5_P, S5_H), (2.0 * S5_H) ** -0.5)
    od_s5_b_im = nrm((N_ODD, S5_GROUPS, S5_P, S5_H), (2.0 * S5_H) ** -0.5)
    od_s5_c_re = nrm((N_ODD, S5_GROUPS, S5_H, S5_P), (2.0 * S5_P) ** -0.5)
    od_s5_c_im = nrm((N_ODD, S5_GROUPS, S5_H, S5_P), (2.0 * S5_P) ** -0.5)
    od_s5_d = nrm((N_ODD, S5_GROUPS, S5_H), 1.0)
    od_s5_w_glu = nrm((N_ODD, S5_WIDTH, S5_WIDTH), S5_WIDTH ** -0.5)
    od_s5_b_glu = nrm((N_ODD, S5_WIDTH), 0.02)
    od_w_out = nrm((N_ODD, MIX_WIDTH, D_MODEL), MIX_WIDTH ** -0.5)
    peer_w_q = nrm((DEPTH, D_MODEL, PEER_HEADS * PEER_DKEY), D_MODEL ** -0.5)
    peer_sub_keys = nrm((DEPTH, PEER_HEADS, 2, PEER_NKEYS, PEER_DKEY // 2), (PEER_DKEY // 2) ** -0.5)
    peer_u = nrm((DEPTH, PEER_EXPERTS, D_MODEL), D_MODEL ** -0.5)
    peer_v = nrm((DEPTH, PEER_EXPERTS, D_MODEL), PEER_HEADS ** -0.5)
    ple_w_proj = nrm((DEPTH, PLE_DIM, D_MODEL), PLE_DIM ** -0.5)
    ple_w_gate = nrm((DEPTH, D_MODEL, D_MODEL), D_MODEL ** -0.5)
    return {'x': x, 'p': p, 'positions': positions,
            'norm_mix_w': norm_mix_w, 'norm_ffn_w': norm_ffn_w, 'norm_ple_w': norm_ple_w,
            'final_norm_w': final_norm_w,
            'ev_w_in': ev_w_in, 'ev_gla_w_up': ev_gla_w_up, 'ev_gla_b_up': ev_gla_b_up,
            'ev_gla_norm_w': ev_gla_norm_w, 'ev_ret_norm_w': ev_ret_norm_w, 'ev_w_out': ev_w_out,
            'od_w_in': od_w_in, 'od_pool_w': od_pool_w, 'od_pool_scale': od_pool_scale,
            'od_s5_a_re': od_s5_a_re, 'od_s5_a_im': od_s5_a_im, 'od_s5_log_dt': od_s5_log_dt,
            'od_s5_b_re': od_s5_b_re, 'od_s5_b_im': od_s5_b_im,
            'od_s5_c_re': od_s5_c_re, 'od_s5_c_im': od_s5_c_im, 'od_s5_d': od_s5_d,
            'od_s5_w_glu': od_s5_w_glu, 'od_s5_b_glu': od_s5_b_glu, 'od_w_out': od_w_out,
            'peer_w_q': peer_w_q, 'peer_sub_keys': peer_sub_keys, 'peer_u': peer_u, 'peer_v': peer_v,
            'ple_w_proj': ple_w_proj, 'ple_w_gate': ple_w_gate}


def reference(x, p, positions, norm_mix_w, norm_ffn_w, norm_ple_w, final_norm_w,
              ev_w_in, ev_gla_w_up, ev_gla_b_up, ev_gla_norm_w, ev_ret_norm_w, ev_w_out,
              od_w_in, od_pool_w, od_pool_scale, od_s5_a_re, od_s5_a_im, od_s5_log_dt,
              od_s5_b_re, od_s5_b_im, od_s5_c_re, od_s5_c_im, od_s5_d, od_s5_w_glu, od_s5_b_glu, od_w_out,
              peer_w_q, peer_sub_keys, peer_u, peer_v, ple_w_proj, ple_w_gate):
    log_gamma = jnp.log(1.0 - 2.0 ** (-5.0 - jnp.arange(RET_HEADS, dtype=jnp.float32)))
    h = x
    for i in range(DEPTH):
        j = i // 2
        xn = rms_norm(h, norm_mix_w[i])
        if i % 2 == 0:
            mix = even_mixer(xn, positions, log_gamma, ev_w_in[j], ev_gla_w_up[j], ev_gla_b_up[j],
                             ev_gla_norm_w[j], ev_ret_norm_w[j], ev_w_out[j])
        else:
            mix = odd_mixer(xn, od_w_in[j], od_pool_w[j], od_pool_scale[j], od_s5_a_re[j], od_s5_a_im[j],
                            od_s5_log_dt[j], od_s5_b_re[j], od_s5_b_im[j], od_s5_c_re[j], od_s5_c_im[j],
                            od_s5_d[j], od_s5_w_glu[j], od_s5_b_glu[j], od_w_out[j])
        h = h + mix
        h = h + peer(rms_norm(h, norm_ffn_w[i]), peer_w_q[i], peer_sub_keys[i], peer_u[i], peer_v[i])
        gate = jax.nn.sigmoid(rms_norm(h, norm_ple_w[i]) @ ple_w_gate[i])
        h = h + (p[i] @ ple_w_proj[i]) * gate
    return rms_norm(h, final_norm_w)
```

```cpp
#include <hip/hip_runtime.h>
#include <hip/hip_cooperative_groups.h>
#include <cstdio>
#include <cstdint>
namespace cg = cooperative_groups;
namespace pg8 {
#define PG8_LAS __attribute__((address_space(3)))
typedef unsigned short bf16_t;
typedef short bf16x8 __attribute__((ext_vector_type(8)));
typedef float f32x4 __attribute__((ext_vector_type(4)));
typedef unsigned u32x4 __attribute__((ext_vector_type(4)));
constexpr int BM = 256, BK = 64, HALF = 128, HTB = HALF * BK * 2  , STAGE_BYTES = 8 * HTB, NXCD = 8, WGM = 8;

__host__ __device__ __forceinline__ int lds_byte(int r, int c) { const int st = (r >> 4) * 2 + (c >> 5), rr = r & 15, cc = c & 31, ob = rr * 64 + cc * 2; return st * 1024 + (ob ^ (((ob >> 9) & 1) << 5)); }
__host__ __device__ __forceinline__ void stage_rc(int b, int& R, int& C) { const int st = b / 1024, sb = b % 1024, swz = sb ^ (((sb >> 9) & 1) << 5); R = (st >> 1) * 16 + swz / 64; C = (st & 1) * 32 + (swz % 64) / 2; }
__host__ __device__ __forceinline__ int perm32(int rho) { const int n = rho >> 4, i = rho & 15; return 8 * (i >> 2) + 4 * n + (i & 3); }

struct Unit { int pm, pn; };
struct Gemm { const bf16_t* A; const bf16_t* Bt; int M, N, K; };

struct StaticOrder {
    int nM, nN, nwg, G, c;
    __host__ __device__ void init(int M, int N, int G_, int c_) { nM = M / BM; nN = N / BM; nwg = nM * nN; G = G_; c = c_; }
    __host__ __device__ bool next(int i, Unit& u) const {
        const long L = (long)i * G + c; if (L >= nwg) return false;
        int wgid = (int)L; { const int q = nwg / NXCD, r = nwg % NXCD, xcd = wgid % NXCD, off = wgid / NXCD; wgid = (xcd < r ? xcd * (q + 1) : r * (q + 1) + (xcd - r) * q) + off; }
        const int nig = WGM * nN, gid = wgid / nig, fm = gid * WGM, gsz = (nM - fm) < WGM ? (nM - fm) : WGM;
        u.pm = fm + ((wgid % nig) % gsz); u.pn = (wgid % nig) / gsz; return true;
    }
    __device__ __forceinline__ void a_ready(const Unit&) const {}
    __device__ __forceinline__ void done(const Unit&) const {}
};

__device__ __forceinline__ unsigned cvt_pk_bf16(float lo, float hi) { unsigned r; asm volatile("v_cvt_pk_bf16_f32 %0, %1, %2" : "=v"(r) : "v"(lo), "v"(hi)); return r; }
typedef float f32x2 __attribute__((ext_vector_type(2)));
__device__ __forceinline__ f32x2 gelu_pk(f32x2 v) {
    const f32x2 av = __builtin_elementwise_abs(v), d = av * 0.2316418882f + 1.0f;
    f32x2 t; t.x = __builtin_amdgcn_rcpf(d.x); t.y = __builtin_amdgcn_rcpf(d.y);
    f32x2 q = t * 0.5307027145f + (-0.7265760135f); q = q * t + 0.7107068705f; q = q * t + (-0.142248368f); q = q * t + 0.127414796f; q = q * t;
    const f32x2 s = (v * v) * (-0.72134752044f);
    f32x2 e; e.x = __builtin_amdgcn_exp2f(s.x); e.y = __builtin_amdgcn_exp2f(s.y);
    const f32x2 m = v * (q * e), r = v - m;
    f32x2 o; o.x = v.x < 0.f ? m.x : r.x; o.y = v.y < 0.f ? m.y : r.y; return o;
}

template <int ACT  > struct EpiBf16 {
    static constexpr bool PERM = true, AFTER_DRAIN = false; static_assert(ACT == 0 || ACT == 1, "EpiBf16: ACT is 0 (none) or 1 (gelu_pk)");
    bf16_t* O; int ldc; const float* bias; int split_cols; size_t split_stride; float scale0;
    __device__ __forceinline__ void operator()(const f32x4 (&acc)[2][2][4][2], const Unit& u, int wr, int wc, int fr, int fq) const {
        const int row0 = u.pm * BM + wr * 64 + fr; int colt = u.pn * BM; bf16_t* base = O;
        float sc = 1.f; if (split_cols) { const int t = colt / split_cols; base += (size_t)t * split_stride; colt -= t * split_cols; if (t == 0) sc = scale0; }
        const int col0 = colt + wc * 32 + 8 * fq, bcol0 = u.pn * BM + wc * 32 + 8 * fq;
        f32x4 bv[2][2];
#pragma unroll
        for (int bj = 0; bj < 2; ++bj)
#pragma unroll
            for (int n = 0; n < 2; ++n) bv[bj][n] = bias ? *(const f32x4*)(bias + bcol0 + bj * HALF + 4 * n) : (f32x4){0.f, 0.f, 0.f, 0.f};
#pragma unroll
        for (int ai = 0; ai < 2; ++ai)
#pragma unroll
            for (int m = 0; m < 4; ++m) { bf16_t* rowp = base + (size_t)(row0 + ai * HALF + m * 16) * ldc + col0;
#pragma unroll
                for (int bj = 0; bj < 2; ++bj) { f32x4 v0 = acc[ai][bj][m][0] + bv[bj][0], v1 = acc[ai][bj][m][1] + bv[bj][1];
                    if (ACT == 1) { f32x2 a = gelu_pk((f32x2){v0[0], v0[1]}), b = gelu_pk((f32x2){v0[2], v0[3]}), c = gelu_pk((f32x2){v1[0], v1[1]}), d = gelu_pk((f32x2){v1[2], v1[3]});
                        v0 = (f32x4){a.x, a.y, b.x, b.y}; v1 = (f32x4){c.x, c.y, d.x, d.y}; }
                    v0 = v0 * sc; v1 = v1 * sc; u32x4 w; w.x = cvt_pk_bf16(v0[0], v0[1]); w.y = cvt_pk_bf16(v0[2], v0[3]); w.z = cvt_pk_bf16(v1[0], v1[1]); w.w = cvt_pk_bf16(v1[2], v1[3]);
                    *(u32x4*)(rowp + bj * HALF) = w; } }
    }
};

__device__ __forceinline__ float row_rstd(const float* ssq, int row) {
    const f32x4* p = (const f32x4*)(ssq + (size_t)row * 16);
    const f32x4 a = p[0], b = p[1], c = p[2], d = p[3];
    const float s = (((a[0] + a[1]) + (a[2] + a[3])) + ((b[0] + b[1]) + (b[2] + b[3]))) + (((c[0] + c[1]) + (c[2] + c[3])) + ((d[0] + d[1]) + (d[2] + d[3])));
    return 1.0f / sqrtf(s * (1.0f / 1024.0f) + 1e-6f);
}
__device__ __forceinline__ float sigmoidf_(float x) { return __builtin_amdgcn_rcpf(1.0f + __expf(-x)); }
typedef unsigned u32x2 __attribute__((ext_vector_type(2)));

struct EpiRes {
    static constexpr bool PERM = false, AFTER_DRAIN = false;
    const float* base; float* out; bf16_t* hb; float* ssq;
    __device__ __forceinline__ void operator()(const f32x4 (&acc)[2][2][4][2], const Unit& u, int wr, int wc, int fr, int fq) const {
        const int row0 = u.pm * BM + wr * 64 + fr, col0 = u.pn * BM + wc * 32 + 4 * fq;
#pragma unroll
        for (int ai = 0; ai < 2; ++ai)
#pragma unroll
            for (int m = 0; m < 4; ++m) { const int row = row0 + ai * HALF + m * 16; const size_t off = (size_t)row * 1024 + col0; float ss = 0.f;
#pragma unroll
                for (int bj = 0; bj < 2; ++bj)
#pragma unroll
                    for (int n = 0; n < 2; ++n) { const size_t o2 = off + bj * HALF + n * 16; const f32x4 o = *(const f32x4*)(base + o2) + acc[ai][bj][m][n];
                        *(f32x4*)(out + o2) = o; ss += (o[0] * o[0] + o[1] * o[1]) + (o[2] * o[2] + o[3] * o[3]);
                        u32x2 w; w.x = cvt_pk_bf16(o[0], o[1]); w.y = cvt_pk_bf16(o[2], o[3]); *(u32x2*)(hb + o2) = w; }
                ss += __shfl_xor(ss, 16); ss += __shfl_xor(ss, 32);
                if (fq == 0) ssq[(size_t)row * 16 + u.pn * 4 + wc] = ss; }
    }
};
struct EpiScaleF32 {
    static constexpr bool PERM = false, AFTER_DRAIN = false;
    float* C; int ldc; const float* ssq;
    __device__ __forceinline__ void operator()(const f32x4 (&acc)[2][2][4][2], const Unit& u, int wr, int wc, int fr, int fq) const {
        const int row0 = u.pm * BM + wr * 64 + fr, col0 = u.pn * BM + wc * 32 + 4 * fq;
#pragma unroll
        for (int ai = 0; ai < 2; ++ai)
#pragma unroll
            for (int m = 0; m < 4; ++m) { const int row = row0 + ai * HALF + m * 16; const float rs = row_rstd(ssq, row); float* rowp = C + (size_t)row * ldc + col0;
#pragma unroll
                for (int bj = 0; bj < 2; ++bj)
#pragma unroll
                    for (int n = 0; n < 2; ++n) *(f32x4*)(rowp + bj * HALF + n * 16) = acc[ai][bj][m][n] * rs; }
    }
};
struct EpiScaleBf16 {
    static constexpr bool PERM = false, AFTER_DRAIN = false;
    bf16_t* O; int ldc; const float* ssq;
    __device__ __forceinline__ void operator()(const f32x4 (&acc)[2][2][4][2], const Unit& u, int wr, int wc, int fr, int fq) const {
        const int row0 = u.pm * BM + wr * 64 + fr, col0 = u.pn * BM + wc * 32 + 4 * fq;
#pragma unroll
        for (int ai = 0; ai < 2; ++ai)
#pragma unroll
            for (int m = 0; m < 4; ++m) { const int row = row0 + ai * HALF + m * 16; const float rs = row_rstd(ssq, row); bf16_t* rowp = O + (size_t)row * ldc + col0;
#pragma unroll
                for (int bj = 0; bj < 2; ++bj)
#pragma unroll
                    for (int n = 0; n < 2; ++n) { const f32x4 o = acc[ai][bj][m][n] * rs; u32x2 w; w.x = cvt_pk_bf16(o[0], o[1]); w.y = cvt_pk_bf16(o[2], o[3]); *(u32x2*)(rowp + bj * HALF + n * 16) = w; } }
    }
};
struct EpiPle {
    static constexpr bool PERM = false, AFTER_DRAIN = false;
    float* h; const bf16_t* pp; bf16_t* hb; const float* ssq_in; float* ssq_out;
    __device__ __forceinline__ void operator()(const f32x4 (&acc)[2][2][4][2], const Unit& u, int wr, int wc, int fr, int fq) const {
        const int row0 = u.pm * BM + wr * 64 + fr, col0 = u.pn * BM + wc * 32 + 4 * fq;
#pragma unroll
        for (int ai = 0; ai < 2; ++ai)
#pragma unroll
            for (int m = 0; m < 4; ++m) { const int row = row0 + ai * HALF + m * 16; const float rs = row_rstd(ssq_in, row); const size_t off = (size_t)row * 1024 + col0; float ss = 0.f;
#pragma unroll
                for (int bj = 0; bj < 2; ++bj)
#pragma unroll
                    for (int n = 0; n < 2; ++n) { const size_t o2 = off + bj * HALF + n * 16; const f32x4 a = acc[ai][bj][m][n] * rs; const u32x2 pw = *(const u32x2*)(pp + o2);
                        f32x4 o = *(const f32x4*)(h + o2);
                        o[0] += __uint_as_float(pw.x << 16) * sigmoidf_(a[0]); o[1] += __uint_as_float(pw.x & 0xffff0000u) * sigmoidf_(a[1]);
                        o[2] += __uint_as_float(pw.y << 16) * sigmoidf_(a[2]); o[3] += __uint_as_float(pw.y & 0xffff0000u) * sigmoidf_(a[3]);
                        *(f32x4*)(h + o2) = o; ss += (o[0] * o[0] + o[1] * o[1]) + (o[2] * o[2] + o[3] * o[3]);
                        u32x2 w; w.x = cvt_pk_bf16(o[0], o[1]); w.y = cvt_pk_bf16(o[2], o[3]); *(u32x2*)(hb + o2) = w; }
                ss += __shfl_xor(ss, 16); ss += __shfl_xor(ss, 32);
                if (fq == 0) ssq_out[(size_t)row * 16 + u.pn * 4 + wc] = ss; }
    }
};
struct EpiGlu {
    static constexpr bool PERM = false, AFTER_DRAIN = false;
    const bf16_t* Z; int ldz; const float* bias; bf16_t* O; int ldo; int ocol0;
    __device__ __forceinline__ void operator()(const f32x4 (&acc)[2][2][4][2], const Unit& u, int wr, int wc, int fr, int fq) const {
        const int row0 = u.pm * BM + wr * 64 + fr, col0 = u.pn * BM + wc * 32 + 4 * fq;
        f32x4 bv[2][2];
#pragma unroll
        for (int bj = 0; bj < 2; ++bj)
#pragma unroll
            for (int n = 0; n < 2; ++n) bv[bj][n] = *(const f32x4*)(bias + col0 + bj * HALF + n * 16);
#pragma unroll
        for (int ai = 0; ai < 2; ++ai)
#pragma unroll
            for (int m = 0; m < 4; ++m) { const int row = row0 + ai * HALF + m * 16;
#pragma unroll
                for (int bj = 0; bj < 2; ++bj)
#pragma unroll
                    for (int n = 0; n < 2; ++n) { const int col = col0 + bj * HALF + n * 16; const f32x4 a = acc[ai][bj][m][n] + bv[bj][n]; const u32x2 zw = *(const u32x2*)(Z + (size_t)row * ldz + col);
                        const float o0 = __uint_as_float(zw.x << 16) * sigmoidf_(a[0]), o1 = __uint_as_float(zw.x & 0xffff0000u) * sigmoidf_(a[1]);
                        const float o2 = __uint_as_float(zw.y << 16) * sigmoidf_(a[2]), o3 = __uint_as_float(zw.y & 0xffff0000u) * sigmoidf_(a[3]);
                        u32x2 w; w.x = cvt_pk_bf16(o0, o1); w.y = cvt_pk_bf16(o2, o3); *(u32x2*)(O + (size_t)row * ldo + ocol0 + col) = w; } }
    }
};
template <class Epi, class Sched, bool ALIGN_EPI = false, bool SP2 = false>
__device__ __forceinline__ void gemm_phase(PG8_LAS unsigned char* lds, const Gemm g, const Sched& S, const Epi& E) {
    int tid_o = threadIdx.x; asm volatile("" : "+v"(tid_o));
    const int tid = tid_o, wid = __builtin_amdgcn_readfirstlane(tid >> 6), lane = tid & 63, wr = wid >> 2, wc = wid & 3, fr = lane & 15, fq = lane >> 4;
    const int K = g.K, nt = K / BK;
    unsigned voffA[2], voffB[2];
#pragma unroll
    for (int i = 0; i < 2; ++i) { int R, C; stage_rc(tid * 16 + i * 8192, R, C); const int Rb = Epi::PERM ? ((R & ~31) + perm32(R & 31)) : R;
        voffA[i] = (unsigned)(R * K + C) * 2u; voffB[i] = (unsigned)(Rb * K + C) * 2u; }
    const size_t kstep = (size_t)(BK * 2);
    const size_t hstep = (size_t)HALF * K * 2;
    const size_t tstep = 2 * hstep;
    const unsigned ldsw = (unsigned)wid * 1024u;
    const int aoff = lds_byte(wr * 64 + fr, fq * 8), boff = lds_byte(wc * 32 + fr, fq * 8);
#define PG8_SA(b, h) (((b) * 2 + (h)) * HTB)
#define PG8_SB(b, h) ((4 + (b) * 2 + (h)) * HTB)
#define PG8_STAGE(bufoff, gbase, voff) do { _Pragma("unroll") for (int _i = 0; _i < 2; ++_i) \
        __builtin_amdgcn_global_load_lds((const unsigned*)((const char*)(gbase) + (voff)[_i]), (PG8_LAS unsigned*)(lds + (bufoff) + ldsw + _i * 8192), 16, 0, 0); } while (0)
#define PG8_LDA(dst, b, h) do { _Pragma("unroll") for (int m = 0; m < 4; ++m) _Pragma("unroll") for (int k = 0; k < 2; ++k) dst[m][k] = *(const PG8_LAS bf16x8*)(lds + PG8_SA(b, h) + aoff + m * 2048 + k * 1024); } while (0)
#define PG8_LDB(dst, b, h) do { _Pragma("unroll") for (int n = 0; n < 2; ++n) _Pragma("unroll") for (int k = 0; k < 2; ++k) dst[n][k] = *(const PG8_LAS bf16x8*)(lds + PG8_SB(b, h) + boff + n * 2048 + k * 1024); } while (0)
#define PG8_MMA(ai, bj, At, Bt) do { __builtin_amdgcn_s_setprio(1); _Pragma("unroll") for (int m = 0; m < 4; ++m) _Pragma("unroll") for (int n = 0; n < 2; ++n) _Pragma("unroll") for (int k = 0; k < 2; ++k) \
        acc[ai][bj][m][n] = __builtin_amdgcn_mfma_f32_16x16x32_bf16(Bt[n][k], At[m][k], acc[ai][bj][m][n], 0, 0, 0); __builtin_amdgcn_s_setprio(0); } while (0)
#define PG8_WAIT_V(n) asm volatile("s_waitcnt vmcnt(" #n ")" ::: "memory")
#define PG8_WAIT_L(n) asm volatile("s_waitcnt lgkmcnt(" #n ")" ::: "memory")
#define PG8_BAR __builtin_amdgcn_s_barrier()
#define PG8_SCHED __builtin_amdgcn_sched_barrier(0)
    Unit cur, nxt; int ui = 0;
    if (!S.next(0, cur)) return;
    f32x4 acc[2][2][4][2];
#pragma unroll
    for (int a = 0; a < 2; ++a)
#pragma unroll
        for (int b = 0; b < 2; ++b)
#pragma unroll
            for (int m = 0; m < 4; ++m)
#pragma unroll
                for (int n = 0; n < 2; ++n) acc[a][b][m][n] = (f32x4){0.f, 0.f, 0.f, 0.f};
    bf16x8 At[4][2], B0[2][2], B1[2][2];
    const char* cA = (const char*)g.A + (size_t)cur.pm * tstep; const char* cB = (const char*)g.Bt + (size_t)cur.pn * tstep;
    S.a_ready(cur);
    if constexpr (SP2) {
        PG8_STAGE(PG8_SB(0, 0), cB, voffB); PG8_STAGE(PG8_SB(0, 1), cB + hstep, voffB); PG8_STAGE(PG8_SA(0, 0), cA, voffA); PG8_STAGE(PG8_SA(0, 1), cA + hstep, voffA);
        if (wr == 1) PG8_BAR;
        PG8_WAIT_V(2); PG8_BAR;
        PG8_STAGE(PG8_SB(1, 0), cB + kstep, voffB); PG8_STAGE(PG8_SA(1, 0), cA + kstep, voffA); PG8_STAGE(PG8_SB(1, 1), cB + hstep + kstep, voffB);
        PG8_WAIT_V(6); PG8_BAR;
    } else {
        PG8_STAGE(PG8_SB(0, 0), cB, voffB); PG8_STAGE(PG8_SA(0, 0), cA, voffA); PG8_STAGE(PG8_SB(0, 1), cB + hstep, voffB); PG8_STAGE(PG8_SA(0, 1), cA + hstep, voffA);
        if (wr == 1) PG8_BAR;
        PG8_WAIT_V(4); PG8_BAR;
        PG8_STAGE(PG8_SB(1, 0), cB + kstep, voffB); PG8_STAGE(PG8_SA(1, 0), cA + kstep, voffA); PG8_STAGE(PG8_SB(1, 1), cB + hstep + kstep, voffB);
        PG8_WAIT_V(6); PG8_BAR;
    }
    for (;;) {
        const bool has_next = S.next(ui + 1, nxt);
        const char* nA = has_next ? (const char*)g.A + (size_t)nxt.pm * tstep : cA; const char* nB = has_next ? (const char*)g.Bt + (size_t)nxt.pn * tstep : cB;
        for (int t = 0; t < nt; t += 2) {
            const bool last = (t == nt - 2);
            const char* a1 = cA + (size_t)(t + 1) * kstep;
            const char* a2 = last ? nA : cA + (size_t)(t + 2) * kstep; const char* b2 = last ? nB : cB + (size_t)(t + 2) * kstep;
            const char* a3 = a2 + kstep; const char* b3 = b2 + kstep;
            if (last && has_next) S.a_ready(nxt);
            if constexpr (SP2) {
            PG8_LDB(B0, 0, 0); PG8_LDB(B1, 0, 1); PG8_SCHED; PG8_LDA(At, 0, 0); PG8_STAGE(PG8_SA(1, 1), a1 + hstep, voffA);
            PG8_WAIT_V(8); PG8_WAIT_L(0); PG8_BAR; PG8_MMA(0, 0, At, B0); PG8_MMA(0, 1, At, B1); PG8_BAR; PG8_SCHED;
            PG8_LDA(At, 0, 1); PG8_STAGE(PG8_SB(0, 0), b2, voffB); PG8_STAGE(PG8_SB(0, 1), b2 + hstep, voffB); PG8_STAGE(PG8_SA(0, 0), a2, voffA);
            PG8_WAIT_V(8); PG8_WAIT_L(0); PG8_BAR; PG8_MMA(1, 0, At, B0); PG8_MMA(1, 1, At, B1); PG8_BAR; PG8_SCHED;
            PG8_LDB(B0, 1, 0); PG8_LDB(B1, 1, 1); PG8_SCHED; PG8_LDA(At, 1, 0); PG8_STAGE(PG8_SA(0, 1), a2 + hstep, voffA);
            PG8_WAIT_V(8); PG8_WAIT_L(0); PG8_BAR; PG8_MMA(0, 0, At, B0); PG8_MMA(0, 1, At, B1); PG8_BAR; PG8_SCHED;
            PG8_LDA(At, 1, 1); PG8_STAGE(PG8_SB(1, 0), b3, voffB); PG8_STAGE(PG8_SB(1, 1), b3 + hstep, voffB); PG8_STAGE(PG8_SA(1, 0), a3, voffA);
            PG8_WAIT_V(8); PG8_WAIT_L(0); PG8_BAR; PG8_MMA(1, 0, At, B0); PG8_MMA(1, 1, At, B1); PG8_BAR; PG8_SCHED;
            } else {
            PG8_LDB(B0, 0, 0); PG8_SCHED; PG8_LDA(At, 0, 0); PG8_STAGE(PG8_SA(1, 1), a1 + hstep, voffA);
            PG8_WAIT_L(8); PG8_BAR; PG8_WAIT_L(0); PG8_MMA(0, 0, At, B0); PG8_BAR; PG8_SCHED;
            PG8_LDB(B1, 0, 1); PG8_STAGE(PG8_SB(0, 0), b2, voffB);
            PG8_BAR; PG8_WAIT_L(0); PG8_MMA(0, 1, At, B1); PG8_BAR;
            PG8_LDA(At, 0, 1); PG8_STAGE(PG8_SA(0, 0), a2, voffA);
            PG8_BAR; PG8_WAIT_L(0); PG8_MMA(1, 0, At, B0); PG8_BAR; PG8_SCHED;
            PG8_STAGE(PG8_SB(0, 1), b2 + hstep, voffB);
            PG8_WAIT_V(6); PG8_BAR; PG8_MMA(1, 1, At, B1); PG8_BAR;
            PG8_LDB(B0, 1, 0); PG8_SCHED; PG8_LDA(At, 1, 0); PG8_STAGE(PG8_SA(0, 1), a2 + hstep, voffA);
            PG8_WAIT_L(8); PG8_BAR; PG8_WAIT_L(0); PG8_MMA(0, 0, At, B0); PG8_BAR; PG8_SCHED;
            PG8_LDB(B1, 1, 1); PG8_STAGE(PG8_SB(1, 0), b3, voffB);
            PG8_BAR; PG8_WAIT_L(0); PG8_MMA(0, 1, At, B1); PG8_BAR;
            PG8_LDA(At, 1, 1); PG8_STAGE(PG8_SA(1, 0), a3, voffA);
            PG8_BAR; PG8_WAIT_L(0); PG8_MMA(1, 0, At, B0); PG8_BAR; PG8_SCHED;
            PG8_STAGE(PG8_SB(1, 1), b3 + hstep, voffB);
            PG8_WAIT_V(6); PG8_BAR; PG8_MMA(1, 1, At, B1); PG8_BAR;
            }
        }
        if constexpr (ALIGN_EPI) { if (wr == 0) PG8_BAR; }
        if constexpr (!Epi::AFTER_DRAIN) { E(acc, cur, wr, wc, fr, fq); S.done(cur); }
        if (!has_next) break;
#pragma unroll
        for (int a = 0; a < 2; ++a)
#pragma unroll
            for (int b = 0; b < 2; ++b)
#pragma unroll
                for (int m = 0; m < 4; ++m)
#pragma unroll
                    for (int n = 0; n < 2; ++n) acc[a][b][m][n] = (f32x4){0.f, 0.f, 0.f, 0.f};
        cur = nxt; cA = nA; cB = nB; ++ui;
        if constexpr (ALIGN_EPI) { if (wr == 1) PG8_BAR; }
    }
    PG8_WAIT_V(0);
    if constexpr (!ALIGN_EPI) { if (wr == 0) PG8_BAR; }
    PG8_BAR;
    if constexpr (Epi::AFTER_DRAIN) { E.fused(acc, cur, wr, wc, fr, fq, lds, wid, lane); S.done(cur); }
#undef PG8_SA
#undef PG8_SB
#undef PG8_STAGE
#undef PG8_LDA
#undef PG8_LDB
#undef PG8_MMA
#undef PG8_WAIT_V
#undef PG8_WAIT_L
#undef PG8_BAR
#undef PG8_SCHED
}
}
#define GAS __attribute__((address_space(1)))
#define LAS __attribute__((address_space(3)))
typedef unsigned short bf16;
typedef unsigned v4u __attribute__((ext_vector_type(4)));
typedef float f32x4 __attribute__((ext_vector_type(4)));
typedef short bf16x8 __attribute__((ext_vector_type(8)));
typedef GAS unsigned gu32;
typedef GAS unsigned long long gu64;
#define RLX_AGENT __ATOMIC_RELAXED, __HIP_MEMORY_SCOPE_AGENT
#define LDS_WAIT() asm volatile("s_waitcnt lgkmcnt(0)" ::: "memory")
#define VM_WAIT() asm volatile("s_waitcnt vmcnt(0)" ::: "memory")
__device__ __forceinline__ unsigned long long rt() { return __builtin_amdgcn_s_memrealtime(); }
__device__ __forceinline__ unsigned f2bf(float f) { unsigned u = __builtin_bit_cast(unsigned, f); return (u + 0x7fffu + ((u >> 16) & 1u)) >> 16; }
__device__ __forceinline__ unsigned pk2(float lo, float hi) { return f2bf(lo) | (f2bf(hi) << 16); }
#define XB_TMO      128
#define XB_XCNT(j)  (256  + 64 * (j))
#define XB_XSUB(j)  (1280 + 64 * (j))
#define XB_XGEN(j)  (2304 + 64 * (j))
#define XB_TOP      3328
#define XB_TOPGEN   3392
#define XCD_BAR_WORDS 3456
#define XB_SPIN_CAP (1u << 18)

__device__ __forceinline__ unsigned xb_ld(unsigned* p)              { return __hip_atomic_load(p, __ATOMIC_RELAXED, __HIP_MEMORY_SCOPE_AGENT); }
__device__ __forceinline__ unsigned xb_add(unsigned* p, unsigned v) { return __hip_atomic_fetch_add(p, v, __ATOMIC_RELAXED, __HIP_MEMORY_SCOPE_AGENT); }
__device__ __forceinline__ unsigned xb_xcc_id() { return (unsigned)__builtin_amdgcn_s_getreg((3 << 11) | 20) & 0xFu; }
#define XB_SPIN(cond, bar) do { unsigned _sp = 0; while (cond) { __builtin_amdgcn_s_sleep(1); \
    if ((++_sp & 255u) == 0u) { if (xb_ld(&(bar)[XB_TMO])) break; if (_sp > XB_SPIN_CAP) { atomicAdd(&(bar)[XB_TMO], 1u); break; } } } } while (0)

struct XcdBarrier {
    unsigned* bar; unsigned x;
    volatile LAS unsigned* st;
};

__device__ __forceinline__ XcdBarrier xcd_barrier_post(unsigned* bar, volatile LAS unsigned* st) {
    XcdBarrier b; b.bar = bar; b.x = xb_xcc_id(); b.st = st;
    if (threadIdx.x == 0) (void)xb_add(&bar[XB_XCNT(b.x)], 1u);
    return b;
}
__device__ __forceinline__ void xcd_barrier_complete(unsigned* bar, unsigned x, unsigned& nloc, unsigned& nx) {
    const unsigned G = gridDim.x * gridDim.y * gridDim.z;
    unsigned sum, cnt, mine, sp = 0u;
    for (;;) {
        sum = 0u; cnt = 0u; mine = 0u;
#pragma unroll
        for (unsigned j = 0; j < 16; ++j) { const unsigned c = xb_ld(&bar[XB_XCNT(j)]); sum += c; cnt += (c > 0u) ? 1u : 0u; mine = (j == x) ? c : mine; }
        if (sum == G) break;
        __builtin_amdgcn_s_sleep(1);
        if ((++sp & 255u) == 0u) { if (xb_ld(&bar[XB_TMO])) break; if (sp > XB_SPIN_CAP) { atomicAdd(&bar[XB_TMO], 1u); break; } }
    }
    nloc = mine > 0u ? mine : 1u; nx = cnt > 0u ? cnt : 1u;
}

__device__ __forceinline__ void xcd_barrier(const XcdBarrier& b) {
    asm volatile("s_waitcnt vmcnt(0)" ::: "memory");
    __syncthreads();
    if (threadIdx.x == 0) {
        unsigned* bar = b.bar;
        __builtin_amdgcn_s_waitcnt(0);
        unsigned nloc = b.st[0], nx = b.st[1];
        if (nloc == 0u) { xcd_barrier_complete(bar, b.x, nloc, nx); b.st[0] = nloc; b.st[1] = nx; }
        const unsigned old = xb_add(&bar[XB_XSUB(b.x)], 1u);
        const unsigned gen = old / nloc;
        if (old + 1u == (gen + 1u) * nloc) {
            __builtin_amdgcn_fence(__ATOMIC_RELEASE, "agent");
            asm volatile("s_waitcnt vmcnt(0)" ::: "memory");
            const unsigned og = xb_add(&bar[XB_TOP], 1u);
            const unsigned tg = og / nx;
            if (og + 1u == (tg + 1u) * nx) xb_add(&bar[XB_TOPGEN], 1u);
            else XB_SPIN(xb_ld(&bar[XB_TOPGEN]) == tg, bar);
            __builtin_amdgcn_fence(__ATOMIC_ACQUIRE, "agent");
            xb_add(&bar[XB_XGEN(b.x)], 1u);
            asm volatile("s_waitcnt vmcnt(0)" ::: "memory");
        } else {
            XB_SPIN(xb_ld(&bar[XB_XGEN(b.x)]) == gen, bar);
            __builtin_amdgcn_fence(__ATOMIC_ACQUIRE, "agent");
            asm volatile("s_waitcnt vmcnt(0)" ::: "memory");
        }
    }
    __syncthreads();
}

constexpr int NWAVES = 8, NTHREADS = 512;
constexpr int NT = 32768, DM = 1024, SEQ = 8192, NCHUNK = 128, PROJW = 3328;
constexpr float EPS = 1e-6f;
enum { I_X = 0, I_P, I_POS, I_NMW, I_NFW, I_NPW, I_FNW, I_EWIN, I_GWUP, I_GBUP, I_GNW, I_RNW, I_EWOUT, I_OWIN, I_POOLW, I_POOLS, I_ARE, I_AIM, I_LDT, I_BRE, I_BIM, I_CRE, I_CIM, I_DSK,
       I_WGLU, I_BGLU, I_OWOUT, I_PWQ, I_PKEYS, I_PU, I_PV, I_PLEP, I_PLEG, N_IN };
constexpr size_t MiB = 1u << 20;
constexpr size_t WS_CTL = 0, CTL_ZERO_BYTES = 64 * 1024;
constexpr size_t WS_WIN0 = 1 * MiB, WS_WOUT0 = 8 * MiB, WS_WEFF = 10 * MiB  , WS_WG = 18 * MiB  , WS_WP = 22 * MiB  , WS_WIN1 = 23 * MiB, WS_WGLU = 25 * MiB, WS_WOUT1 = 26 * MiB;
constexpr size_t WS_ROT = 28 * MiB, WS_S5C = 30 * MiB, WS_SSQ0 = 31 * MiB, WS_SSQ1 = 33 * MiB, WS_DEC = 35 * MiB;
constexpr size_t S5_ABAR = 0, S5_A64 = 16384, S5_BBAR = 32768  , S5_CM = 32768 + 262144  ;
constexpr size_t WS_A0 = 36 * MiB, WS_A1 = 100 * MiB, WS_R1 = 164 * MiB;
constexpr size_t WS_PROJ = WS_R1, WS_KV = WS_R1 + 208 * MiB;
constexpr size_t WS_SC = WS_R1, WS_EID = WS_R1 + 256 * MiB, WS_GATE = WS_R1 + 272 * MiB;
constexpr size_t WS_UT = WS_R1, WS_VT = WS_R1 + 32 * MiB, WS_PB = WS_R1 + 64 * MiB, WS_PP = WS_R1 + 80 * MiB;
constexpr size_t WS_U = WS_R1, WS_Z = WS_R1 + 64 * MiB, WS_E = WS_R1 + 96 * MiB;
constexpr size_t WS_END = WS_R1 + 288 * MiB;
constexpr int RING_BYTES = 131072, MISC_OFF = RING_BYTES + 320, LDS_BYTES = 147456;

__device__ __forceinline__ float bf2f(unsigned short b) { return __uint_as_float((unsigned)b << 16); }
__device__ __forceinline__ float bflo(unsigned w) { return __uint_as_float(w << 16); }
__device__ __forceinline__ float bfhi(unsigned w) { return __uint_as_float(w & 0xffff0000u); }
__device__ __forceinline__ float wave_sum(float v) {
#pragma unroll
    for (int o = 1; o < 64; o <<= 1) v += __shfl_xor(v, o);
    return v;
}
__device__ __forceinline__ float gelu1(float v) {
    const float av = fabsf(v), t = __builtin_amdgcn_rcpf(av * 0.2316418882f + 1.0f);
    float q = t * 0.5307027145f + (-0.7265760135f); q = q * t + 0.7107068705f; q = q * t + (-0.142248368f); q = q * t + 0.127414796f; q = q * t;
    const float e = __builtin_amdgcn_exp2f((v * v) * (-0.72134752044f));
    const float m = v * (q * e);
    return v < 0.f ? m : v - m;
}
__device__ __forceinline__ float logsigf(float x) { return fminf(x, 0.f) - __logf(1.0f + __expf(-fabsf(x))); }
__device__ __forceinline__ float siluf(float x) { return x * __builtin_amdgcn_rcpf(1.0f + __expf(-x)); }

struct Ctx {
    LAS unsigned char* lds;
    int tid, lane, wave, G, bid;
    float* h;
    unsigned char* ws;
};
struct Args { const void* in[N_IN]; float* out; unsigned char* ws; };
constexpr int PTR_OFF = 131072 + 1024;
#define IN(i) inptr(C, (i))
#define WSP(T, off) ((T*)(C.ws + (off)))
#define PHASE_ENTER(C) do { int t_ = threadIdx.x; asm volatile("" : "+v"(t_)); C.tid = t_; C.lane = t_ & 63; C.wave = __builtin_amdgcn_readfirstlane(t_ >> 6); asm volatile("" : "+s"(C.ws), "+s"(C.h)); C.ws = (unsigned char*)(GAS unsigned char*)C.ws; C.h = (float*)(GAS float*)C.h; } while (0)
__device__ __forceinline__ const float* inptr(const Ctx& C, int i) { const LAS unsigned* t = (const LAS unsigned*)(C.lds + PTR_OFF) + 2 * i;
    const unsigned lo = __builtin_amdgcn_readfirstlane(t[0]), hi = __builtin_amdgcn_readfirstlane(t[1]); return (const float*)(const GAS float*)(((unsigned long long)hi << 32) | lo); }

__device__ __forceinline__ void tr_item(const float* W, int ldw, int c0, bf16* WT, int K, int r0, const float* ks, float cs, LAS float* scr, int item, int nblk, int lane) {
    const int kb = item / nblk, nb = item % nblk, k0 = 64 * kb, n0 = 32 * nb;
#pragma unroll 8
    for (int i = 0; i < 32; ++i) { const int kk = 2 * i + (lane >> 5); float v = W[(size_t)(k0 + kk) * ldw + c0 + n0 + (lane & 31)]; if (ks) v *= ks[k0 + kk]; scr[kk * 33 + (lane & 31)] = v * cs; }
    LDS_WAIT(); asm volatile("" ::: "memory");
    const int c = lane & 7;
#pragma unroll
    for (int j = 0; j < 4; ++j) { const int n = (lane >> 3) + 8 * j; const LAS float* s = scr + (8 * c) * 33 + n;
        v4u o; o.x = pk2(s[0 * 33], s[1 * 33]); o.y = pk2(s[2 * 33], s[3 * 33]); o.z = pk2(s[4 * 33], s[5 * 33]); o.w = pk2(s[6 * 33], s[7 * 33]);
        *(v4u*)(WT + (size_t)(r0 + n0 + n) * K + k0 + 8 * c) = o; }
    LDS_WAIT(); asm volatile("" ::: "memory");
}
__device__ __forceinline__ void fold_item(const float* KM, int sk, int sc, const float* W, int ldw, int wc0, int kb, bf16* OUT, const float* kscale, const float* nscale, LAS float* lds, int tid) {
    LAS float* KL = lds;
    LAS float* WL = lds + 128 * 132;
    if (sc == 1) { for (int idx = tid; idx < 16384; idx += NTHREADS) { const int key = idx >> 7, c = idx & 127; KL[key * 132 + c] = KM[(size_t)key * sk + c]; } }
    else         { for (int idx = tid; idx < 16384; idx += NTHREADS) { const int c = idx >> 7, key = idx & 127; KL[key * 132 + c] = KM[(size_t)key * sk + (size_t)c * sc]; } }
    for (int idx = tid; idx < 8192; idx += NTHREADS) { const int k = idx >> 7, c = idx & 127; WL[k * 132 + c] = W[(size_t)(kb * 64 + k) * ldw + wc0 + c]; }
    __syncthreads();
    const int ty = tid >> 4, tx = tid & 15;
    float acc[4][4];
#pragma unroll
    for (int i = 0; i < 4; ++i)
#pragma unroll
        for (int j = 0; j < 4; ++j) acc[i][j] = 0.f;
    for (int c4 = 0; c4 < 32; ++c4) {
        f32x4 a[4], b[4];
#pragma unroll
        for (int i = 0; i < 4; ++i) a[i] = *(const LAS f32x4*)(KL + (4 * ty + i) * 132 + 4 * c4);
#pragma unroll
        for (int j = 0; j < 4; ++j) b[j] = *(const LAS f32x4*)(WL + (tx + 16 * j) * 132 + 4 * c4);
#pragma unroll
        for (int i = 0; i < 4; ++i)
#pragma unroll
            for (int j = 0; j < 4; ++j) acc[i][j] += (a[i][0] * b[j][0] + a[i][1] * b[j][1]) + (a[i][2] * b[j][2] + a[i][3] * b[j][3]);
    }
#pragma unroll
    for (int i = 0; i < 4; ++i) { const int key = 4 * ty + i; const float ns = nscale ? nscale[key] : 1.0f;
#pragma unroll
        for (int j = 0; j < 4; ++j) { const int k = kb * 64 + tx + 16 * j; OUT[(size_t)key * 1024 + k] = (bf16)f2bf(acc[i][j] * kscale[k] * ns); } }
    __syncthreads();
}

__device__ __forceinline__ void phase_prologue(Ctx C, const Args& A) {
    PHASE_ENTER(C);
    const int tid = C.tid, lane = C.lane;
    const int gw = C.bid * NWAVES + C.wave, NGW = C.G * NWAVES;
    const int gt = C.bid * NTHREADS + tid, NGT = C.G * NTHREADS;
    for (int it = C.bid; it < 576; it += C.G) {
        if (it < 512) { const int l = it >> 8, hp = (it >> 4) & 15, kb = it & 15;
            fold_item(IN(I_PKEYS) + (size_t)(l * 16 + hp) * 16384, 128, 1, IN(I_PWQ) + (size_t)l * 1024 * 2048, 2048, hp * 128, kb,
                      WSP(bf16, WS_WEFF) + (size_t)l * 2048 * 1024 + (size_t)hp * 128 * 1024, IN(I_NFW) + l * 1024, nullptr, (LAS float*)C.lds, tid);
        } else { const int r = it - 512, g = r >> 4, kb = r & 15;
            fold_item(IN(I_POOLW) + (size_t)g * 16384, 1, 128, IN(I_OWIN), 1024, g * 128, kb,
                      WSP(bf16, WS_WIN1) + (size_t)g * 128 * 1024, IN(I_NMW) + 1024, IN(I_POOLS) + g * 128, (LAS float*)C.lds, tid);
        }
    }
    LAS float* scr = (LAS float*)(C.lds + C.wave * 8448);
    constexpr int TR_ITEMS = 128 + 640 + 128 + 128 + 512 + 512 + 512 + 512 + 128 + 128 + 256 + 128 + 512;
    for (int it = gw; it < TR_ITEMS; it += NGW) {
        int r = it;
#define TRJOB(W, ldw, c0, ncols, Krows, WT, r0, ks, cs) { constexpr int nb_ = (ncols) / 32, ni_ = ((Krows) / 64) * nb_; if (r < ni_) { tr_item(W, ldw, c0, WT, Krows, r0, ks, cs, scr, r, nb_, lane); continue; } r -= ni_; }
        TRJOB(IN(I_EWIN), 3088, 0,    256,  1024, WSP(bf16, WS_WIN0), 0,    IN(I_NMW), 0.125f)
        TRJOB(IN(I_EWIN), 3088, 256,  1280, 1024, WSP(bf16, WS_WIN0), 256,  IN(I_NMW), 1.0f)
        TRJOB(IN(I_EWIN), 3088, 1552, 256,  1024, WSP(bf16, WS_WIN0), 1792, IN(I_NMW), 1.0f)
        TRJOB(IN(I_EWIN), 3088, 1808, 256,  1024, WSP(bf16, WS_WIN0), 2048, IN(I_NMW), 0.125f)
        TRJOB(IN(I_EWIN), 3088, 2064, 1024, 1024, WSP(bf16, WS_WIN0), 2304, IN(I_NMW), 1.0f)
        TRJOB(IN(I_EWOUT), 1024, 0, 1024, 1024, WSP(bf16, WS_WOUT0), 0, (const float*)nullptr, 1.0f)
        TRJOB(IN(I_PLEG), 1024, 0, 1024, 1024, WSP(bf16, WS_WG), 0, IN(I_NPW), 1.0f)
        TRJOB(IN(I_PLEG) + 1024 * 1024, 1024, 0, 1024, 1024, WSP(bf16, WS_WG) + 1024 * 1024, 0, IN(I_NPW) + 1024, 1.0f)
        TRJOB(IN(I_PLEP), 1024, 0, 1024, 256, WSP(bf16, WS_WP), 0, (const float*)nullptr, 1.0f)
        TRJOB(IN(I_PLEP) + 256 * 1024, 1024, 0, 1024, 256, WSP(bf16, WS_WP) + 1024 * 256, 0, (const float*)nullptr, 1.0f)
        TRJOB(IN(I_OWIN), 1024, 512, 512, 1024, WSP(bf16, WS_WIN1), 512, IN(I_NMW) + 1024, 1.0f)
        TRJOB(IN(I_WGLU), 512, 0, 512, 512, WSP(bf16, WS_WGLU), 0, (const float*)nullptr, 1.0f)
        TRJOB(IN(I_OWOUT), 1024, 0, 1024, 1024, WSP(bf16, WS_WOUT1), 0, (const float*)nullptr, 1.0f)
#undef TRJOB
    }
    for (int idx = gt; idx < 256 * 1024; idx += NGT) { const int j = idx >> 10, k = idx & 1023; const float* wr = IN(I_EWIN) + (size_t)k * 3088 + 1536; const float* wu = IN(I_GWUP) + j; float s = 0.f;
#pragma unroll
        for (int r = 0; r < 16; ++r) s += wr[r] * wu[r * 256];
        WSP(bf16, WS_WIN0)[(size_t)(1536 + j) * 1024 + k] = (bf16)f2bf(s * IN(I_NMW)[k]); }
    for (int idx = gt; idx < SEQ * 32; idx += NGT) { const int s = idx >> 5, i = idx & 31; const double pos = (double)((const int*)IN(I_POS))[s];
        const double ang = pos * exp2(-(double)i * (13.287712379549449 / 32.0)); const double r = ang - 6.283185307179586 * rint(ang * 0.15915494309189535);
        float sn, cs; sincosf((float)r, &sn, &cs); WSP(float, WS_ROT)[2 * idx] = cs; WSP(float, WS_ROT)[2 * idx + 1] = sn; }
    for (int idx = gt; idx < 2048; idx += NGT) { const int g = idx >> 6;
        const double dt = exp((double)IN(I_LDT)[g]), are = (double)IN(I_ARE)[idx], aim = (double)IN(I_AIM)[idx];
        const double mag = exp(are * dt); double th = aim * dt; th -= 6.283185307179586 * rint(th * 0.15915494309189535);
        const double abr = mag * cos(th), abi = mag * sin(th);
        const double den = are * are + aim * aim, nr = abr - 1.0, ni = abi;
        const double cre = (nr * are + ni * aim) / den, cim = (ni * are - nr * aim) / den;
        const double m64 = exp(64.0 * are * dt); double t64 = 64.0 * aim * dt; t64 -= 6.283185307179586 * rint(t64 * 0.15915494309189535);
        float* s5 = WSP(float, WS_S5C);
        s5[S5_ABAR / 4 + 2 * idx] = (float)abr; s5[S5_ABAR / 4 + 2 * idx + 1] = (float)abi;
        s5[S5_A64 / 4 + 2 * idx] = (float)(m64 * cos(t64)); s5[S5_A64 / 4 + 2 * idx + 1] = (float)(m64 * sin(t64));
        for (int hh = 0; hh < 16; ++hh) { const double br = (double)IN(I_BRE)[idx * 16 + hh], bi = (double)IN(I_BIM)[idx * 16 + hh];
            s5[S5_BBAR / 4 + (idx * 16 + hh) * 2] = (float)(cre * br - cim * bi); s5[S5_BBAR / 4 + (idx * 16 + hh) * 2 + 1] = (float)(cre * bi + cim * br); } }
    for (int idx = gt; idx < 32 * 16 * 128; idx += NGT) { const int k = idx & 127, gh = idx >> 7;
        const float v = k < 64 ? IN(I_CRE)[gh * 64 + k] : -IN(I_CIM)[gh * 64 + k - 64]; ((bf16*)(C.ws + WS_S5C + S5_CM))[idx] = (bf16)f2bf(v); }
    for (int m = gw; m < NT; m += NGW) { const f32x4* xr = (const f32x4*)(IN(I_X) + (size_t)m * DM) + lane; f32x4 v[4]; float s = 0.f;
#pragma unroll
        for (int j = 0; j < 4; ++j) { v[j] = xr[64 * j]; s += (v[j][0] * v[j][0] + v[j][1] * v[j][1]) + (v[j][2] * v[j][2] + v[j][3] * v[j][3]); }
        const float rs = 1.0f / sqrtf(wave_sum(s) * (1.0f / DM) + EPS);
        unsigned long long* o8 = (unsigned long long*)(WSP(bf16, WS_A0) + (size_t)m * DM) + lane;
#pragma unroll
        for (int j = 0; j < 4; ++j) o8[64 * j] = (unsigned long long)pk2(v[j][0] * rs, v[j][1] * rs) | ((unsigned long long)pk2(v[j][2] * rs, v[j][3] * rs) << 32); }
}

__device__ __forceinline__ float lg2gamma(int hh) { return __log2f(1.0f - exp2f(-5.0f - (float)hh)); }

__device__ __forceinline__ void gla_gate_local(const bf16* prow, int lacol, float bu, float (&g)[16]) {
    float run = 0.f;
#pragma unroll
    for (int c = 0; c < 16; ++c) { const float x = bf2f(prow[(size_t)c * PROJW + lacol]) + bu; run += logsigf(x) * (1.0f / 16.0f); g[c] = run; }
}
__device__ __forceinline__ void stage_vt(const bf16* prow, int vbase, LAS bf16* Vt, int c0, int lane) {
#pragma unroll
    for (int eh = 0; eh < 2; ++eh) { const int e = lane + 64 * eh; unsigned w[8];
#pragma unroll
        for (int c = 0; c < 16; c += 2) w[c >> 1] = (unsigned)prow[(size_t)c * PROJW + vbase + e] | ((unsigned)prow[(size_t)(c + 1) * PROJW + vbase + e] << 16);
        *(LAS v4u*)(Vt + e * 72 + c0) = (v4u){w[0], w[1], w[2], w[3]}; *(LAS v4u*)(Vt + e * 72 + c0 + 8) = (v4u){w[4], w[5], w[6], w[7]}; }
}

__device__ __forceinline__ void phase_kv(Ctx C, const Args& A) {
    PHASE_ENTER(C);
    const int lane = C.lane, half = C.wave >> 2, w4 = C.wave & 3, fr = lane & 15, fq = lane >> 4, c0 = 16 * w4;
    LAS unsigned char* hb = C.lds + half * 28672;
    LAS bf16* Kt = (LAS bf16*)hb; LAS bf16* Vt = (LAS bf16*)(hb + 9216); LAS float* TOT = (LAS float*)(hb + 27648);
    const bf16* PROJ = WSP(bf16, WS_PROJ);
    for (int item = C.bid; item < 2048; item += C.G) {
        const int pair = item & 3, n = (item >> 2) & 127, b = item >> 9; const bool isret = pair >= 2;
        const int hh = (pair & 1) * 2 + half, t0 = b * SEQ + n * 64;
        const bf16* prow = PROJ + (size_t)(t0 + c0) * PROJW;
        float g[16]; float glast = 0.f, off = 0.f;
        if (!isret) { gla_gate_local(prow, 1536 + hh * 64 + lane, IN(I_GBUP)[hh * 64 + lane], g); TOT[w4 * 64 + lane] = g[15]; }
        __syncthreads();
        if (!isret) {
#pragma unroll
            for (int w = 0; w < 4; ++w) { const float tv = TOT[w * 64 + lane]; glast += tv; if (w < w4) off += tv; } }
        unsigned kw[8];
        if (!isret) { const int kcol = 256 + hh * 64 + lane;
#pragma unroll
            for (int c = 0; c < 16; c += 2) { const float k0 = bf2f(prow[(size_t)c * PROJW + kcol]) * __expf(glast - (off + g[c])), k1 = bf2f(prow[(size_t)(c + 1) * PROJW + kcol]) * __expf(glast - (off + g[c + 1])); kw[c >> 1] = pk2(k0, k1); }
        } else { const int kcol = 2048 + hh * 64 + lane; const float lg = lg2gamma(hh); const float* rot = WSP(float, WS_ROT) + ((size_t)(n * 64 + c0) * 32 + (lane & 31)) * 2; float kv[2];
#pragma unroll
            for (int c = 0; c < 16; ++c) { const float own = bf2f(prow[(size_t)c * PROJW + kcol]), oth = bf2f(prow[(size_t)c * PROJW + (kcol ^ 32)]); const float cs = rot[c * 64], sn = rot[c * 64 + 1];
                const float r = lane < 32 ? own * cs - oth * sn : own * cs + oth * sn; kv[c & 1] = r * exp2f(lg * (float)(63 - (c0 + c))); if (c & 1) kw[c >> 1] = pk2(kv[0], kv[1]); } }
        *(LAS v4u*)(Kt + lane * 72 + c0) = (v4u){kw[0], kw[1], kw[2], kw[3]}; *(LAS v4u*)(Kt + lane * 72 + c0 + 8) = (v4u){kw[4], kw[5], kw[6], kw[7]};
        stage_vt(prow, isret ? 2304 + hh * 128 : 512 + hh * 128, Vt, c0, lane);
        if (!isret && w4 == 0) WSP(float, WS_DEC)[(size_t)((b * 4 + hh) * 128 + n) * 64 + lane] = __expf(glast);
        __syncthreads();
        f32x4 acc[2][4];
#pragma unroll
        for (int et = 0; et < 2; ++et)
#pragma unroll
            for (int dt = 0; dt < 4; ++dt) acc[et][dt] = (f32x4){0.f, 0.f, 0.f, 0.f};
#pragma unroll
        for (int kk = 0; kk < 2; ++kk) { bf16x8 bfr[4];
#pragma unroll
            for (int dt = 0; dt < 4; ++dt) bfr[dt] = *(const LAS bf16x8*)(Kt + (dt * 16 + fr) * 72 + kk * 32 + 8 * fq);
#pragma unroll
            for (int et = 0; et < 2; ++et) { const bf16x8 afr = *(const LAS bf16x8*)(Vt + ((2 * w4 + et) * 16 + fr) * 72 + kk * 32 + 8 * fq);
#pragma unroll
                for (int dt = 0; dt < 4; ++dt) acc[et][dt] = __builtin_amdgcn_mfma_f32_16x16x32_bf16(afr, bfr[dt], acc[et][dt], 0, 0, 0); } }
        bf16* KV = WSP(bf16, WS_KV) + (size_t)((b * 8 + (isret ? 4 + hh : hh)) * 128 + n) * 8192;
#pragma unroll
        for (int et = 0; et < 2; ++et)
#pragma unroll
            for (int dt = 0; dt < 4; ++dt)
#pragma unroll
                for (int r = 0; r < 4; ++r) KV[((2 * w4 + et) * 16 + 4 * fq + r) * 64 + dt * 16 + fr] = (bf16)f2bf(acc[et][dt][r]);
        __syncthreads();
    }
}

__device__ __forceinline__ void phase_scan(Ctx C, const Args& A) {
    PHASE_ENTER(C);
    for (int gid = C.bid * NTHREADS + C.tid; gid < 131072; gid += C.G * NTHREADS) {
        const int dp = gid & 31, e = (gid >> 5) & 127, bh = gid >> 12, h8 = bh & 7, b = bh >> 3;
        unsigned* p = (unsigned*)(WSP(bf16, WS_KV) + (size_t)bh * 128 * 8192 + e * 64) + dp;
        float s0 = 0.f, s1 = 0.f;
        if (h8 < 4) { const float* dec = WSP(float, WS_DEC) + (size_t)(b * 4 + h8) * 128 * 64 + 2 * dp;
#pragma unroll 8
            for (int n = 0; n < NCHUNK; ++n) { const unsigned kv = p[(size_t)n * 4096]; const float d0 = dec[n * 64], d1 = dec[n * 64 + 1]; p[(size_t)n * 4096] = pk2(s0, s1); s0 = d0 * s0 + bflo(kv); s1 = d1 * s1 + bfhi(kv); }
        } else { const float d = exp2f(64.0f * lg2gamma(h8 - 4));
#pragma unroll 8
            for (int n = 0; n < NCHUNK; ++n) { const unsigned kv = p[(size_t)n * 4096]; p[(size_t)n * 4096] = pk2(s0, s1); s0 = d * s0 + bflo(kv); s1 = d * s1 + bfhi(kv); } }
    }
}

__device__ __forceinline__ void phase_mix0_out(Ctx C, const Args& A) {
    PHASE_ENTER(C);
    const int lane = C.lane, half = C.wave >> 2, w4 = C.wave & 3, fr = lane & 15, fq = lane >> 4, c0 = 16 * w4;
    LAS unsigned char* hb = C.lds + half * 56320;
    LAS bf16* Qp = (LAS bf16*)hb; LAS bf16* Kp = (LAS bf16*)(hb + 9216); LAS bf16* Qpp = (LAS bf16*)(hb + 18432); LAS bf16* Vt = (LAS bf16*)(hb + 27648); LAS bf16* Pm = (LAS bf16*)(hb + 46080);
    LAS float* TOT = (LAS float*)(hb + 55296);
    const bf16* PROJ = WSP(bf16, WS_PROJ); bf16* Y = WSP(bf16, WS_A1);
    for (int item = C.bid; item < 2048; item += C.G) {
        const int pair = item & 3, n = (item >> 2) & 127, b = item >> 9; const bool isret = pair >= 2;
        const int hh = (pair & 1) * 2 + half, t0 = b * SEQ + n * 64;
        const bf16* prow = PROJ + (size_t)(t0 + c0) * PROJW;
        const float lg = lg2gamma(hh);
        float g[16]; float glast = 0.f, off = 0.f;
        if (!isret) { gla_gate_local(prow, 1536 + hh * 64 + lane, IN(I_GBUP)[hh * 64 + lane], g); TOT[w4 * 64 + lane] = g[15]; }
        __syncthreads();
        if (!isret) {
#pragma unroll
            for (int w = 0; w < 4; ++w) { const float tv = TOT[w * 64 + lane]; glast += tv; if (w < w4) off += tv; }
            const float ref = 0.5f * glast; const int qcol = hh * 64 + lane, kcol = 256 + hh * 64 + lane;
#pragma unroll
            for (int c = 0; c < 16; ++c) { const float gq = off + g[c], q = bf2f(prow[(size_t)c * PROJW + qcol]), k = bf2f(prow[(size_t)c * PROJW + kcol]); const int o = (c0 + c) * 72 + lane;
                Qp[o] = (bf16)f2bf(q * __expf(gq - ref)); Kp[o] = (bf16)f2bf(k * __expf(ref - gq)); Qpp[o] = (bf16)f2bf(q * __expf(gq)); }
        } else { const int qcol = 1792 + hh * 64 + lane, kcol = 2048 + hh * 64 + lane; const float* rot = WSP(float, WS_ROT) + ((size_t)(n * 64 + c0) * 32 + (lane & 31)) * 2;
#pragma unroll
            for (int c = 0; c < 16; ++c) { const float cs = rot[c * 64], sn = rot[c * 64 + 1];
                const float qo = bf2f(prow[(size_t)c * PROJW + qcol]), qx = bf2f(prow[(size_t)c * PROJW + (qcol ^ 32)]), ko = bf2f(prow[(size_t)c * PROJW + kcol]), kx = bf2f(prow[(size_t)c * PROJW + (kcol ^ 32)]);
                const float qr = lane < 32 ? qo * cs - qx * sn : qo * cs + qx * sn, kr = lane < 32 ? ko * cs - kx * sn : ko * cs + kx * sn; const int o = (c0 + c) * 72 + lane;
                Qp[o] = (bf16)f2bf(qr); Kp[o] = (bf16)f2bf(kr); Qpp[o] = (bf16)f2bf(qr * exp2f(lg * (float)(c0 + c + 1))); } }
        stage_vt(prow, isret ? 2304 + hh * 128 : 512 + hh * 128, Vt, c0, lane);
        __syncthreads();
        { f32x4 s[4];
#pragma unroll
            for (int jt = 0; jt < 4; ++jt) s[jt] = (f32x4){0.f, 0.f, 0.f, 0.f};
#pragma unroll
            for (int kk = 0; kk < 2; ++kk) { const bf16x8 afr = *(const LAS bf16x8*)(Qp + (16 * w4 + fr) * 72 + kk * 32 + 8 * fq);
#pragma unroll
                for (int jt = 0; jt < 4; ++jt) { const bf16x8 bfr = *(const LAS bf16x8*)(Kp + (16 * jt + fr) * 72 + kk * 32 + 8 * fq); s[jt] = __builtin_amdgcn_mfma_f32_16x16x32_bf16(afr, bfr, s[jt], 0, 0, 0); } }
#pragma unroll
            for (int jt = 0; jt < 4; ++jt)
#pragma unroll
                for (int r = 0; r < 4; ++r) { const int i = 16 * w4 + 4 * fq + r, j = 16 * jt + fr; float v = s[jt][r]; if (isret) v *= exp2f(lg * (float)(i - j)); if (j > i) v = 0.f; Pm[i * 72 + j] = (bf16)f2bf(v); } }
        asm volatile("s_waitcnt lgkmcnt(0)" ::: "memory");
        f32x4 o[8];
#pragma unroll
        for (int et = 0; et < 8; ++et) o[et] = (f32x4){0.f, 0.f, 0.f, 0.f};
        const bf16* St = WSP(bf16, WS_KV) + (size_t)((b * 8 + (isret ? 4 + hh : hh)) * 128 + n) * 8192;
#pragma unroll
        for (int kk = 0; kk < 2; ++kk) { const bf16x8 afr = *(const LAS bf16x8*)(Pm + (16 * w4 + fr) * 72 + kk * 32 + 8 * fq), afr2 = *(const LAS bf16x8*)(Qpp + (16 * w4 + fr) * 72 + kk * 32 + 8 * fq);
#pragma unroll
            for (int et = 0; et < 8; ++et) { const bf16x8 bfr = *(const LAS bf16x8*)(Vt + (16 * et + fr) * 72 + kk * 32 + 8 * fq); const bf16x8 bfr2 = *(const bf16x8*)(St + (16 * et + fr) * 64 + kk * 32 + 8 * fq);
                o[et] = __builtin_amdgcn_mfma_f32_16x16x32_bf16(afr, bfr, o[et], 0, 0, 0); o[et] = __builtin_amdgcn_mfma_f32_16x16x32_bf16(afr2, bfr2, o[et], 0, 0, 0); } }
        float mu[4], rs[4];
#pragma unroll
        for (int r = 0; r < 4; ++r) { float s1 = 0.f;
            if (isret) {
#pragma unroll
                for (int et = 0; et < 8; ++et) s1 += o[et][r];
                s1 += __shfl_xor(s1, 1); s1 += __shfl_xor(s1, 2); s1 += __shfl_xor(s1, 4); s1 += __shfl_xor(s1, 8); }
            mu[r] = s1 * (1.0f / 128.0f); float s2 = 0.f;
#pragma unroll
            for (int et = 0; et < 8; ++et) { const float d = o[et][r] - mu[r]; s2 += d * d; }
            s2 += __shfl_xor(s2, 1); s2 += __shfl_xor(s2, 2); s2 += __shfl_xor(s2, 4); s2 += __shfl_xor(s2, 8);
            rs[r] = 1.0f / sqrtf(s2 * (1.0f / 128.0f) + EPS); }
        const int gcol0 = isret ? 2816 + hh * 128 : 1024 + hh * 128, ycol0 = isret ? 512 + hh * 128 : hh * 128;
#pragma unroll
        for (int et = 0; et < 8; ++et) { const int e = 16 * et + fr; const float nw = isret ? IN(I_RNW)[hh * 128 + e] : IN(I_GNW)[e];
#pragma unroll
            for (int r = 0; r < 4; ++r) { const int t = t0 + 16 * w4 + 4 * fq + r; const float gate = siluf(bf2f(PROJ[(size_t)t * PROJW + gcol0 + e]));
                Y[(size_t)t * DM + ycol0 + e] = (bf16)f2bf((o[et][r] - mu[r]) * rs[r] * nw * gate); } }
        __syncthreads();
    }
}

__device__ __forceinline__ unsigned mono_key(float v) { const unsigned u = __float_as_uint(v); return u ^ ((unsigned)((int)u >> 31) | 0x80000000u); }
__device__ __forceinline__ float mono_val(unsigned k) { return __uint_as_float((k & 0x80000000u) ? (k ^ 0x80000000u) : ~k); }
#define INS16(L, x) { unsigned x_ = (x); _Pragma("unroll") for (int q_ = 0; q_ < 16; ++q_) { const unsigned hi_ = max(L[q_], x_), lo_ = min(L[q_], x_); L[q_] = hi_; x_ = lo_; } }
__device__ __forceinline__ void top16_list(const float* SC, int tok0, int X, LAS float* row, int lane, unsigned (&L)[16]) {
#pragma unroll
    for (int q = 0; q < 16; ++q) L[q] = 0u;
    for (int q = 0; q < 4; ++q) {
#pragma unroll
        for (int m = 0; m < 8; ++m) { const int li = m * 8 + (lane >> 3); const f32x4 v = *(const f32x4*)(SC + (size_t)(tok0 + (li >> 3)) * 2048 + (li & 7) * 256 + X * 128 + q * 32 + (lane & 7) * 4);
            LAS float* dst = row + li * 33 + (lane & 7) * 4; dst[0] = v[0]; dst[1] = v[1]; dst[2] = v[2]; dst[3] = v[3]; }
        asm volatile("s_waitcnt lgkmcnt(0)" ::: "memory");
#pragma unroll 4
        for (int i = 0; i < 32; ++i) { const float v = row[lane * 33 + i]; const unsigned k = (mono_key(v) & ~127u) | (unsigned)(127 - (q * 32 + i)); INS16(L, k); }
        asm volatile("s_waitcnt lgkmcnt(0)" ::: "memory");
    }
}
__device__ __forceinline__ void phase_topk(Ctx C, const Args& A) {
    PHASE_ENTER(C);
    const int lane = C.lane; const int gw = C.bid * NWAVES + C.wave, NGW = C.G * NWAVES;
    LAS float* row = (LAS float*)(C.lds + C.wave * 8448);
    const float* SC = WSP(float, WS_SC);
    for (int it = gw; it < NT / 8; it += NGW) {
        const int tok0 = it * 8, mytok = tok0 + (lane >> 3), myh = lane & 7;
        unsigned TA[16], TB[16];
        top16_list(SC, tok0, 0, row, lane, TA);
        top16_list(SC, tok0, 1, row, lane, TB);
        float sa[16], sb[16]; LAS int* irow = (LAS int*)(row + lane * 33);
#pragma unroll
        for (int i = 0; i < 16; ++i) { sa[i] = mono_val(TA[i] & ~127u); sb[i] = mono_val(TB[i] & ~127u); irow[i] = 127 - (int)(TA[i] & 127u); irow[16 + i] = 127 - (int)(TB[i] & 127u); }
        unsigned B[16];
#pragma unroll
        for (int q = 0; q < 16; ++q) B[q] = 0u;
#pragma unroll
        for (int i = 0; i < 16; ++i)
#pragma unroll
            for (int j = 0; j < 16; ++j) if ((i + 1) * (j + 1) <= 16) { const unsigned k = (mono_key(sa[i] + sb[j]) & ~255u) | (unsigned)(255 - (i * 16 + j)); INS16(B, k); }
        asm volatile("s_waitcnt lgkmcnt(0)" ::: "memory");
        const float mx = mono_val(B[0] & ~255u); float ex[16]; float zs = 0.f;
#pragma unroll
        for (int r = 0; r < 16; ++r) { ex[r] = __expf(mono_val(B[r] & ~255u) - mx); zs += ex[r]; }
        const float iz = 1.0f / zs;
        int* eo = WSP(int, WS_EID) + (size_t)mytok * 128 + myh * 16; float* go = WSP(float, WS_GATE) + (size_t)mytok * 128 + myh * 16;
#pragma unroll
        for (int r4 = 0; r4 < 4; ++r4) { int ev[4]; float gv[4];
#pragma unroll
            for (int r = 0; r < 4; ++r) { const int flat = 255 - (int)(B[r4 * 4 + r] & 255u); ev[r] = irow[flat >> 4] * 128 + irow[16 + (flat & 15)]; gv[r] = ex[r4 * 4 + r] * iz; }
            *(int4*)(eo + r4 * 4) = make_int4(ev[0], ev[1], ev[2], ev[3]); *(f32x4*)(go + r4 * 4) = (f32x4){gv[0], gv[1], gv[2], gv[3]}; }
        asm volatile("s_waitcnt lgkmcnt(0)" ::: "memory");
    }
}

__device__ __forceinline__ void phase_convert_peer(Ctx C, const Args& A, int l) {
    PHASE_ENTER(C);
    const int gt = C.bid * NTHREADS + C.tid, NGT = C.G * NTHREADS;
    const float* U = IN(I_PU) + (size_t)l * 16384 * 1024; const float* V = IN(I_PV) + (size_t)l * 16384 * 1024; const float* nw = IN(I_NFW) + l * 1024;
    for (int i = gt; i < 16384 * 128; i += NGT) {
        const f32x4 a = *(const f32x4*)(U + (size_t)i * 8), b = *(const f32x4*)(U + (size_t)i * 8 + 4); const int k = (i & 127) * 8; const f32x4 w0 = *(const f32x4*)(nw + k), w1 = *(const f32x4*)(nw + k + 4);
        *(v4u*)(WSP(bf16, WS_UT) + (size_t)i * 8) = (v4u){pk2(a[0] * w0[0], a[1] * w0[1]), pk2(a[2] * w0[2], a[3] * w0[3]), pk2(b[0] * w1[0], b[1] * w1[1]), pk2(b[2] * w1[2], b[3] * w1[3])};
        const f32x4 c = *(const f32x4*)(V + (size_t)i * 8), d = *(const f32x4*)(V + (size_t)i * 8 + 4);
        *(v4u*)(WSP(bf16, WS_VT) + (size_t)i * 8) = (v4u){pk2(c[0], c[1]), pk2(c[2], c[3]), pk2(d[0], d[1]), pk2(d[2], d[3])}; }
    const float* P = IN(I_P) + (size_t)l * NT * 256;
    for (int i = gt; i < NT * 32; i += NGT) { const f32x4 a = *(const f32x4*)(P + (size_t)i * 8), b = *(const f32x4*)(P + (size_t)i * 8 + 4);
        *(v4u*)(WSP(bf16, WS_PB) + (size_t)i * 8) = (v4u){pk2(a[0], a[1]), pk2(a[2], a[3]), pk2(b[0], b[1]), pk2(b[2], b[3])}; }
}

typedef __bf16 bf2_t __attribute__((ext_vector_type(2)));
__device__ __forceinline__ float dot2bf(unsigned a, unsigned b, float c) { return __builtin_amdgcn_fdot2_f32_bf16(__builtin_bit_cast(bf2_t, a), __builtin_bit_cast(bf2_t, b), c, false); }
__device__ __forceinline__ void phase_experts(Ctx C, const Args& A, bf16* hbout, float* ssq_out) {
    PHASE_ENTER(C);
    const int lane = C.lane; const int gw = C.bid * NWAVES + C.wave, NGW = C.G * NWAVES;
    const bf16* UT = WSP(bf16, WS_UT); const bf16* VT = WSP(bf16, WS_VT);
    for (int t = gw; t < NT; t += NGW) {
        float* hr = C.h + (size_t)t * DM;
        f32x4 x[4]; x[0] = *(const f32x4*)(hr + 8 * lane); x[1] = *(const f32x4*)(hr + 8 * lane + 4); x[2] = *(const f32x4*)(hr + 512 + 8 * lane); x[3] = *(const f32x4*)(hr + 512 + 8 * lane + 4);
        float ss = 0.f; unsigned xb[8];
#pragma unroll
        for (int j = 0; j < 4; ++j) { ss += (x[j][0] * x[j][0] + x[j][1] * x[j][1]) + (x[j][2] * x[j][2] + x[j][3] * x[j][3]); xb[2 * j] = pk2(x[j][0], x[j][1]); xb[2 * j + 1] = pk2(x[j][2], x[j][3]); }
        const float rstd = 1.0f / sqrtf(wave_sum(ss) * (1.0f / DM) + EPS);
        const int e0 = WSP(int, WS_EID)[(size_t)t * 128 + lane], e1 = WSP(int, WS_EID)[(size_t)t * 128 + 64 + lane];
        const float g0 = WSP(float, WS_GATE)[(size_t)t * 128 + lane], g1 = WSP(float, WS_GATE)[(size_t)t * 128 + 64 + lane];
        float o[16];
#pragma unroll
        for (int i = 0; i < 16; ++i) o[i] = 0.f;
#pragma unroll 1
        for (int hf = 0; hf < 2; ++hf) { const int ev = hf ? e1 : e0; const int gvb = __float_as_int(hf ? g1 : g0);
#pragma unroll 1
            for (int r0 = 0; r0 < 64; r0 += 4) {
                v4u ua[4][2], va[4][2];
#pragma unroll
                for (int q = 0; q < 4; ++q) { const int e = __builtin_amdgcn_readlane(ev, r0 + q); const v4u* ur = (const v4u*)(UT + (size_t)e * DM); const v4u* vr = (const v4u*)(VT + (size_t)e * DM);
                    ua[q][0] = ur[lane]; ua[q][1] = ur[64 + lane]; va[q][0] = vr[lane]; va[q][1] = vr[64 + lane]; }
#pragma unroll
                for (int q = 0; q < 4; ++q) { float d = 0.f;
                    d = dot2bf(ua[q][0][0], xb[0], d); d = dot2bf(ua[q][0][1], xb[1], d); d = dot2bf(ua[q][0][2], xb[2], d); d = dot2bf(ua[q][0][3], xb[3], d);
                    d = dot2bf(ua[q][1][0], xb[4], d); d = dot2bf(ua[q][1][1], xb[5], d); d = dot2bf(ua[q][1][2], xb[6], d); d = dot2bf(ua[q][1][3], xb[7], d);
                    d = wave_sum(d);
                    const float w = __int_as_float(__builtin_amdgcn_readlane(gvb, r0 + q)) * gelu1(d * rstd);
#pragma unroll
                    for (int c = 0; c < 4; ++c) { o[2 * c] += w * bflo(va[q][0][c]); o[2 * c + 1] += w * bfhi(va[q][0][c]); o[8 + 2 * c] += w * bflo(va[q][1][c]); o[8 + 2 * c + 1] += w * bfhi(va[q][1][c]); } }
            } }
        f32x4 y[4]; float s2 = 0.f;
#pragma unroll
        for (int j = 0; j < 4; ++j) { y[j] = x[j] + (f32x4){o[4 * j], o[4 * j + 1], o[4 * j + 2], o[4 * j + 3]}; s2 += (y[j][0] * y[j][0] + y[j][1] * y[j][1]) + (y[j][2] * y[j][2] + y[j][3] * y[j][3]); }
        *(f32x4*)(hr + 8 * lane) = y[0]; *(f32x4*)(hr + 8 * lane + 4) = y[1]; *(f32x4*)(hr + 512 + 8 * lane) = y[2]; *(f32x4*)(hr + 512 + 8 * lane + 4) = y[3];
        bf16* hbr = hbout + (size_t)t * DM;
        *(v4u*)(hbr + 8 * lane) = (v4u){pk2(y[0][0], y[0][1]), pk2(y[0][2], y[0][3]), pk2(y[1][0], y[1][1]), pk2(y[1][2], y[1][3])};
        *(v4u*)(hbr + 512 + 8 * lane) = (v4u){pk2(y[2][0], y[2][1]), pk2(y[2][2], y[2][3]), pk2(y[3][0], y[3][1]), pk2(y[3][2], y[3][3])};
        const float tot = wave_sum(s2);
        if (lane < 16) ssq_out[(size_t)t * 16 + lane] = lane == 0 ? tot : 0.f;
    }
}

__device__ __forceinline__ void phase_pool(Ctx C, const Args& A) {
    PHASE_ENTER(C);
    const bf16* U = WSP(bf16, WS_U); bf16* Y = WSP(bf16, WS_A1);
    const int c = C.tid, win = 2 << (c >> 7);
    for (int bn = C.bid; bn < 512; bn += C.G) {
        const int b = bn >> 7, n = bn & 127, p0 = n * 64; const bf16* ub = U + (size_t)b * SEQ * DM + c;
        float sum = 0.f;
        for (int q = (p0 - win > 0 ? p0 - win : 0); q < p0; ++q) sum += bf2f(ub[(size_t)q * DM]);
#pragma unroll 4
        for (int t = 0; t < 64; ++t) { const int pos = p0 + t; const float cur = bf2f(ub[(size_t)pos * DM]); sum += cur; if (pos - win >= 0) sum -= bf2f(ub[(size_t)(pos - win) * DM]);
            const float cnt = (float)(pos + 1 < win ? pos + 1 : win); Y[(size_t)(b * SEQ + pos) * DM + c] = (bf16)f2bf(sum / cnt - cur); }
    }
}
__device__ __forceinline__ void s5_load_consts(const Ctx& C, int g, int lane, float& abr, float& abi, float (&Br)[16], float (&Bi)[16]) {
    const float* s5 = WSP(float, WS_S5C); const int idx = g * 64 + lane;
    abr = s5[S5_ABAR / 4 + 2 * idx]; abi = s5[S5_ABAR / 4 + 2 * idx + 1];
#pragma unroll
    for (int h = 0; h < 16; ++h) { Br[h] = s5[S5_BBAR / 4 + (idx * 16 + h) * 2]; Bi[h] = s5[S5_BBAR / 4 + (idx * 16 + h) * 2 + 1]; }
}
__device__ __forceinline__ void s5_step(const bf16* up, float abr, float abi, const float (&Br)[16], const float (&Bi)[16], float& xr, float& xi) {
    const v4u u0 = *(const v4u*)up, u1 = *(const v4u*)(up + 8);
    float br = 0.f, bi = 0.f;
#pragma unroll
    for (int c = 0; c < 4; ++c) { const float a = bflo(u0[c]), b = bfhi(u0[c]), d = bflo(u1[c]), e = bfhi(u1[c]);
        br += Br[2 * c] * a; bi += Bi[2 * c] * a; br += Br[2 * c + 1] * b; bi += Bi[2 * c + 1] * b; br += Br[8 + 2 * c] * d; bi += Bi[8 + 2 * c] * d; br += Br[8 + 2 * c + 1] * e; bi += Bi[8 + 2 * c + 1] * e; }
    const float nr = abr * xr - abi * xi + br, ni = abr * xi + abi * xr + bi; xr = nr; xi = ni;
}
__device__ __forceinline__ void phase_s5_local(Ctx C, const Args& A) {
    PHASE_ENTER(C);
    const int lane = C.lane; const int gw = C.bid * NWAVES + C.wave, NGW = C.G * NWAVES;
    for (int it = gw; it < 16384; it += NGW) { const int g = it & 31, bn = it >> 5;
        float abr, abi, Br[16], Bi[16]; s5_load_consts(C, g, lane, abr, abi, Br, Bi);
        const bf16* up = WSP(bf16, WS_U) + (size_t)bn * 64 * DM + 512 + g * 16; float xr = 0.f, xi = 0.f;
#pragma unroll 4
        for (int t = 0; t < 64; ++t) s5_step(up + (size_t)t * DM, abr, abi, Br, Bi, xr, xi);
        float* e = WSP(float, WS_E) + ((size_t)(bn * 32 + g) * 64 + lane) * 2; e[0] = xr; e[1] = xi; }
}
__device__ __forceinline__ void phase_s5_carry(Ctx C, const Args& A) {
    PHASE_ENTER(C);
    for (int gid = C.bid * NTHREADS + C.tid; gid < 8192; gid += C.G * NTHREADS) { const int p = gid & 63, g = (gid >> 6) & 31, b = gid >> 11;
        const float* s5 = WSP(float, WS_S5C); const float ar = s5[S5_A64 / 4 + 2 * (g * 64 + p)], ai = s5[S5_A64 / 4 + 2 * (g * 64 + p) + 1];
        float2* e = (float2*)WSP(float, WS_E) + ((size_t)(b * 128) * 32 + g) * 64 + p; float cr = 0.f, ci = 0.f;
#pragma unroll 8
        for (int n = 0; n < NCHUNK; ++n) { const float2 tv = e[(size_t)n * 2048]; e[(size_t)n * 2048] = make_float2(cr, ci); const float nr = ar * cr - ai * ci + tv.x, ni = ar * ci + ai * cr + tv.y; cr = nr; ci = ni; } }
}
__device__ __forceinline__ void phase_s5_out(Ctx C, const Args& A) {
    PHASE_ENTER(C);
    const int lane = C.lane, fr = lane & 15, fq = lane >> 4; const int gw = C.bid * NWAVES + C.wave, NGW = C.G * NWAVES;
    LAS bf16* XL = (LAS bf16*)(C.lds + C.wave * 4352);
    for (int it = gw; it < 16384; it += NGW) { const int g = it & 31, bn = it >> 5;
        float abr, abi, Br[16], Bi[16]; s5_load_consts(C, g, lane, abr, abi, Br, Bi);
        const bf16* ub = WSP(bf16, WS_U) + (size_t)bn * 64 * DM + 512 + g * 16;
        const float* e = WSP(float, WS_E) + ((size_t)(bn * 32 + g) * 64 + lane) * 2; float xr = e[0], xi = e[1];
        bf16x8 cm[4]; const bf16* CM = (const bf16*)(C.ws + WS_S5C + S5_CM) + (size_t)(g * 16 + fr) * 128;
#pragma unroll
        for (int kk = 0; kk < 4; ++kk) cm[kk] = *(const bf16x8*)(CM + kk * 32 + 8 * fq);
        const float dsk = IN(I_DSK)[g * 16 + fr];
        for (int sub = 0; sub < 4; ++sub) {
#pragma unroll 4
            for (int tt = 0; tt < 16; ++tt) { s5_step(ub + (size_t)(sub * 16 + tt) * DM, abr, abi, Br, Bi, xr, xi); XL[tt * 136 + lane] = (bf16)f2bf(xr); XL[tt * 136 + 64 + lane] = (bf16)f2bf(xi); }
            asm volatile("s_waitcnt lgkmcnt(0)" ::: "memory");
            f32x4 acc = (f32x4){0.f, 0.f, 0.f, 0.f};
#pragma unroll
            for (int kk = 0; kk < 4; ++kk) { const bf16x8 a = *(const LAS bf16x8*)(XL + fr * 136 + kk * 32 + 8 * fq); acc = __builtin_amdgcn_mfma_f32_16x16x32_bf16(a, cm[kk], acc, 0, 0, 0); }
#pragma unroll
            for (int r = 0; r < 4; ++r) { const size_t tok = (size_t)bn * 64 + sub * 16 + 4 * fq + r; const float uv = bf2f(WSP(bf16, WS_U)[tok * DM + 512 + g * 16 + fr]);
                WSP(bf16, WS_Z)[tok * 512 + g * 16 + fr] = (bf16)f2bf(gelu1(acc[r] + dsk * uv)); }
            asm volatile("s_waitcnt lgkmcnt(0)" ::: "memory");
        } }
}
__device__ __forceinline__ void phase_final_norm(Ctx C, const Args& A) {
    PHASE_ENTER(C);
    const int lane = C.lane; const int gw = C.bid * NWAVES + C.wave, NGW = C.G * NWAVES; const f32x4* wv = (const f32x4*)IN(I_FNW) + lane;
    for (int m = gw; m < NT; m += NGW) { f32x4* xr = (f32x4*)(C.h + (size_t)m * DM) + lane; f32x4 v[4]; float s = 0.f;
#pragma unroll
        for (int j = 0; j < 4; ++j) { v[j] = xr[64 * j]; s += (v[j][0] * v[j][0] + v[j][1] * v[j][1]) + (v[j][2] * v[j][2] + v[j][3] * v[j][3]); }
        const float rs = 1.0f / sqrtf(wave_sum(s) * (1.0f / DM) + EPS);
#pragma unroll
        for (int j = 0; j < 4; ++j) xr[64 * j] = v[j] * rs * wv[64 * j]; }
}

constexpr int CW_BAR = 1024;

__global__ void __launch_bounds__(NTHREADS, 2) mk_fwd(Args A) {
    extern __shared__ __attribute__((aligned(16))) unsigned char lds_raw[];
    Ctx C;
    C.lds = (LAS unsigned char*)lds_raw; C.tid = threadIdx.x; C.lane = C.tid & 63; C.wave = __builtin_amdgcn_readfirstlane(C.tid >> 6); C.G = gridDim.x; C.bid = blockIdx.x;
    C.h = A.out; C.ws = A.ws;
    volatile LAS unsigned* MISC = (volatile LAS unsigned*)(C.lds + MISC_OFF);
    for (int u = C.tid; u < (LDS_BYTES - RING_BYTES) / 4; u += NTHREADS) ((LAS unsigned*)(C.lds + RING_BYTES))[u] = 0u;
    __syncthreads();
    if (C.tid == 0) {
#pragma unroll
        for (int i = 0; i < N_IN; ++i) ((LAS unsigned long long*)(C.lds + PTR_OFF))[i] = (unsigned long long)A.in[i];
    }
    __syncthreads();
    XcdBarrier bar = xcd_barrier_post((unsigned*)(C.ws + WS_CTL) + CW_BAR, MISC + 8);
#define GBAR() xcd_barrier(bar)
#define FRESH() do { asm volatile("" : "+s"(C.ws), "+s"(C.h)); C.ws = (unsigned char*)(GAS unsigned char*)C.ws; C.h = (float*)(GAS float*)C.h; } while (0)
#define GEMM(EpiT, E, Ap, Bp, Mv, Nv, Kv) do { pg8::Gemm g_{(const pg8::bf16_t*)(Ap), (const pg8::bf16_t*)(Bp), Mv, Nv, Kv}; pg8::StaticOrder S_; S_.init(Mv, Nv, C.G, C.bid); \
        pg8::gemm_phase<EpiT, pg8::StaticOrder, true, true>(C.lds, g_, S_, E); } while (0)
    float* SSQ0 = WSP(float, WS_SSQ0); float* SSQ1 = WSP(float, WS_SSQ1);
    bf16* A0 = WSP(bf16, WS_A0); bf16* A1 = WSP(bf16, WS_A1);

    phase_prologue(C, A);
    cg::this_grid().sync();
    FRESH(); { pg8::EpiBf16<0> E{(pg8::bf16_t*)WSP(bf16, WS_PROJ), PROJW, nullptr, 0, 0, 1.f}; GEMM(pg8::EpiBf16<0>, E, A0, WSP(bf16, WS_WIN0), NT, PROJW, DM); }
    GBAR();
    phase_kv(C, A); GBAR();
    phase_scan(C, A); GBAR();
    phase_mix0_out(C, A); GBAR();
    FRESH(); { pg8::EpiRes E{IN(I_X), C.h, (pg8::bf16_t*)A0, SSQ0}; GEMM(pg8::EpiRes, E, A1, WSP(bf16, WS_WOUT0), NT, DM, DM); }
    GBAR();
#pragma unroll
    for (int l = 0; l < 2; ++l) {
        if (l == 1) {
            FRESH(); { pg8::EpiScaleBf16 E{(pg8::bf16_t*)WSP(bf16, WS_U), DM, SSQ0}; GEMM(pg8::EpiScaleBf16, E, A0, WSP(bf16, WS_WIN1), NT, DM, DM); }
            GBAR();
            phase_s5_local(C, A); phase_pool(C, A); GBAR();
            phase_s5_carry(C, A); GBAR();
            phase_s5_out(C, A); GBAR();
            FRESH(); { pg8::EpiGlu E{(const pg8::bf16_t*)WSP(bf16, WS_Z), 512, IN(I_BGLU), (pg8::bf16_t*)A1, DM, 512}; GEMM(pg8::EpiGlu, E, WSP(bf16, WS_Z), WSP(bf16, WS_WGLU), NT, 512, 512); }
            GBAR();
            FRESH(); { pg8::EpiRes E{C.h, C.h, (pg8::bf16_t*)A0, SSQ0}; GEMM(pg8::EpiRes, E, A1, WSP(bf16, WS_WOUT1), NT, DM, DM); }
            GBAR();
        }
        FRESH(); { pg8::EpiScaleF32 E{WSP(float, WS_SC), 2048, SSQ0}; GEMM(pg8::EpiScaleF32, E, A0, WSP(bf16, WS_WEFF) + (size_t)l * 2048 * 1024, NT, 2048, DM); }
        GBAR();
        phase_topk(C, A); GBAR();
        phase_convert_peer(C, A, l); GBAR();
        phase_experts(C, A, A1, SSQ1);
        FRESH(); { pg8::EpiBf16<0> E{(pg8::bf16_t*)WSP(bf16, WS_PP), DM, nullptr, 0, 0, 1.f}; GEMM(pg8::EpiBf16<0>, E, WSP(bf16, WS_PB), WSP(bf16, WS_WP) + (size_t)l * 1024 * 256, NT, DM, 256); }
        GBAR();
        FRESH(); { pg8::EpiPle E{C.h, (const pg8::bf16_t*)WSP(bf16, WS_PP), (pg8::bf16_t*)A0, SSQ1, SSQ0}; GEMM(pg8::EpiPle, E, A1, WSP(bf16, WS_WG) + (size_t)l * 1024 * 1024, NT, DM, DM); }
        GBAR();
    }
    phase_final_norm(C, A);
}

extern "C" void kernel_launch(void* const* d_in, const int* in_sizes, int n_in, void* d_out, int out_size, void* d_ws, size_t ws_size, hipStream_t stream) {
    static int grid = 0;
    if (grid == 0) {
        if (n_in != N_IN || out_size != NT * DM || ws_size < WS_END) { fprintf(stderr, "kernel_launch: unexpected shapes (n_in %d, out %d, ws %zu, need %zu)\n", n_in, out_size, ws_size, (size_t)WS_END); grid = -1; return; }
        int dev = 0, cus = 0, per_cu = 0;
        if (hipGetDevice(&dev) != hipSuccess || hipDeviceGetAttribute(&cus, hipDeviceAttributeMultiprocessorCount, dev) != hipSuccess) { grid = -1; return; }
        if (hipFuncSetAttribute((const void*)mk_fwd, hipFuncAttributeMaxDynamicSharedMemorySize, LDS_BYTES) != hipSuccess) { fprintf(stderr, "kernel_launch: hipFuncSetAttribute failed\n"); grid = -1; return; }
        if (hipOccupancyMaxActiveBlocksPerMultiprocessor(&per_cu, (const void*)mk_fwd, NTHREADS, LDS_BYTES) != hipSuccess || per_cu < 1) { fprintf(stderr, "kernel_launch: occupancy query says %d blocks per CU\n", per_cu); grid = -1; return; }
        grid = cus;
    }
    if (grid < 0) return;
    if (hipMemsetAsync((char*)d_ws + WS_CTL, 0, CTL_ZERO_BYTES, stream) != hipSuccess) return;
    Args a{};
    for (int i = 0; i < N_IN; ++i) a.in[i] = d_in[i];
    a.out = (float*)d_out; a.ws = (unsigned char*)d_ws;
    void* kargs[] = {&a};
    const hipError_t le = hipLaunchCooperativeKernel((const void*)mk_fwd, dim3(grid), dim3(NTHREADS), kargs, LDS_BYTES, stream);
    if (le != hipSuccess) fprintf(stderr, "kernel_launch: cooperative launch failed: %s (grid %d)\n", hipGetErrorString(le), grid);
}
```

```cpp
#include <hip/hip_runtime.h>
#include <hip/hip_cooperative_groups.h>
#include <cstdio>
#include <cstdint>
namespace cg = cooperative_groups;
namespace pg8 {
#define PG8_LAS __attribute__((address_space(3)))
typedef unsigned short bf16_t;
typedef short bf16x8 __attribute__((ext_vector_type(8)));
typedef float f32x4 __attribute__((ext_vector_type(4)));
typedef unsigned u32x4 __attribute__((ext_vector_type(4)));
constexpr int BM = 256, BK = 64, HALF = 128, HTB = HALF * BK * 2  , STAGE_BYTES = 8 * HTB, NXCD = 8, WGM = 8;

__host__ __device__ __forceinline__ int lds_byte(int r, int c) { const int st = (r >> 4) * 2 + (c >> 5), rr = r & 15, cc = c & 31, ob = rr * 64 + cc * 2; return st * 1024 + (ob ^ (((ob >> 9) & 1) << 5)); }
__host__ __device__ __forceinline__ void stage_rc(int b, int& R, int& C) { const int st = b / 1024, sb = b % 1024, swz = sb ^ (((sb >> 9) & 1) << 5); R = (st >> 1) * 16 + swz / 64; C = (st & 1) * 32 + (swz % 64) / 2; }
__host__ __device__ __forceinline__ int perm32(int rho) { const int n = rho >> 4, i = rho & 15; return 8 * (i >> 2) + 4 * n + (i & 3); }

struct Unit { int pm, pn; };
struct Gemm { const bf16_t* A; const bf16_t* Bt; int M, N, K; };

struct StaticOrder {
    int nM, nN, nwg, G, c;
    __host__ __device__ void init(int M, int N, int G_, int c_) { nM = M / BM; nN = N / BM; nwg = nM * nN; G = G_; c = c_; }
    __host__ __device__ bool next(int i, Unit& u) const {
        const long L = (long)i * G + c; if (L >= nwg) return false;
        int wgid = (int)L; { const int q = nwg / NXCD, r = nwg % NXCD, xcd = wgid % NXCD, off = wgid / NXCD; wgid = (xcd < r ? xcd * (q + 1) : r * (q + 1) + (xcd - r) * q) + off; }
        const int nig = WGM * nN, gid = wgid / nig, fm = gid * WGM, gsz = (nM - fm) < WGM ? (nM - fm) : WGM;
        u.pm = fm + ((wgid % nig) % gsz); u.pn = (wgid % nig) / gsz; return true;
    }
    __device__ __forceinline__ void a_ready(const Unit&) const {}
    __device__ __forceinline__ void done(const Unit&) const {}
};

__device__ __forceinline__ unsigned cvt_pk_bf16(float lo, float hi) { unsigned r; asm volatile("v_cvt_pk_bf16_f32 %0, %1, %2" : "=v"(r) : "v"(lo), "v"(hi)); return r; }
typedef float f32x2 __attribute__((ext_vector_type(2)));
__device__ __forceinline__ f32x2 gelu_pk(f32x2 v) {
    const f32x2 av = __builtin_elementwise_abs(v), d = av * 0.2316418882f + 1.0f;
    f32x2 t; t.x = __builtin_amdgcn_rcpf(d.x); t.y = __builtin_amdgcn_rcpf(d.y);
    f32x2 q = t * 0.5307027145f + (-0.7265760135f); q = q * t + 0.7107068705f; q = q * t + (-0.142248368f); q = q * t + 0.127414796f; q = q * t;
    const f32x2 s = (v * v) * (-0.72134752044f);
    f32x2 e; e.x = __builtin_amdgcn_exp2f(s.x); e.y = __builtin_amdgcn_exp2f(s.y);
    const f32x2 m = v * (q * e), r = v - m;
    f32x2 o; o.x = v.x < 0.f ? m.x : r.x; o.y = v.y < 0.f ? m.y : r.y; return o;
}

template <int ACT  > struct EpiBf16 {
    static constexpr bool PERM = true, AFTER_DRAIN = false; static_assert(ACT == 0 || ACT == 1, "EpiBf16: ACT is 0 (none) or 1 (gelu_pk)");
    bf16_t* O; int ldc; const float* bias; int split_cols; size_t split_stride; float scale0;
    __device__ __forceinline__ void operator()(const f32x4 (&acc)[2][2][4][2], const Unit& u, int wr, int wc, int fr, int fq) const {
        const int row0 = u.pm * BM + wr * 64 + fr; int colt = u.pn * BM; bf16_t* base = O;
        float sc = 1.f; if (split_cols) { const int t = colt / split_cols; base += (size_t)t * split_stride; colt -= t * split_cols; if (t == 0) sc = scale0; }
        const int col0 = colt + wc * 32 + 8 * fq, bcol0 = u.pn * BM + wc * 32 + 8 * fq;
        f32x4 bv[2][2];
#pragma unroll
        for (int bj = 0; bj < 2; ++bj)
#pragma unroll
            for (int n = 0; n < 2; ++n) bv[bj][n] = bias ? *(const f32x4*)(bias + bcol0 + bj * HALF + 4 * n) : (f32x4){0.f, 0.f, 0.f, 0.f};
#pragma unroll
        for (int ai = 0; ai < 2; ++ai)
#pragma unroll
            for (int m = 0; m < 4; ++m) { bf16_t* rowp = base + (size_t)(row0 + ai * HALF + m * 16) * ldc + col0;
#pragma unroll
                for (int bj = 0; bj < 2; ++bj) { f32x4 v0 = acc[ai][bj][m][0] + bv[bj][0], v1 = acc[ai][bj][m][1] + bv[bj][1];
                    if (ACT == 1) { f32x2 a = gelu_pk((f32x2){v0[0], v0[1]}), b = gelu_pk((f32x2){v0[2], v0[3]}), c = gelu_pk((f32x2){v1[0], v1[1]}), d = gelu_pk((f32x2){v1[2], v1[3]});
                        v0 = (f32x4){a.x, a.y, b.x, b.y}; v1 = (f32x4){c.x, c.y, d.x, d.y}; }
                    v0 = v0 * sc; v1 = v1 * sc; u32x4 w; w.x = cvt_pk_bf16(v0[0], v0[1]); w.y = cvt_pk_bf16(v0[2], v0[3]); w.z = cvt_pk_bf16(v1[0], v1[1]); w.w = cvt_pk_bf16(v1[2], v1[3]);
                    *(u32x4*)(rowp + bj * HALF) = w; } }
    }
};

__device__ __forceinline__ float row_rstd(const float* ssq, int row) {
    const f32x4* p = (const f32x4*)(ssq + (size_t)row * 16);
    const f32x4 a = p[0], b = p[1], c = p[2], d = p[3];
    const float s = (((a[0] + a[1]) + (a[2] + a[3])) + ((b[0] + b[1]) + (b[2] + b[3]))) + (((c[0] + c[1]) + (c[2] + c[3])) + ((d[0] + d[1]) + (d[2] + d[3])));
    return 1.0f / sqrtf(s * (1.0f / 1024.0f) + 1e-6f);
}
__device__ __forceinline__ float sigmoidf_(float x) { return __builtin_amdgcn_rcpf(1.0f + __expf(-x)); }
typedef unsigned u32x2 __attribute__((ext_vector_type(2)));

struct EpiRes {
    static constexpr bool PERM = false, AFTER_DRAIN = false;
    const float* base32; const bf16_t* base16; bf16_t* hb; float* ssq; unsigned char* xq8;
    __device__ __forceinline__ void operator()(const f32x4 (&acc)[2][2][4][2], const Unit& u, int wr, int wc, int fr, int fq) const {
        const int row0 = u.pm * BM + wr * 64 + fr, col0 = u.pn * BM + wc * 32 + 4 * fq;
#pragma unroll
        for (int ai = 0; ai < 2; ++ai)
#pragma unroll
            for (int m = 0; m < 4; ++m) { const int row = row0 + ai * HALF + m * 16; const size_t off = (size_t)row * 1024 + col0; float ss = 0.f;
#pragma unroll
                for (int bj = 0; bj < 2; ++bj)
#pragma unroll
                    for (int n = 0; n < 2; ++n) { const size_t o2 = off + bj * HALF + n * 16; f32x4 b;
                        if (base32) b = *(const f32x4*)(base32 + o2);
                        else { const u32x2 bw = *(const u32x2*)(base16 + o2); b = (f32x4){__uint_as_float(bw.x << 16), __uint_as_float(bw.x & 0xffff0000u), __uint_as_float(bw.y << 16), __uint_as_float(bw.y & 0xffff0000u)}; }
                        const f32x4 o = b + acc[ai][bj][m][n];
                        ss += (o[0] * o[0] + o[1] * o[1]) + (o[2] * o[2] + o[3] * o[3]);
                        u32x2 w; w.x = cvt_pk_bf16(o[0], o[1]); w.y = cvt_pk_bf16(o[2], o[3]); *(u32x2*)(hb + o2) = w;
                        int w8 = __builtin_amdgcn_cvt_pk_fp8_f32(o[0], o[1], 0, false); w8 = __builtin_amdgcn_cvt_pk_fp8_f32(o[2], o[3], w8, true); *(unsigned*)(xq8 + o2) = (unsigned)w8; }
                ss += __shfl_xor(ss, 16); ss += __shfl_xor(ss, 32);
                if (fq == 0) ssq[(size_t)row * 16 + u.pn * 4 + wc] = ss; }
    }
};
struct EpiScaleF32 {
    static constexpr bool PERM = false, AFTER_DRAIN = false;
    float* C; int ldc; const float* ssq;
    __device__ __forceinline__ void operator()(const f32x4 (&acc)[2][2][4][2], const Unit& u, int wr, int wc, int fr, int fq) const {
        const int row0 = u.pm * BM + wr * 64 + fr, col0 = u.pn * BM + wc * 32 + 4 * fq;
#pragma unroll
        for (int ai = 0; ai < 2; ++ai)
#pragma unroll
            for (int m = 0; m < 4; ++m) { const int row = row0 + ai * HALF + m * 16; const float rs = row_rstd(ssq, row); float* rowp = C + (size_t)row * ldc + col0;
#pragma unroll
                for (int bj = 0; bj < 2; ++bj)
#pragma unroll
                    for (int n = 0; n < 2; ++n) *(f32x4*)(rowp + bj * HALF + n * 16) = acc[ai][bj][m][n] * rs; }
    }
};
struct EpiScaleBf16 {
    static constexpr bool PERM = false, AFTER_DRAIN = false;
    bf16_t* O; int ldc; const float* ssq;
    __device__ __forceinline__ void operator()(const f32x4 (&acc)[2][2][4][2], const Unit& u, int wr, int wc, int fr, int fq) const {
        const int row0 = u.pm * BM + wr * 64 + fr, col0 = u.pn * BM + wc * 32 + 4 * fq;
#pragma unroll
        for (int ai = 0; ai < 2; ++ai)
#pragma unroll
            for (int m = 0; m < 4; ++m) { const int row = row0 + ai * HALF + m * 16; const float rs = row_rstd(ssq, row); bf16_t* rowp = O + (size_t)row * ldc + col0;
#pragma unroll
                for (int bj = 0; bj < 2; ++bj)
#pragma unroll
                    for (int n = 0; n < 2; ++n) { const f32x4 o = acc[ai][bj][m][n] * rs; u32x2 w; w.x = cvt_pk_bf16(o[0], o[1]); w.y = cvt_pk_bf16(o[2], o[3]); *(u32x2*)(rowp + bj * HALF + n * 16) = w; } }
    }
};
struct EpiScoreT {
    static constexpr bool PERM = false, AFTER_DRAIN = false;
    bf16_t* O; const float* ssq;
    __device__ __forceinline__ void operator()(const f32x4 (&acc)[2][2][4][2], const Unit& u, int wr, int wc, int fr, int fq) const {
        const int row0 = u.pm * BM + wr * 64 + fr, h = u.pn;
#pragma unroll
        for (int ai = 0; ai < 2; ++ai)
#pragma unroll
            for (int m = 0; m < 4; ++m) { const int row = row0 + ai * HALF + m * 16; const float rs = row_rstd(ssq, row);
#pragma unroll
                for (int bj = 0; bj < 2; ++bj)
#pragma unroll
                    for (int n = 0; n < 2; ++n) { const f32x4 o = acc[ai][bj][m][n] * rs; u32x2 w; w.x = cvt_pk_bf16(o[0], o[1]); w.y = cvt_pk_bf16(o[2], o[3]);
                        const size_t e = ((((size_t)(row >> 3) * 2 + bj) * 8 + (2 * wc + n)) * 64 + ((row & 7) * 8 + h)) * 16 + 4 * fq;
                        *(u32x2*)(O + e) = w; } }
    }
};
struct EpiPle {
    static constexpr bool PERM = false, AFTER_DRAIN = false;
    const bf16_t* hin; const bf16_t* pp; bf16_t* hb; const float* ssq_in; float* ssq_out;
    __device__ __forceinline__ void operator()(const f32x4 (&acc)[2][2][4][2], const Unit& u, int wr, int wc, int fr, int fq) const {
        const int row0 = u.pm * BM + wr * 64 + fr, col0 = u.pn * BM + wc * 32 + 4 * fq;
#pragma unroll
        for (int ai = 0; ai < 2; ++ai)
#pragma unroll
            for (int m = 0; m < 4; ++m) { const int row = row0 + ai * HALF + m * 16; const float rs = row_rstd(ssq_in, row); const size_t off = (size_t)row * 1024 + col0; float ss = 0.f;
#pragma unroll
                for (int bj = 0; bj < 2; ++bj)
#pragma unroll
                    for (int n = 0; n < 2; ++n) { const size_t o2 = off + bj * HALF + n * 16; const f32x4 a = acc[ai][bj][m][n] * rs; const u32x2 pw = *(const u32x2*)(pp + o2); const u32x2 hw = *(const u32x2*)(hin + o2);
                        f32x4 o;
                        o[0] = __uint_as_float(hw.x << 16) + __uint_as_float(pw.x << 16) * sigmoidf_(a[0]); o[1] = __uint_as_float(hw.x & 0xffff0000u) + __uint_as_float(pw.x & 0xffff0000u) * sigmoidf_(a[1]);
                        o[2] = __uint_as_float(hw.y << 16) + __uint_as_float(pw.y << 16) * sigmoidf_(a[2]); o[3] = __uint_as_float(hw.y & 0xffff0000u) + __uint_as_float(pw.y & 0xffff0000u) * sigmoidf_(a[3]);
                        ss += (o[0] * o[0] + o[1] * o[1]) + (o[2] * o[2] + o[3] * o[3]);
                        u32x2 w; w.x = cvt_pk_bf16(o[0], o[1]); w.y = cvt_pk_bf16(o[2], o[3]); *(u32x2*)(hb + o2) = w; }
                ss += __shfl_xor(ss, 16); ss += __shfl_xor(ss, 32);
                if (fq == 0) ssq_out[(size_t)row * 16 + u.pn * 4 + wc] = ss; }
    }
};
struct EpiGlu {
    static constexpr bool PERM = false, AFTER_DRAIN = false;
    const bf16_t* Z; int ldz; const float* bias; bf16_t* O; int ldo; int ocol0;
    __device__ __forceinline__ void operator()(const f32x4 (&acc)[2][2][4][2], const Unit& u, int wr, int wc, int fr, int fq) const {
        const int row0 = u.pm * BM + wr * 64 + fr, col0 = u.pn * BM + wc * 32 + 4 * fq;
        f32x4 bv[2][2];
#pragma unroll
        for (int bj = 0; bj < 2; ++bj)
#pragma unroll
            for (int n = 0; n < 2; ++n) bv[bj][n] = *(const f32x4*)(bias + col0 + bj * HALF + n * 16);
#pragma unroll
        for (int ai = 0; ai < 2; ++ai)
#pragma unroll
            for (int m = 0; m < 4; ++m) { const int row = row0 + ai * HALF + m * 16;
#pragma unroll
                for (int bj = 0; bj < 2; ++bj)
#pragma unroll
                    for (int n = 0; n < 2; ++n) { const int col = col0 + bj * HALF + n * 16; const f32x4 a = acc[ai][bj][m][n] + bv[bj][n]; const u32x2 zw = *(const u32x2*)(Z + (size_t)row * ldz + col);
                        const float o0 = __uint_as_float(zw.x << 16) * sigmoidf_(a[0]), o1 = __uint_as_float(zw.x & 0xffff0000u) * sigmoidf_(a[1]);
                        const float o2 = __uint_as_float(zw.y << 16) * sigmoidf_(a[2]), o3 = __uint_as_float(zw.y & 0xffff0000u) * sigmoidf_(a[3]);
                        u32x2 w; w.x = cvt_pk_bf16(o0, o1); w.y = cvt_pk_bf16(o2, o3); *(u32x2*)(O + (size_t)row * ldo + ocol0 + col) = w; } }
    }
};
template <class Epi, class Sched, bool ALIGN_EPI = false, bool SP2 = false>
__device__ __forceinline__ void gemm_phase(PG8_LAS unsigned char* lds, const Gemm g, const Sched& S, const Epi& E) {
    int tid_o = threadIdx.x; asm volatile("" : "+v"(tid_o));
    const int tid = tid_o, wid = __builtin_amdgcn_readfirstlane(tid >> 6), lane = tid & 63, wr = wid >> 2, wc = wid & 3, fr = lane & 15, fq = lane >> 4;
    const int K = g.K, nt = K / BK;
    unsigned voffA[2], voffB[2];
#pragma unroll
    for (int i = 0; i < 2; ++i) { int R, C; stage_rc(tid * 16 + i * 8192, R, C); const int Rb = Epi::PERM ? ((R & ~31) + perm32(R & 31)) : R;
        voffA[i] = (unsigned)(R * K + C) * 2u; voffB[i] = (unsigned)(Rb * K + C) * 2u; }
    const size_t kstep = (size_t)(BK * 2);
    const size_t hstep = (size_t)HALF * K * 2;
    const size_t tstep = 2 * hstep;
    const unsigned ldsw = (unsigned)wid * 1024u;
    const int aoff = lds_byte(wr * 64 + fr, fq * 8), boff = lds_byte(wc * 32 + fr, fq * 8);
#define PG8_SA(b, h) (((b) * 2 + (h)) * HTB)
#define PG8_SB(b, h) ((4 + (b) * 2 + (h)) * HTB)
#define PG8_STAGE(bufoff, gbase, voff) do { _Pragma("unroll") for (int _i = 0; _i < 2; ++_i) \
        __builtin_amdgcn_global_load_lds((const unsigned*)((const char*)(gbase) + (voff)[_i]), (PG8_LAS unsigned*)(lds + (bufoff) + ldsw + _i * 8192), 16, 0, 0); } while (0)
#define PG8_LDA(dst, b, h) do { _Pragma("unroll") for (int m = 0; m < 4; ++m) _Pragma("unroll") for (int k = 0; k < 2; ++k) dst[m][k] = *(const PG8_LAS bf16x8*)(lds + PG8_SA(b, h) + aoff + m * 2048 + k * 1024); } while (0)
#define PG8_LDB(dst, b, h) do { _Pragma("unroll") for (int n = 0; n < 2; ++n) _Pragma("unroll") for (int k = 0; k < 2; ++k) dst[n][k] = *(const PG8_LAS bf16x8*)(lds + PG8_SB(b, h) + boff + n * 2048 + k * 1024); } while (0)
#define PG8_MMA(ai, bj, At, Bt) do { __builtin_amdgcn_s_setprio(1); _Pragma("unroll") for (int m = 0; m < 4; ++m) _Pragma("unroll") for (int n = 0; n < 2; ++n) _Pragma("unroll") for (int k = 0; k < 2; ++k) \
        acc[ai][bj][m][n] = __builtin_amdgcn_mfma_f32_16x16x32_bf16(Bt[n][k], At[m][k], acc[ai][bj][m][n], 0, 0, 0); __builtin_amdgcn_s_setprio(0); } while (0)
#define PG8_WAIT_V(n) asm volatile("s_waitcnt vmcnt(" #n ")" ::: "memory")
#define PG8_WAIT_L(n) asm volatile("s_waitcnt lgkmcnt(" #n ")" ::: "memory")
#define PG8_BAR __builtin_amdgcn_s_barrier()
#define PG8_SCHED __builtin_amdgcn_sched_barrier(0)
    Unit cur, nxt; int ui = 0;
    if (!S.next(0, cur)) return;
    f32x4 acc[2][2][4][2];
#pragma unroll
    for (int a = 0; a < 2; ++a)
#pragma unroll
        for (int b = 0; b < 2; ++b)
#pragma unroll
            for (int m = 0; m < 4; ++m)
#pragma unroll
                for (int n = 0; n < 2; ++n) acc[a][b][m][n] = (f32x4){0.f, 0.f, 0.f, 0.f};
    bf16x8 At[4][2], B0[2][2], B1[2][2];
    const char* cA = (const char*)g.A + (size_t)cur.pm * tstep; const char* cB = (const char*)g.Bt + (size_t)cur.pn * tstep;
    S.a_ready(cur);
    if constexpr (SP2) {
        PG8_STAGE(PG8_SB(0, 0), cB, voffB); PG8_STAGE(PG8_SB(0, 1), cB + hstep, voffB); PG8_STAGE(PG8_SA(0, 0), cA, voffA); PG8_STAGE(PG8_SA(0, 1), cA + hstep, voffA);
        if (wr == 1) PG8_BAR;
        PG8_WAIT_V(2); PG8_BAR;
        PG8_STAGE(PG8_SB(1, 0), cB + kstep, voffB); PG8_STAGE(PG8_SA(1, 0), cA + kstep, voffA); PG8_STAGE(PG8_SB(1, 1), cB + hstep + kstep, voffB);
        PG8_WAIT_V(6); PG8_BAR;
    } else {
        PG8_STAGE(PG8_SB(0, 0), cB, voffB); PG8_STAGE(PG8_SA(0, 0), cA, voffA); PG8_STAGE(PG8_SB(0, 1), cB + hstep, voffB); PG8_STAGE(PG8_SA(0, 1), cA + hstep, voffA);
        if (wr == 1) PG8_BAR;
        PG8_WAIT_V(4); PG8_BAR;
        PG8_STAGE(PG8_SB(1, 0), cB + kstep, voffB); PG8_STAGE(PG8_SA(1, 0), cA + kstep, voffA); PG8_STAGE(PG8_SB(1, 1), cB + hstep + kstep, voffB);
        PG8_WAIT_V(6); PG8_BAR;
    }
    for (;;) {
        const bool has_next = S.next(ui + 1, nxt);
        const char* nA = has_next ? (const char*)g.A + (size_t)nxt.pm * tstep : cA; const char* nB = has_next ? (const char*)g.Bt + (size_t)nxt.pn * tstep : cB;
        for (int t = 0; t < nt; t += 2) {
            const bool last = (t == nt - 2);
            const char* a1 = cA + (size_t)(t + 1) * kstep;
            const char* a2 = last ? nA : cA + (size_t)(t + 2) * kstep; const char* b2 = last ? nB : cB + (size_t)(t + 2) * kstep;
            const char* a3 = a2 + kstep; const char* b3 = b2 + kstep;
            if (last && has_next) S.a_ready(nxt);
            if constexpr (SP2) {
            PG8_LDB(B0, 0, 0); PG8_LDB(B1, 0, 1); PG8_SCHED; PG8_LDA(At, 0, 0); PG8_STAGE(PG8_SA(1, 1), a1 + hstep, voffA);
            PG8_WAIT_V(8); PG8_WAIT_L(0); PG8_BAR; PG8_MMA(0, 0, At, B0); PG8_MMA(0, 1, At, B1); PG8_BAR; PG8_SCHED;
            PG8_LDA(At, 0, 1); PG8_STAGE(PG8_SB(0, 0), b2, voffB); PG8_STAGE(PG8_SB(0, 1), b2 + hstep, voffB); PG8_STAGE(PG8_SA(0, 0), a2, voffA);
            PG8_WAIT_V(8); PG8_WAIT_L(0); PG8_BAR; PG8_MMA(1, 0, At, B0); PG8_MMA(1, 1, At, B1); PG8_BAR; PG8_SCHED;
            PG8_LDB(B0, 1, 0); PG8_LDB(B1, 1, 1); PG8_SCHED; PG8_LDA(At, 1, 0); PG8_STAGE(PG8_SA(0, 1), a2 + hstep, voffA);
            PG8_WAIT_V(8); PG8_WAIT_L(0); PG8_BAR; PG8_MMA(0, 0, At, B0); PG8_MMA(0, 1, At, B1); PG8_BAR; PG8_SCHED;
            PG8_LDA(At, 1, 1); PG8_STAGE(PG8_SB(1, 0), b3, voffB); PG8_STAGE(PG8_SB(1, 1), b3 + hstep, voffB); PG8_STAGE(PG8_SA(1, 0), a3, voffA);
            PG8_WAIT_V(8); PG8_WAIT_L(0); PG8_BAR; PG8_MMA(1, 0, At, B0); PG8_MMA(1, 1, At, B1); PG8_BAR; PG8_SCHED;
            } else {
            PG8_LDB(B0, 0, 0); PG8_SCHED; PG8_LDA(At, 0, 0); PG8_STAGE(PG8_SA(1, 1), a1 + hstep, voffA);
            PG8_WAIT_L(8); PG8_BAR; PG8_WAIT_L(0); PG8_MMA(0, 0, At, B0); PG8_BAR; PG8_SCHED;
            PG8_LDB(B1, 0, 1); PG8_STAGE(PG8_SB(0, 0), b2, voffB);
            PG8_BAR; PG8_WAIT_L(0); PG8_MMA(0, 1, At, B1); PG8_BAR;
            PG8_LDA(At, 0, 1); PG8_STAGE(PG8_SA(0, 0), a2, voffA);
            PG8_BAR; PG8_WAIT_L(0); PG8_MMA(1, 0, At, B0); PG8_BAR; PG8_SCHED;
            PG8_STAGE(PG8_SB(0, 1), b2 + hstep, voffB);
            PG8_WAIT_V(6); PG8_BAR; PG8_MMA(1, 1, At, B1); PG8_BAR;
            PG8_LDB(B0, 1, 0); PG8_SCHED; PG8_LDA(At, 1, 0); PG8_STAGE(PG8_SA(0, 1), a2 + hstep, voffA);
            PG8_WAIT_L(8); PG8_BAR; PG8_WAIT_L(0); PG8_MMA(0, 0, At, B0); PG8_BAR; PG8_SCHED;
            PG8_LDB(B1, 1, 1); PG8_STAGE(PG8_SB(1, 0), b3, voffB);
            PG8_BAR; PG8_WAIT_L(0); PG8_MMA(0, 1, At, B1); PG8_BAR;
            PG8_LDA(At, 1, 1); PG8_STAGE(PG8_SA(1, 0), a3, voffA);
            PG8_BAR; PG8_WAIT_L(0); PG8_MMA(1, 0, At, B0); PG8_BAR; PG8_SCHED;
            PG8_STAGE(PG8_SB(1, 1), b3 + hstep, voffB);
            PG8_WAIT_V(6); PG8_BAR; PG8_MMA(1, 1, At, B1); PG8_BAR;
            }
        }
        if constexpr (ALIGN_EPI) { if (wr == 0) PG8_BAR; }
        if constexpr (!Epi::AFTER_DRAIN) { E(acc, cur, wr, wc, fr, fq); S.done(cur); }
        if (!has_next) break;
#pragma unroll
        for (int a = 0; a < 2; ++a)
#pragma unroll
            for (int b = 0; b < 2; ++b)
#pragma unroll
                for (int m = 0; m < 4; ++m)
#pragma unroll
                    for (int n = 0; n < 2; ++n) acc[a][b][m][n] = (f32x4){0.f, 0.f, 0.f, 0.f};
        cur = nxt; cA = nA; cB = nB; ++ui;
        if constexpr (ALIGN_EPI) { if (wr == 1) PG8_BAR; }
    }
    PG8_WAIT_V(0);
    if constexpr (!ALIGN_EPI) { if (wr == 0) PG8_BAR; }
    PG8_BAR;
    if constexpr (Epi::AFTER_DRAIN) { E.fused(acc, cur, wr, wc, fr, fq, lds, wid, lane); S.done(cur); }
#undef PG8_SA
#undef PG8_SB
#undef PG8_STAGE
#undef PG8_LDA
#undef PG8_LDB
#undef PG8_MMA
#undef PG8_WAIT_V
#undef PG8_WAIT_L
#undef PG8_BAR
#undef PG8_SCHED
}
}
#define GAS __attribute__((address_space(1)))
#define LAS __attribute__((address_space(3)))
typedef unsigned short bf16;
typedef unsigned v4u __attribute__((ext_vector_type(4)));
typedef float f32x4 __attribute__((ext_vector_type(4)));
typedef short bf16x8 __attribute__((ext_vector_type(8)));
typedef GAS unsigned gu32;
typedef GAS unsigned long long gu64;
#define RLX_AGENT __ATOMIC_RELAXED, __HIP_MEMORY_SCOPE_AGENT
#define LDS_WAIT() asm volatile("s_waitcnt lgkmcnt(0)" ::: "memory")
#define VM_WAIT() asm volatile("s_waitcnt vmcnt(0)" ::: "memory")
__device__ __forceinline__ unsigned long long rt() { return __builtin_amdgcn_s_memrealtime(); }
__device__ __forceinline__ unsigned f2bf(float f) { unsigned u = __builtin_bit_cast(unsigned, f); return (u + 0x7fffu + ((u >> 16) & 1u)) >> 16; }
__device__ __forceinline__ unsigned pk2(float lo, float hi) { return f2bf(lo) | (f2bf(hi) << 16); }
#define XB_TMO      128
#define XB_XCNT(j)  (256  + 64 * (j))
#define XB_XSUB(j)  (1280 + 64 * (j))
#define XB_XGEN(j)  (2304 + 64 * (j))
#define XB_TOP      3328
#define XB_TOPGEN   3392
#define XCD_BAR_WORDS 3456
#define XB_SPIN_CAP (1u << 18)

__device__ __forceinline__ unsigned xb_ld(unsigned* p)              { return __hip_atomic_load(p, __ATOMIC_RELAXED, __HIP_MEMORY_SCOPE_AGENT); }
__device__ __forceinline__ unsigned xb_add(unsigned* p, unsigned v) { return __hip_atomic_fetch_add(p, v, __ATOMIC_RELAXED, __HIP_MEMORY_SCOPE_AGENT); }
__device__ __forceinline__ unsigned xb_xcc_id() { return (unsigned)__builtin_amdgcn_s_getreg((3 << 11) | 20) & 0xFu; }
#define XB_SPIN(cond, bar) do { unsigned _sp = 0; while (cond) { __builtin_amdgcn_s_sleep(1); \
    if ((++_sp & 255u) == 0u) { if (xb_ld(&(bar)[XB_TMO])) break; if (_sp > XB_SPIN_CAP) { atomicAdd(&(bar)[XB_TMO], 1u); break; } } } } while (0)

struct XcdBarrier {
    unsigned* bar; unsigned x;
    volatile LAS unsigned* st;
};

__device__ __forceinline__ XcdBarrier xcd_barrier_post(unsigned* bar, volatile LAS unsigned* st) {
    XcdBarrier b; b.bar = bar; b.x = xb_xcc_id(); b.st = st;
    if (threadIdx.x == 0) (void)xb_add(&bar[XB_XCNT(b.x)], 1u);
    return b;
}
__device__ __forceinline__ void xcd_barrier_complete(unsigned* bar, unsigned x, unsigned& nloc, unsigned& nx) {
    const unsigned G = gridDim.x * gridDim.y * gridDim.z;
    unsigned sum, cnt, mine, sp = 0u;
    for (;;) {
        sum = 0u; cnt = 0u; mine = 0u;
#pragma unroll
        for (unsigned j = 0; j < 16; ++j) { const unsigned c = xb_ld(&bar[XB_XCNT(j)]); sum += c; cnt += (c > 0u) ? 1u : 0u; mine = (j == x) ? c : mine; }
        if (sum == G) break;
        __builtin_amdgcn_s_sleep(1);
        if ((++sp & 255u) == 0u) { if (xb_ld(&bar[XB_TMO])) break; if (sp > XB_SPIN_CAP) { atomicAdd(&bar[XB_TMO], 1u); break; } }
    }
    nloc = mine > 0u ? mine : 1u; nx = cnt > 0u ? cnt : 1u;
}

__device__ __forceinline__ void xcd_barrier(const XcdBarrier& b) {
    asm volatile("s_waitcnt vmcnt(0)" ::: "memory");
    __syncthreads();
    if (threadIdx.x == 0) {
        unsigned* bar = b.bar;
        __builtin_amdgcn_s_waitcnt(0);
        unsigned nloc = b.st[0], nx = b.st[1];
        if (nloc == 0u) { xcd_barrier_complete(bar, b.x, nloc, nx); b.st[0] = nloc; b.st[1] = nx; }
        const unsigned old = xb_add(&bar[XB_XSUB(b.x)], 1u);
        const unsigned gen = old / nloc;
        if (old + 1u == (gen + 1u) * nloc) {
            __builtin_amdgcn_fence(__ATOMIC_RELEASE, "agent");
            asm volatile("s_waitcnt vmcnt(0)" ::: "memory");
            const unsigned og = xb_add(&bar[XB_TOP], 1u);
            const unsigned tg = og / nx;
            if (og + 1u == (tg + 1u) * nx) xb_add(&bar[XB_TOPGEN], 1u);
            else XB_SPIN(xb_ld(&bar[XB_TOPGEN]) == tg, bar);
            __builtin_amdgcn_fence(__ATOMIC_ACQUIRE, "agent");
            xb_add(&bar[XB_XGEN(b.x)], 1u);
            asm volatile("s_waitcnt vmcnt(0)" ::: "memory");
        } else {
            XB_SPIN(xb_ld(&bar[XB_XGEN(b.x)]) == gen, bar);
            __builtin_amdgcn_fence(__ATOMIC_ACQUIRE, "agent");
            asm volatile("s_waitcnt vmcnt(0)" ::: "memory");
        }
    }
    __syncthreads();
}

constexpr int NWAVES = 8, NTHREADS = 512;
constexpr int NT = 32768, DM = 1024, SEQ = 8192, NCHUNK = 128, PROJW = 3328;
constexpr float EPS = 1e-6f;
enum { I_X = 0, I_P, I_POS, I_NMW, I_NFW, I_NPW, I_FNW, I_EWIN, I_GWUP, I_GBUP, I_GNW, I_RNW, I_EWOUT, I_OWIN, I_POOLW, I_POOLS, I_ARE, I_AIM, I_LDT, I_BRE, I_BIM, I_CRE, I_CIM, I_DSK,
       I_WGLU, I_BGLU, I_OWOUT, I_PWQ, I_PKEYS, I_PU, I_PV, I_PLEP, I_PLEG, N_IN };
constexpr size_t MiB = 1u << 20;
constexpr size_t WS_CTL = 0, CTL_ZERO_BYTES = 64 * 1024;
constexpr size_t WS_WIN0 = 1 * MiB, WS_WOUT0 = 8 * MiB, WS_WEFF = 10 * MiB  , WS_WG = 18 * MiB  , WS_WP = 22 * MiB  , WS_WIN1 = 23 * MiB, WS_WGLU = 25 * MiB, WS_WOUT1 = 26 * MiB;
constexpr size_t WS_ROT = 28 * MiB, WS_S5C = 30 * MiB, WS_SSQ0 = 31 * MiB, WS_SSQ1 = 33 * MiB, WS_DEC = 35 * MiB;
constexpr size_t S5_ABAR = 0, S5_A64 = 16384, S5_BBAR = 32768  , S5_CM = 32768 + 262144  , S5_BB16 = S5_CM + 131072  ;
constexpr size_t WS_A0 = 36 * MiB, WS_A1 = 100 * MiB, WS_R1 = 164 * MiB;
constexpr size_t WS_PROJ = WS_R1, WS_KV = WS_R1 + 208 * MiB;
constexpr size_t WS_SC = WS_R1, WS_EID = WS_R1 + 256 * MiB, WS_GATE = WS_R1 + 272 * MiB;
constexpr size_t WS_COEF = WS_R1 + 160 * MiB;
constexpr size_t WS_XQ = WS_R1 + 224 * MiB;
constexpr size_t WS_UT4 = WS_R1 + 288 * MiB, WS_VT4 = WS_UT4 + 8 * MiB, WS_SCL = WS_UT4 + 16 * MiB, WS_PB = WS_UT4 + 18 * MiB, WS_PP = WS_R1 + 80 * MiB;
constexpr size_t WS_U = WS_R1, WS_Z = WS_R1 + 64 * MiB, WS_E = WS_R1 + 96 * MiB;
constexpr size_t WS_END = WS_R1 + 288 * MiB + 34 * MiB;
constexpr int RING_BYTES = 131072, MISC_OFF = RING_BYTES + 320, LDS_BYTES = 147456;

__device__ __forceinline__ float bf2f(unsigned short b) { return __uint_as_float((unsigned)b << 16); }
__device__ __forceinline__ float bf2f(unsigned b) { return __uint_as_float(b << 16); }
__device__ __forceinline__ float bflo(unsigned w) { return __uint_as_float(w << 16); }
__device__ __forceinline__ float bfhi(unsigned w) { return __uint_as_float(w & 0xffff0000u); }
__device__ __forceinline__ float wave_sum(float v) {
#pragma unroll
    for (int o = 1; o < 64; o <<= 1) v += __shfl_xor(v, o);
    return v;
}
__device__ __forceinline__ float gelu1(float v) {
    const float av = fabsf(v), t = __builtin_amdgcn_rcpf(av * 0.2316418882f + 1.0f);
    float q = t * 0.5307027145f + (-0.7265760135f); q = q * t + 0.7107068705f; q = q * t + (-0.142248368f); q = q * t + 0.127414796f; q = q * t;
    const float e = __builtin_amdgcn_exp2f((v * v) * (-0.72134752044f));
    const float m = v * (q * e);
    return v < 0.f ? m : v - m;
}
__device__ __forceinline__ float logsigf(float x) { return fminf(x, 0.f) - __logf(1.0f + __expf(-fabsf(x))); }
__device__ __forceinline__ float siluf(float x) { return x * __builtin_amdgcn_rcpf(1.0f + __expf(-x)); }

struct Ctx {
    LAS unsigned char* lds;
    int tid, lane, wave, G, bid;
    float* h;
    unsigned char* ws;
};
struct Args { const void* in[N_IN]; float* out; unsigned char* ws; };
constexpr int PTR_OFF = 131072 + 1024;
#define IN(i) inptr(C, (i))
#define WSP(T, off) ((T*)(C.ws + (off)))
#define PHASE_ENTER(C) do { int t_ = threadIdx.x; asm volatile("" : "+v"(t_)); C.tid = t_; C.lane = t_ & 63; C.wave = __builtin_amdgcn_readfirstlane(t_ >> 6); asm volatile("" : "+s"(C.ws), "+s"(C.h)); C.ws = (unsigned char*)(GAS unsigned char*)C.ws; C.h = (float*)(GAS float*)C.h; } while (0)
__device__ __forceinline__ const float* inptr(const Ctx& C, int i) { const LAS unsigned* t = (const LAS unsigned*)(C.lds + PTR_OFF) + 2 * i;
    const unsigned lo = __builtin_amdgcn_readfirstlane(t[0]), hi = __builtin_amdgcn_readfirstlane(t[1]); return (const float*)(const GAS float*)(((unsigned long long)hi << 32) | lo); }

__device__ __forceinline__ void tr_item(const float* W, int ldw, int c0, bf16* WT, int K, int r0, const float* ks, float cs, LAS float* scr, int item, int nblk, int lane) {
    const int kb = item / nblk, nb = item % nblk, k0 = 64 * kb, n0 = 32 * nb;
#pragma unroll 8
    for (int i = 0; i < 32; ++i) { const int kk = 2 * i + (lane >> 5); float v = W[(size_t)(k0 + kk) * ldw + c0 + n0 + (lane & 31)]; if (ks) v *= ks[k0 + kk]; scr[kk * 33 + (lane & 31)] = v * cs; }
    LDS_WAIT(); asm volatile("" ::: "memory");
    const int c = lane & 7;
#pragma unroll
    for (int j = 0; j < 4; ++j) { const int n = (lane >> 3) + 8 * j; const LAS float* s = scr + (8 * c) * 33 + n;
        v4u o; o.x = pk2(s[0 * 33], s[1 * 33]); o.y = pk2(s[2 * 33], s[3 * 33]); o.z = pk2(s[4 * 33], s[5 * 33]); o.w = pk2(s[6 * 33], s[7 * 33]);
        *(v4u*)(WT + (size_t)(r0 + n0 + n) * K + k0 + 8 * c) = o; }
    LDS_WAIT(); asm volatile("" ::: "memory");
}
__device__ __forceinline__ void fold_item(const float* KM, int sk, int sc, const float* W, int ldw, int wc0, int kb, bf16* OUT, const float* kscale, const float* nscale, LAS float* lds, int tid) {
    LAS float* KL = lds;
    LAS float* WL = lds + 128 * 132;
    if (sc == 1) { for (int idx = tid; idx < 16384; idx += NTHREADS) { const int key = idx >> 7, c = idx & 127; KL[key * 132 + c] = KM[(size_t)key * sk + c]; } }
    else         { for (int idx = tid; idx < 16384; idx += NTHREADS) { const int c = idx >> 7, key = idx & 127; KL[key * 132 + c] = KM[(size_t)key * sk + (size_t)c * sc]; } }
    for (int idx = tid; idx < 8192; idx += NTHREADS) { const int k = idx >> 7, c = idx & 127; WL[k * 132 + c] = W[(size_t)(kb * 64 + k) * ldw + wc0 + c]; }
    __syncthreads();
    const int ty = tid >> 4, tx = tid & 15;
    float acc[4][4];
#pragma unroll
    for (int i = 0; i < 4; ++i)
#pragma unroll
        for (int j = 0; j < 4; ++j) acc[i][j] = 0.f;
    for (int c4 = 0; c4 < 32; ++c4) {
        f32x4 a[4], b[4];
#pragma unroll
        for (int i = 0; i < 4; ++i) a[i] = *(const LAS f32x4*)(KL + (4 * ty + i) * 132 + 4 * c4);
#pragma unroll
        for (int j = 0; j < 4; ++j) b[j] = *(const LAS f32x4*)(WL + (tx + 16 * j) * 132 + 4 * c4);
#pragma unroll
        for (int i = 0; i < 4; ++i)
#pragma unroll
            for (int j = 0; j < 4; ++j) acc[i][j] += (a[i][0] * b[j][0] + a[i][1] * b[j][1]) + (a[i][2] * b[j][2] + a[i][3] * b[j][3]);
    }
#pragma unroll
    for (int i = 0; i < 4; ++i) { const int key = 4 * ty + i; const float ns = nscale ? nscale[key] : 1.0f;
#pragma unroll
        for (int j = 0; j < 4; ++j) { const int k = kb * 64 + tx + 16 * j; OUT[(size_t)key * 1024 + k] = (bf16)f2bf(acc[i][j] * kscale[k] * ns); } }
    __syncthreads();
}

__device__ __forceinline__ void phase_prologue(Ctx C, const Args& A) {
    PHASE_ENTER(C);
    const int tid = C.tid, lane = C.lane;
    const bool split = C.G >= 192; const int NF = split ? 96 : C.G;
    const bool do_fold = !split || C.bid < NF, do_rest = !split || C.bid >= NF;
    const int wb = split ? C.bid - NF : C.bid, nwb = split ? C.G - NF : C.G;
    const int gw = wb * NWAVES + C.wave, NGW = nwb * NWAVES;
    const int gt = wb * NTHREADS + tid, NGT = nwb * NTHREADS;
    if (do_fold) for (int it = C.bid; it < 576; it += NF) {
        if (it < 512) { const int l = it >> 8, hp = (it >> 4) & 15, kb = it & 15;
            fold_item(IN(I_PKEYS) + (size_t)(l * 16 + hp) * 16384, 128, 1, IN(I_PWQ) + (size_t)l * 1024 * 2048, 2048, hp * 128, kb,
                      WSP(bf16, WS_WEFF) + (size_t)l * 2048 * 1024 + (size_t)hp * 128 * 1024, IN(I_NFW) + l * 1024, nullptr, (LAS float*)C.lds, tid);
        } else { const int r = it - 512, g = r >> 4, kb = r & 15;
            fold_item(IN(I_POOLW) + (size_t)g * 16384, 1, 128, IN(I_OWIN), 1024, g * 128, kb,
                      WSP(bf16, WS_WIN1) + (size_t)g * 128 * 1024, IN(I_NMW) + 1024, IN(I_POOLS) + g * 128, (LAS float*)C.lds, tid);
        }
    }
    if (do_rest) {
    LAS float* scr = (LAS float*)(C.lds + C.wave * 8448);
    constexpr int TR_ITEMS = 128 + 640 + 128 + 128 + 512 + 512 + 512 + 512 + 128 + 128 + 256 + 128 + 512;
    for (int it = gw; it < TR_ITEMS; it += NGW) {
        int r = it;
#define TRJOB(W, ldw, c0, ncols, Krows, WT, r0, ks, cs) { constexpr int nb_ = (ncols) / 32, ni_ = ((Krows) / 64) * nb_; if (r < ni_) { tr_item(W, ldw, c0, WT, Krows, r0, ks, cs, scr, r, nb_, lane); continue; } r -= ni_; }
        TRJOB(IN(I_EWIN), 3088, 0,    256,  1024, WSP(bf16, WS_WIN0), 0,    IN(I_NMW), 0.125f)
        TRJOB(IN(I_EWIN), 3088, 256,  1280, 1024, WSP(bf16, WS_WIN0), 256,  IN(I_NMW), 1.0f)
        TRJOB(IN(I_EWIN), 3088, 1552, 256,  1024, WSP(bf16, WS_WIN0), 1792, IN(I_NMW), 1.0f)
        TRJOB(IN(I_EWIN), 3088, 1808, 256,  1024, WSP(bf16, WS_WIN0), 2048, IN(I_NMW), 0.125f)
        TRJOB(IN(I_EWIN), 3088, 2064, 1024, 1024, WSP(bf16, WS_WIN0), 2304, IN(I_NMW), 1.0f)
        TRJOB(IN(I_EWOUT), 1024, 0, 1024, 1024, WSP(bf16, WS_WOUT0), 0, (const float*)nullptr, 1.0f)
        TRJOB(IN(I_PLEG), 1024, 0, 1024, 1024, WSP(bf16, WS_WG), 0, IN(I_NPW), 1.0f)
        TRJOB(IN(I_PLEG) + 1024 * 1024, 1024, 0, 1024, 1024, WSP(bf16, WS_WG) + 1024 * 1024, 0, IN(I_NPW) + 1024, 1.0f)
        TRJOB(IN(I_PLEP), 1024, 0, 1024, 256, WSP(bf16, WS_WP), 0, (const float*)nullptr, 1.0f)
        TRJOB(IN(I_PLEP) + 256 * 1024, 1024, 0, 1024, 256, WSP(bf16, WS_WP) + 1024 * 256, 0, (const float*)nullptr, 1.0f)
        TRJOB(IN(I_OWIN), 1024, 512, 512, 1024, WSP(bf16, WS_WIN1), 512, IN(I_NMW) + 1024, 1.0f)
        TRJOB(IN(I_WGLU), 512, 0, 512, 512, WSP(bf16, WS_WGLU), 0, (const float*)nullptr, 1.0f)
        TRJOB(IN(I_OWOUT), 1024, 0, 1024, 1024, WSP(bf16, WS_WOUT1), 0, (const float*)nullptr, 1.0f)
#undef TRJOB
    }
    for (int idx = gt; idx < 256 * 1024; idx += NGT) { const int j = idx >> 10, k = idx & 1023; const float* wr = IN(I_EWIN) + (size_t)k * 3088 + 1536; const float* wu = IN(I_GWUP) + j; float s = 0.f;
#pragma unroll
        for (int r = 0; r < 16; ++r) s += wr[r] * wu[r * 256];
        WSP(bf16, WS_WIN0)[(size_t)(1536 + j) * 1024 + k] = (bf16)f2bf(s * IN(I_NMW)[k]); }
    for (int idx = gt; idx < SEQ * 32; idx += NGT) { const int s = idx >> 5, i = idx & 31; const double pos = (double)((const int*)IN(I_POS))[s];
        const double ang = pos * exp2(-(double)i * (13.287712379549449 / 32.0)); const double r = ang - 6.283185307179586 * rint(ang * 0.15915494309189535);
        float sn, cs; sincosf((float)r, &sn, &cs); WSP(float, WS_ROT)[2 * idx] = cs; WSP(float, WS_ROT)[2 * idx + 1] = sn; }
    for (int idx = gt; idx < 2048; idx += NGT) { const int g = idx >> 6;
        const double dt = exp((double)IN(I_LDT)[g]), are = (double)IN(I_ARE)[idx], aim = (double)IN(I_AIM)[idx];
        const double mag = exp(are * dt); double th = aim * dt; th -= 6.283185307179586 * rint(th * 0.15915494309189535);
        const double abr = mag * cos(th), abi = mag * sin(th);
        const double den = are * are + aim * aim, nr = abr - 1.0, ni = abi;
        const double cre = (nr * are + ni * aim) / den, cim = (ni * are - nr * aim) / den;
        const double m64 = exp(64.0 * are * dt); double t64 = 64.0 * aim * dt; t64 -= 6.283185307179586 * rint(t64 * 0.15915494309189535);
        float* s5 = WSP(float, WS_S5C);
        s5[S5_ABAR / 4 + 2 * idx] = (float)abr; s5[S5_ABAR / 4 + 2 * idx + 1] = (float)abi;
        s5[S5_A64 / 4 + 2 * idx] = (float)(m64 * cos(t64)); s5[S5_A64 / 4 + 2 * idx + 1] = (float)(m64 * sin(t64));
        for (int hh = 0; hh < 16; ++hh) { const double br = (double)IN(I_BRE)[idx * 16 + hh], bi = (double)IN(I_BIM)[idx * 16 + hh];
            s5[S5_BBAR / 4 + (idx * 16 + hh) * 2] = (float)(cre * br - cim * bi); s5[S5_BBAR / 4 + (idx * 16 + hh) * 2 + 1] = (float)(cre * bi + cim * br);
            bf16* bb = (bf16*)(C.ws + WS_S5C + S5_BB16) + (size_t)g * 128 * 16; const int pp_ = idx & 63;
            bb[(pp_) * 16 + hh] = (bf16)f2bf((float)(cre * br - cim * bi)); bb[(64 + pp_) * 16 + hh] = (bf16)f2bf((float)(cre * bi + cim * br)); } }
    for (int idx = gt; idx < 32 * 16 * 128; idx += NGT) { const int k = idx & 127, gh = idx >> 7;
        const float v = k < 64 ? IN(I_CRE)[gh * 64 + k] : -IN(I_CIM)[gh * 64 + k - 64]; ((bf16*)(C.ws + WS_S5C + S5_CM))[idx] = (bf16)f2bf(v); }
#pragma unroll 4
    for (int m = gw; m < NT; m += NGW) { const f32x4* xr = (const f32x4*)(IN(I_X) + (size_t)m * DM) + lane; f32x4 v[4]; float s = 0.f;
#pragma unroll
        for (int j = 0; j < 4; ++j) { v[j] = xr[64 * j]; s += (v[j][0] * v[j][0] + v[j][1] * v[j][1]) + (v[j][2] * v[j][2] + v[j][3] * v[j][3]); }
        const float rs = 1.0f / sqrtf(wave_sum(s) * (1.0f / DM) + EPS);
        unsigned long long* o8 = (unsigned long long*)(WSP(bf16, WS_A0) + (size_t)m * DM) + lane;
#pragma unroll
        for (int j = 0; j < 4; ++j) o8[64 * j] = (unsigned long long)pk2(v[j][0] * rs, v[j][1] * rs) | ((unsigned long long)pk2(v[j][2] * rs, v[j][3] * rs) << 32); }
    }
}

__device__ __forceinline__ float lg2gamma(int hh) { return __log2f(1.0f - exp2f(-5.0f - (float)hh)); }

__device__ __forceinline__ void gla_gate_local(const unsigned (&rla)[16], float bu, float (&g)[16]) {
    float run = 0.f;
#pragma unroll
    for (int c = 0; c < 16; ++c) { const float x = bf2f(rla[c]) + bu; run += logsigf(x) * (1.0f / 16.0f); g[c] = run; }
}
__device__ __forceinline__ void stage_vt(const unsigned (&v0)[16], const unsigned (&v1)[16], LAS bf16* Vt, int c0, int lane) {
    unsigned w[8];
#pragma unroll
    for (int c = 0; c < 16; c += 2) w[c >> 1] = (unsigned)v0[c] | ((unsigned)v0[c + 1] << 16);
    *(LAS v4u*)(Vt + lane * 72 + c0) = (v4u){w[0], w[1], w[2], w[3]}; *(LAS v4u*)(Vt + lane * 72 + c0 + 8) = (v4u){w[4], w[5], w[6], w[7]};
#pragma unroll
    for (int c = 0; c < 16; c += 2) w[c >> 1] = (unsigned)v1[c] | ((unsigned)v1[c + 1] << 16);
    *(LAS v4u*)(Vt + (lane + 64) * 72 + c0) = (v4u){w[0], w[1], w[2], w[3]}; *(LAS v4u*)(Vt + (lane + 64) * 72 + c0 + 8) = (v4u){w[4], w[5], w[6], w[7]};
}

__device__ __forceinline__ void phase_kv(Ctx C, const Args& A) {
    PHASE_ENTER(C);
    const int half = C.wave >> 2;
    LAS unsigned char* hb = C.lds + half * 28672;
    LAS bf16* Kt = (LAS bf16*)hb; LAS bf16* Vt = (LAS bf16*)(hb + 9216); LAS float* TOT = (LAS float*)(hb + 27648);
    const bf16* PROJ = WSP(bf16, WS_PROJ);
    unsigned r_la[16], r_k[16], r_kx[16], r_v0[16], r_v1[16]; float r_cs[16], r_sn[16]; float bu = 0.f;
#pragma unroll
    for (int c = 0; c < 16; ++c) { r_la[c] = 0u; r_kx[c] = 0u; r_cs[c] = 0.f; r_sn[c] = 0.f; r_k[c] = 0u; r_v0[c] = 0u; r_v1[c] = 0u; }
#define KV_LOAD(IT, LANE, C0) do { const int pair_ = (IT) & 3, n_ = ((IT) >> 2) & 127, b_ = (IT) >> 9; const bool ret_ = pair_ >= 2; const int hh_ = (pair_ & 1) * 2 + half; \
        const bf16* prow_ = PROJ + (size_t)(b_ * SEQ + n_ * 64 + (C0)) * PROJW; const int xoff_ = (LANE) < 32 ? 32 : -32; \
        const bf16* bK_ = prow_ + (ret_ ? 2048 + hh_ * 64 : 256 + hh_ * 64); const bf16* bV_ = prow_ + (ret_ ? 2304 + hh_ * 128 : 512 + hh_ * 128); const bf16* bL_ = prow_ + 1536 + hh_ * 64; \
        if (!ret_) { bu = IN(I_GBUP)[hh_ * 64 + (LANE)]; _Pragma("unroll") for (int c = 0; c < 16; ++c) r_la[c] = bL_[c * PROJW + (LANE)]; } \
        else { const float* rot_ = WSP(float, WS_ROT) + ((size_t)(n_ * 64 + (C0)) * 32 + ((LANE) & 31)) * 2; \
               _Pragma("unroll") for (int c = 0; c < 16; ++c) { r_kx[c] = bK_[c * PROJW + (LANE) + xoff_]; r_cs[c] = rot_[c * 64]; r_sn[c] = rot_[c * 64 + 1]; } } \
        _Pragma("unroll") for (int c = 0; c < 16; ++c) { r_k[c] = bK_[c * PROJW + (LANE)]; r_v0[c] = bV_[c * PROJW + (LANE)]; r_v1[c] = bV_[c * PROJW + (LANE) + 64]; } } while (0)
    if (C.bid < 2048) KV_LOAD(C.bid, C.lane, 16 * (C.wave & 3));
    for (int item = C.bid; item < 2048; item += C.G) {
        int lane_o = C.lane, w4_o = C.wave & 3; asm volatile("" : "+v"(lane_o), "+s"(w4_o));
        const int lane = lane_o, w4 = w4_o, fr = lane & 15, fq = lane >> 4, c0 = 16 * w4;
        const int pair = item & 3, n = (item >> 2) & 127, b = item >> 9; const bool isret = pair >= 2;
        const int hh = (pair & 1) * 2 + half, t0 = b * SEQ + n * 64;
        const bf16* prow = PROJ + (size_t)(t0 + c0) * PROJW;
        float g[16]; float glast = 0.f, off = 0.f;
        if (!isret) { gla_gate_local(r_la, bu, g); TOT[w4 * 64 + lane] = g[15]; }
        __syncthreads();
        if (!isret) {
#pragma unroll
            for (int w = 0; w < 4; ++w) { const float tv = TOT[w * 64 + lane]; glast += tv; if (w < w4) off += tv; } }
        unsigned kw[8];
        if (!isret) {
#pragma unroll
            for (int c = 0; c < 16; c += 2) { const float k0 = bf2f(r_k[c]) * __expf(glast - (off + g[c])), k1 = bf2f(r_k[c + 1]) * __expf(glast - (off + g[c + 1])); kw[c >> 1] = pk2(k0, k1); }
        } else { const float lg = lg2gamma(hh); float kv[2];
#pragma unroll
            for (int c = 0; c < 16; ++c) { const float own = bf2f(r_k[c]), oth = bf2f(r_kx[c]); const float cs = r_cs[c], sn = r_sn[c];
                const float r = lane < 32 ? own * cs - oth * sn : own * cs + oth * sn; kv[c & 1] = r * exp2f(lg * (float)(63 - (c0 + c))); if (c & 1) kw[c >> 1] = pk2(kv[0], kv[1]); } }
        *(LAS v4u*)(Kt + lane * 72 + c0) = (v4u){kw[0], kw[1], kw[2], kw[3]}; *(LAS v4u*)(Kt + lane * 72 + c0 + 8) = (v4u){kw[4], kw[5], kw[6], kw[7]};
        stage_vt(r_v0, r_v1, Vt, c0, lane);
        if (!isret && w4 == 0) WSP(float, WS_DEC)[(size_t)((b * 4 + hh) * 128 + n) * 64 + lane] = __expf(glast);
        asm volatile("" ::: "memory");
        if (item + C.G < 2048) KV_LOAD(item + C.G, lane, c0);
        __syncthreads();
        f32x4 acc[2][4];
#pragma unroll
        for (int et = 0; et < 2; ++et)
#pragma unroll
            for (int dt = 0; dt < 4; ++dt) acc[et][dt] = (f32x4){0.f, 0.f, 0.f, 0.f};
#pragma unroll
        for (int kk = 0; kk < 2; ++kk) { bf16x8 bfr[4];
#pragma unroll
            for (int dt = 0; dt < 4; ++dt) bfr[dt] = *(const LAS bf16x8*)(Kt + (dt * 16 + fr) * 72 + kk * 32 + 8 * fq);
#pragma unroll
            for (int et = 0; et < 2; ++et) { const bf16x8 afr = *(const LAS bf16x8*)(Vt + ((2 * w4 + et) * 16 + fr) * 72 + kk * 32 + 8 * fq);
#pragma unroll
                for (int dt = 0; dt < 4; ++dt) acc[et][dt] = __builtin_amdgcn_mfma_f32_16x16x32_bf16(afr, bfr[dt], acc[et][dt], 0, 0, 0); } }
        bf16* KV = WSP(bf16, WS_KV) + (size_t)((b * 8 + (isret ? 4 + hh : hh)) * 128 + n) * 8192;
#pragma unroll
        for (int et = 0; et < 2; ++et)
#pragma unroll
            for (int dt = 0; dt < 4; ++dt)
#pragma unroll
                for (int r = 0; r < 4; ++r) KV[((2 * w4 + et) * 16 + 4 * fq + r) * 64 + dt * 16 + fr] = (bf16)f2bf(acc[et][dt][r]);
        __syncthreads();
    }
#undef KV_LOAD
}

__device__ __forceinline__ void phase_scan(Ctx C, const Args& A) {
    PHASE_ENTER(C);
    for (int gid = C.bid * NTHREADS + C.tid; gid < 131072; gid += C.G * NTHREADS) {
        const int dp = gid & 31, e = (gid >> 5) & 127, bh = gid >> 12, h8 = bh & 7, b = bh >> 3;
        unsigned* p = (unsigned*)(WSP(bf16, WS_KV) + (size_t)bh * 128 * 8192 + e * 64) + dp;
        float s0 = 0.f, s1 = 0.f;
        if (h8 < 4) { const float* dec = WSP(float, WS_DEC) + (size_t)(b * 4 + h8) * 128 * 64 + 2 * dp;
#pragma unroll 8
            for (int n = 0; n < NCHUNK; ++n) { const unsigned kv = p[(size_t)n * 4096]; const float d0 = dec[n * 64], d1 = dec[n * 64 + 1]; p[(size_t)n * 4096] = pk2(s0, s1); s0 = d0 * s0 + bflo(kv); s1 = d1 * s1 + bfhi(kv); }
        } else { const float d = exp2f(64.0f * lg2gamma(h8 - 4));
#pragma unroll 8
            for (int n = 0; n < NCHUNK; ++n) { const unsigned kv = p[(size_t)n * 4096]; p[(size_t)n * 4096] = pk2(s0, s1); s0 = d * s0 + bflo(kv); s1 = d * s1 + bfhi(kv); } }
    }
}

__device__ __forceinline__ void phase_mix0_out(Ctx C, const Args& A) {
    PHASE_ENTER(C);
    const int half = C.wave >> 2;
    LAS unsigned char* hb = C.lds + half * 56320;
    LAS bf16* Qp = (LAS bf16*)hb; LAS bf16* Kp = (LAS bf16*)(hb + 9216); LAS bf16* Qpp = (LAS bf16*)(hb + 18432); LAS bf16* Vt = (LAS bf16*)(hb + 27648); LAS bf16* Pm = (LAS bf16*)(hb + 46080);
    LAS float* TOT = (LAS float*)(hb + 55296);
    const bf16* PROJ = WSP(bf16, WS_PROJ); bf16* Y = WSP(bf16, WS_A1);
    for (int item = C.bid; item < 2048; item += C.G) {
        int lane_o = C.lane, w4_o = C.wave & 3; asm volatile("" : "+v"(lane_o), "+s"(w4_o));
        const int lane = lane_o, w4 = w4_o, fr = lane & 15, fq = lane >> 4, c0 = 16 * w4;
        const int pair = item & 3, n = (item >> 2) & 127, b = item >> 9; const bool isret = pair >= 2;
        const int hh = (pair & 1) * 2 + half, t0 = b * SEQ + n * 64;
        const bf16* prow = PROJ + (size_t)(t0 + c0) * PROJW;
        const float lg = lg2gamma(hh);
        const int gcol0 = isret ? 2816 + hh * 128 : 1024 + hh * 128, ycol0 = isret ? 512 + hh * 128 : hh * 128;
        const bf16* bQ = prow + (isret ? 1792 + hh * 64 : hh * 64); const bf16* bK = prow + (isret ? 2048 + hh * 64 : 256 + hh * 64); const bf16* bV = prow + (isret ? 2304 + hh * 128 : 512 + hh * 128); const bf16* bL = prow + 1536 + hh * 64;
        const int xoff = lane < 32 ? 32 : -32;
        unsigned r_la[16], r_q[16], r_k[16], r_qx[16], r_kx[16], r_v0[16], r_v1[16]; float bu = 0.f;
#pragma unroll
        for (int c = 0; c < 16; ++c) { r_la[c] = 0u; r_qx[c] = 0u; r_kx[c] = 0u; }
        const float* rot = WSP(float, WS_ROT) + ((size_t)(n * 64 + c0) * 32 + (lane & 31)) * 2;
        if (!isret) { bu = IN(I_GBUP)[hh * 64 + lane];
#pragma unroll
            for (int c = 0; c < 16; ++c) r_la[c] = bL[c * PROJW + lane];
        } else {
#pragma unroll
            for (int c = 0; c < 16; ++c) { r_qx[c] = bQ[c * PROJW + lane + xoff]; r_kx[c] = bK[c * PROJW + lane + xoff]; } }
#pragma unroll
        for (int c = 0; c < 16; ++c) { r_q[c] = bQ[c * PROJW + lane]; r_k[c] = bK[c * PROJW + lane]; r_v0[c] = bV[c * PROJW + lane]; r_v1[c] = bV[c * PROJW + lane + 64]; }
        float g[16]; float glast = 0.f, off = 0.f;
        if (!isret) { gla_gate_local(r_la, bu, g); TOT[w4 * 64 + lane] = g[15]; }
        __syncthreads();
        if (!isret) {
#pragma unroll
            for (int w = 0; w < 4; ++w) { const float tv = TOT[w * 64 + lane]; glast += tv; if (w < w4) off += tv; }
            const float ref = 0.5f * glast;
#pragma unroll
            for (int c = 0; c < 16; ++c) { const float gq = off + g[c], q = bf2f(r_q[c]), k = bf2f(r_k[c]); const int o = (c0 + c) * 72 + lane;
                Qp[o] = (bf16)f2bf(q * __expf(gq - ref)); Kp[o] = (bf16)f2bf(k * __expf(ref - gq)); Qpp[o] = (bf16)f2bf(q * __expf(gq)); }
        } else {
#pragma unroll
            for (int c = 0; c < 16; ++c) { const float cs = rot[c * 64], sn = rot[c * 64 + 1];
                const float qo = bf2f(r_q[c]), qx = bf2f(r_qx[c]), ko = bf2f(r_k[c]), kx = bf2f(r_kx[c]);
                const float qr = lane < 32 ? qo * cs - qx * sn : qo * cs + qx * sn, kr = lane < 32 ? ko * cs - kx * sn : ko * cs + kx * sn; const int o = (c0 + c) * 72 + lane;
                Qp[o] = (bf16)f2bf(qr); Kp[o] = (bf16)f2bf(kr); Qpp[o] = (bf16)f2bf(qr * exp2f(lg * (float)(c0 + c + 1))); } }
        stage_vt(r_v0, r_v1, Vt, c0, lane);
        asm volatile("" ::: "memory");
        const bf16* St = WSP(bf16, WS_KV) + (size_t)((b * 8 + (isret ? 4 + hh : hh)) * 128 + n) * 8192;
        bf16x8 sfr[2][8]; unsigned r_g[8][4];
#pragma unroll
        for (int kk = 0; kk < 2; ++kk)
#pragma unroll
            for (int et = 0; et < 8; ++et) sfr[kk][et] = *(const bf16x8*)(St + (16 * et + fr) * 64 + kk * 32 + 8 * fq);
#pragma unroll
        for (int et = 0; et < 8; ++et)
#pragma unroll
            for (int r = 0; r < 4; ++r) r_g[et][r] = (PROJ + (size_t)(t0 + 16 * w4) * PROJW + gcol0)[(4 * fq + r) * PROJW + 16 * et + fr];
        __syncthreads();
        { f32x4 sc[4];
#pragma unroll
            for (int jt = 0; jt < 4; ++jt) sc[jt] = (f32x4){0.f, 0.f, 0.f, 0.f};
#pragma unroll
            for (int kk = 0; kk < 2; ++kk) { const bf16x8 afr = *(const LAS bf16x8*)(Qp + (16 * w4 + fr) * 72 + kk * 32 + 8 * fq);
#pragma unroll
                for (int jt = 0; jt < 4; ++jt) { const bf16x8 bfr = *(const LAS bf16x8*)(Kp + (16 * jt + fr) * 72 + kk * 32 + 8 * fq); sc[jt] = __builtin_amdgcn_mfma_f32_16x16x32_bf16(afr, bfr, sc[jt], 0, 0, 0); } }
#pragma unroll
            for (int jt = 0; jt < 4; ++jt)
#pragma unroll
                for (int r = 0; r < 4; ++r) { const int i = 16 * w4 + 4 * fq + r, j = 16 * jt + fr; float v = sc[jt][r]; if (isret) v *= exp2f(lg * (float)(i - j)); if (j > i) v = 0.f; Pm[i * 72 + j] = (bf16)f2bf(v); } }
        asm volatile("s_waitcnt lgkmcnt(0)" ::: "memory");
        f32x4 o[8];
#pragma unroll
        for (int et = 0; et < 8; ++et) o[et] = (f32x4){0.f, 0.f, 0.f, 0.f};
#pragma unroll
        for (int kk = 0; kk < 2; ++kk) { const bf16x8 afr = *(const LAS bf16x8*)(Pm + (16 * w4 + fr) * 72 + kk * 32 + 8 * fq), afr2 = *(const LAS bf16x8*)(Qpp + (16 * w4 + fr) * 72 + kk * 32 + 8 * fq);
#pragma unroll
            for (int et = 0; et < 8; ++et) { const bf16x8 bfr = *(const LAS bf16x8*)(Vt + (16 * et + fr) * 72 + kk * 32 + 8 * fq);
                o[et] = __builtin_amdgcn_mfma_f32_16x16x32_bf16(afr, bfr, o[et], 0, 0, 0); o[et] = __builtin_amdgcn_mfma_f32_16x16x32_bf16(afr2, sfr[kk][et], o[et], 0, 0, 0); } }
        float mu[4], rs[4];
#pragma unroll
        for (int r = 0; r < 4; ++r) { float s1 = 0.f;
            if (isret) {
#pragma unroll
                for (int et = 0; et < 8; ++et) s1 += o[et][r];
                s1 += __shfl_xor(s1, 1); s1 += __shfl_xor(s1, 2); s1 += __shfl_xor(s1, 4); s1 += __shfl_xor(s1, 8); }
            mu[r] = s1 * (1.0f / 128.0f); float s2 = 0.f;
#pragma unroll
            for (int et = 0; et < 8; ++et) { const float d = o[et][r] - mu[r]; s2 += d * d; }
            s2 += __shfl_xor(s2, 1); s2 += __shfl_xor(s2, 2); s2 += __shfl_xor(s2, 4); s2 += __shfl_xor(s2, 8);
            rs[r] = 1.0f / sqrtf(s2 * (1.0f / 128.0f) + EPS); }
#pragma unroll
        for (int et = 0; et < 8; ++et) { const int e = 16 * et + fr; const float nw = isret ? IN(I_RNW)[hh * 128 + e] : IN(I_GNW)[e];
#pragma unroll
            for (int r = 0; r < 4; ++r) { const int t = t0 + 16 * w4 + 4 * fq + r; const float gate = siluf(bf2f(r_g[et][r]));
                Y[(size_t)t * DM + ycol0 + e] = (bf16)f2bf((o[et][r] - mu[r]) * rs[r] * nw * gate); } }
        __syncthreads();
    }
}

__device__ __forceinline__ unsigned mono_key(float v) { const unsigned u = __float_as_uint(v); return u ^ ((unsigned)((int)u >> 31) | 0x80000000u); }
__device__ __forceinline__ float mono_val(unsigned k) { return __uint_as_float((k & 0x80000000u) ? (k ^ 0x80000000u) : ~k); }
#define CE_DESC(a, b) { const unsigned hi_ = max((a), (b)), lo_ = min((a), (b)); (a) = hi_; (b) = lo_; }
__device__ __forceinline__ void sort16_desc(unsigned (&v)[16]) {
#pragma unroll
    for (int k = 2; k <= 16; k <<= 1)
#pragma unroll
        for (int j = k >> 1; j > 0; j >>= 1)
#pragma unroll
            for (int i = 0; i < 16; ++i) { const int l = i ^ j; if (l > i) { if ((i & k) == 0) { CE_DESC(v[i], v[l]); } else { CE_DESC(v[l], v[i]); } } }
}
__device__ __forceinline__ void merge_top16(unsigned (&T)[16], const unsigned (&G)[16]) {
#pragma unroll
    for (int i = 0; i < 16; ++i) T[i] = max(T[i], G[15 - i]);
#pragma unroll
    for (int j = 8; j > 0; j >>= 1)
#pragma unroll
        for (int i = 0; i < 16; ++i) { const int l = i ^ j; if (l > i) CE_DESC(T[i], T[l]); }
}
struct TkChunk { v4u a, b; };
__device__ __forceinline__ void topk_load_chunk(const bf16* SC, int it, int X, int c, int lane, TkChunk& n) {
    const GAS v4u* p = (const GAS v4u*)((const GAS unsigned char*)SC + ((size_t)((it * 2 + X) * 8 + c) * 64 + lane) * 32); n.a = p[0]; n.b = p[1];
}
__device__ __forceinline__ void top16_list(const bf16* SC, int it, int X, int itn, int Xn, int lane, unsigned (&L)[16], TkChunk& nxt) {
#pragma unroll
    for (int c = 0; c < 8; ++c) {
        const TkChunk cur = nxt;
        if (c < 7) topk_load_chunk(SC, it, X, c + 1, lane, nxt); else topk_load_chunk(SC, itn, Xn, 0, lane, nxt);
        unsigned G[16];
#pragma unroll
        for (int i = 0; i < 8; ++i) { const unsigned w = i < 4 ? cur.a[i] : cur.b[i - 4];
            G[2 * i] = (mono_key(bflo(w)) & ~127u) | (unsigned)(127 - (c * 16 + 2 * i)); G[2 * i + 1] = (mono_key(bfhi(w)) & ~127u) | (unsigned)(127 - (c * 16 + 2 * i + 1)); }
        sort16_desc(G);
        if (c == 0) {
#pragma unroll
            for (int i = 0; i < 16; ++i) L[i] = G[i];
        } else merge_top16(L, G);
    }
}
__device__ __forceinline__ void phase_topk(Ctx C, const Args& A) {
    PHASE_ENTER(C);
    const int lane = C.lane; const int gw = C.bid * NWAVES + C.wave, NGW = C.G * NWAVES;
    LAS float* row = (LAS float*)(C.lds + C.wave * 8448);
    const bf16* SC = WSP(bf16, WS_SC);
    TkChunk nxt; if (gw < NT / 8) topk_load_chunk(SC, gw, 0, 0, lane, nxt);
    for (int it = gw; it < NT / 8; it += NGW) {
        const int tok0 = it * 8, mytok = tok0 + (lane >> 3), myh = lane & 7;
        unsigned TA[16], TB[16];
        const int itn = (it + NGW < NT / 8) ? it + NGW : it;
        top16_list(SC, it, 0, it, 1, lane, TA, nxt);
        top16_list(SC, it, 1, itn, 0, lane, TB, nxt);
        float sa[16], sb[16]; LAS int* irow = (LAS int*)(row + lane * 33);
#pragma unroll
        for (int i = 0; i < 16; ++i) { sa[i] = mono_val(TA[i] & ~127u); sb[i] = mono_val(TB[i] & ~127u); irow[i] = 127 - (int)(TA[i] & 127u); irow[16 + i] = 127 - (int)(TB[i] & 127u); }
        unsigned B[16];
        {
            constexpr int NC = 50;
            unsigned Gp[16];
#pragma unroll
            for (int grp = 0; grp < 4; ++grp) {
                int cnt = 0, slot = 0;
#pragma unroll
                for (int i = 0; i < 16; ++i)
#pragma unroll
                    for (int j = 0; j < 16; ++j) if ((i + 1) * (j + 1) <= 16) { if (cnt >= grp * 16 && cnt < grp * 16 + 16) { Gp[slot] = (mono_key(sa[i] + sb[j]) & ~255u) | (unsigned)(255 - (i * 16 + j)); ++slot; } ++cnt; }
#pragma unroll
                for (int z = 0; z < 16; ++z) if (z >= NC - grp * 16) Gp[z] = 0u;
                sort16_desc(Gp);
                if (grp == 0) {
#pragma unroll
                    for (int i = 0; i < 16; ++i) B[i] = Gp[i];
                } else merge_top16(B, Gp);
            }
        }
        asm volatile("s_waitcnt lgkmcnt(0)" ::: "memory");
        const float mx = mono_val(B[0] & ~255u); float ex[16]; float zs = 0.f;
#pragma unroll
        for (int r = 0; r < 16; ++r) { ex[r] = __expf(mono_val(B[r] & ~255u) - mx); zs += ex[r]; }
        const float iz = 1.0f / zs;
        int* eo = WSP(int, WS_EID) + (size_t)mytok * 128 + myh * 16; float* go = WSP(float, WS_GATE) + (size_t)mytok * 128 + myh * 16;
#pragma unroll
        for (int r4 = 0; r4 < 4; ++r4) { int ev[4]; float gv[4];
#pragma unroll
            for (int r = 0; r < 4; ++r) { const int flat = 255 - (int)(B[r4 * 4 + r] & 255u); ev[r] = irow[flat >> 4] * 128 + irow[16 + (flat & 15)]; gv[r] = ex[r4 * 4 + r] * iz; }
            *(int4*)(eo + r4 * 4) = make_int4(ev[0], ev[1], ev[2], ev[3]); *(f32x4*)(go + r4 * 4) = (f32x4){gv[0], gv[1], gv[2], gv[3]}; }
        asm volatile("s_waitcnt lgkmcnt(0)" ::: "memory");
    }
}

__device__ __forceinline__ unsigned fp4_code(float y) {
    const float a = fabsf(y);
    const unsigned c = (a > 0.25f) + (a > 0.75f) + (a > 1.25f) + (a > 1.75f) + (a > 2.5f) + (a > 3.5f) + (a > 5.0f);
    return c | (y < 0.f ? 8u : 0u);
}
__device__ __forceinline__ float wave_max64(float v) {
#pragma unroll
    for (int o = 1; o < 64; o <<= 1) v = fmaxf(v, __shfl_xor(v, o));
    return v;
}
__device__ __forceinline__ void quant_row16(const f32x4 (&v)[4], float inv, unsigned& d0, unsigned& d1) {
    unsigned w[2] = {0u, 0u};
#pragma unroll
    for (int c = 0; c < 4; ++c)
#pragma unroll
        for (int j = 0; j < 4; ++j) w[c >> 1] |= fp4_code(v[c][j] * inv) << (4 * ((c & 1) * 4 + j));
    d0 = w[0]; d1 = w[1];
}
__device__ __forceinline__ void phase_convert_peer(Ctx C, const Args& A, int l, int wg0, int nwg) {
    PHASE_ENTER(C);
    if (C.bid < wg0) return;
    const int gt = (C.bid - wg0) * NTHREADS + C.tid, NGT = nwg * NTHREADS;
    const float* U = IN(I_PU) + (size_t)l * 16384 * 1024; const float* V = IN(I_PV) + (size_t)l * 16384 * 1024; const float* nw = IN(I_NFW) + l * 1024;
#pragma unroll 2
    for (int i = gt; i < 16384 * 64; i += NGT) {
        const f32x4* up = (const f32x4*)(U + (size_t)i * 16); const f32x4* wp = (const f32x4*)(nw + (i & 63) * 16); const f32x4* vp = (const f32x4*)(V + (size_t)i * 16);
        f32x4 a[4], b[4];
#pragma unroll
        for (int c = 0; c < 4; ++c) { a[c] = up[c] * wp[c]; b[c] = vp[c]; }
        float au = 0.f, av = 0.f;
#pragma unroll
        for (int c = 0; c < 4; ++c) { au = fmaxf(au, fmaxf(fmaxf(fabsf(a[c][0]), fabsf(a[c][1])), fmaxf(fabsf(a[c][2]), fabsf(a[c][3])))); av = fmaxf(av, fmaxf(fmaxf(fabsf(b[c][0]), fabsf(b[c][1])), fmaxf(fabsf(b[c][2]), fabsf(b[c][3])))); }
        au = wave_max64(au); av = wave_max64(av);
        const float su = au > 0.f ? au * (1.0f / 6.0f) : 1.0f, sv = av > 0.f ? av * (1.0f / 6.0f) : 1.0f;
        unsigned u0, u1, v0, v1;
        quant_row16(a, 1.0f / su, u0, u1); quant_row16(b, 1.0f / sv, v0, v1);
        const int e = i >> 6, bl = i & 63;
        *(uint2*)(C.ws + WS_UT4 + (size_t)e * 512 + bl * 8) = make_uint2(u0, u1);
        *(uint2*)(C.ws + WS_VT4 + ((size_t)(bl >> 3) * 16384 + e) * 64 + (bl & 7) * 8) = make_uint2(v0, v1);
        if (bl == 0) *(float2*)(C.ws + WS_SCL + (size_t)e * 8) = make_float2(su, sv); }
    const float* P = IN(I_P) + (size_t)l * NT * 256;
#pragma unroll 4
    for (int i = gt; i < NT * 32; i += NGT) { const f32x4 a = *(const f32x4*)(P + (size_t)i * 8), b = *(const f32x4*)(P + (size_t)i * 8 + 4);
        *(v4u*)(WSP(bf16, WS_PB) + (size_t)i * 8) = (v4u){pk2(a[0], a[1]), pk2(a[2], a[3]), pk2(b[0], b[1]), pk2(b[2], b[3])}; }
}

typedef float f32x2 __attribute__((ext_vector_type(2)));
#define DPP_ADD(v, ctrl) ((v) + __builtin_bit_cast(float, __builtin_amdgcn_update_dpp(0, __builtin_bit_cast(int, (v)), (ctrl), 0xF, 0xF, true)))
__device__ __forceinline__ float row16_sum(float v) {
    v = DPP_ADD(v, 0xB1); v = DPP_ADD(v, 0x4E); v = DPP_ADD(v, 0x141); v = DPP_ADD(v, 0x140); return v;
}
__device__ __forceinline__ float wave_sum_fast(float v) { v = row16_sum(v); v += __shfl_xor(v, 16); v += __shfl_xor(v, 32); return v; }
typedef int v8i_t __attribute__((ext_vector_type(8)));
#define FP4X2(w, b) __builtin_amdgcn_cvt_scalef32_pk_f32_fp4((w), 1.0f, (b))

typedef unsigned u32x2_t __attribute__((ext_vector_type(2)));
constexpr int EU_TOK = 4, EU_CAP = 128 * EU_TOK, EU_WAVE_LDS = 8192 + 1024 * EU_TOK + 2 * 4 * EU_CAP;
__device__ __forceinline__ int eu_build(const v4u (&E)[2], int c, LAS unsigned* wl, int lane) {
    int base = 0; const unsigned long long lt = (1ull << lane) - 1ull;
#pragma unroll
    for (int q = 0; q < 2; ++q)
#pragma unroll
        for (int j = 0; j < 4; ++j) { const unsigned e = E[q][j]; const bool in = (int)(e >> 11) == c; const unsigned long long m = __ballot(in);
            if (in) wl[base + __popcll(m & lt)] = e | ((unsigned)(q * 256 + 4 * lane + j) << 14);
            base += __popcll(m); }
    if (lane < 16 && base + lane < EU_CAP) wl[base + lane] = (unsigned)(c << 11) | 0x80000000u;
    return base;
}
#define EU_STEP(st) { const v4u a_ = *(const LAS v4u*)((((st) & 3) == 0 ? pa0 : (((st) & 3) == 1 ? pa1 : (((st) & 3) == 2 ? pa2 : pa3))) + 256 * ((st) >> 2)); \
        const v4u b0 = *(const LAS v4u*)(((st) & 1 ? p10 : p00) + 256 * ((st) >> 1)), b1 = *(const LAS v4u*)(((st) & 1 ? p11 : p01) + 256 * ((st) >> 1)); \
        const v8i_t bb = {(int)b0[0], (int)b0[1], (int)b0[2], (int)b0[3], (int)b1[0], (int)b1[1], (int)b1[2], (int)b1[3]}; \
        const v8i_t aa = {(int)a_[0], (int)a_[1], (int)a_[2], (int)a_[3], 0, 0, 0, 0}; \
        d = __builtin_amdgcn_mfma_scale_f32_16x16x128_f8f6f4(aa, bb, d, 4, 0, 0, 0x7f7f7f7f, 0, 0x7f7f7f7f); }
__device__ __forceinline__ void eu_block_loads(v4u (&EN)[2], v4u (&XN)[EU_TOK], f32x4 (&sq)[4], const int* EID, const unsigned char* XQ, const float* SSQ, int blk, int lane) {
    const GAS v4u* ep = (const GAS v4u*)(EID + (size_t)blk * EU_CAP) + lane;
#pragma unroll
    for (int q = 0; q < 2; ++q) EN[q] = ep[64 * q];
    const GAS v4u* xp = (const GAS v4u*)(XQ + (size_t)blk * (1024 * EU_TOK)) + lane;
#pragma unroll
    for (int s = 0; s < EU_TOK; ++s) XN[s] = xp[64 * s];
    { const GAS f32x4* sp = (const GAS f32x4*)(SSQ + (size_t)(blk * EU_TOK + (lane & 3)) * 16); sq[0] = sp[0]; sq[1] = sp[1]; sq[2] = sp[2]; sq[3] = sp[3]; }
}
__device__ __forceinline__ float eu_rstd(const f32x4 (&sq)[4]) {
    const f32x4 a = sq[0], b = sq[1], c = sq[2], d = sq[3];
    const float s = (((a[0] + a[1]) + (a[2] + a[3])) + ((b[0] + b[1]) + (b[2] + b[3]))) + (((c[0] + c[1]) + (c[2] + c[3])) + ((d[0] + d[1]) + (d[2] + d[3])));
    return 1.0f / sqrtf(s * (1.0f / 1024.0f) + 1e-6f);
}
__device__ __forceinline__ void phase_experts_u(Ctx C, const Args& A) {
    PHASE_ENTER(C);
    const int lane = C.lane; const int ncls = C.G >> 3;
    if (C.bid >= ncls * 8) return;
    const int c = C.bid & 7; const int wi = (C.bid >> 3) * NWAVES + C.wave, NWC = ncls * NWAVES;
    const GAS unsigned char* UT = (const GAS unsigned char*)(C.ws + WS_UT4); const GAS u32x2_t* SC2 = (const GAS u32x2_t*)(C.ws + WS_SCL);
    const int* EID = WSP(int, WS_EID); const GAS float* GATE = (const GAS float*)WSP(float, WS_GATE); GAS unsigned char* COEF = (GAS unsigned char*)(C.ws + WS_COEF);
    const unsigned char* XQ = C.ws + WS_XQ; const float* SSQ = WSP(float, WS_SSQ0);
    LAS unsigned char* at = C.lds + C.wave * EU_WAVE_LDS; LAS unsigned char* xq = at + 8192; LAS unsigned* wl = (LAS unsigned*)(xq + 1024 * EU_TOK);
    constexpr int NBLK = NT / EU_TOK;
    int blk = wi; if (blk >= NBLK) return;
    v4u EN[2], XN[EU_TOK]; f32x4 rsn[4];
    eu_block_loads(EN, XN, rsn, EID, XQ, SSQ, blk, lane);
    const int kg = lane >> 4, i16 = lane & 15, s4 = lane & 3;
    const int mB = kg | (s4 << 2);
    const LAS unsigned char* xr = xq + s4 * 1024;
    const LAS unsigned char* p00 = xr + 16 * (0 ^ mB); const LAS unsigned char* p01 = xr + 16 * (4 ^ mB); const LAS unsigned char* p10 = xr + 16 * (8 ^ mB); const LAS unsigned char* p11 = xr + 16 * (12 ^ mB);
    const int mA = kg ^ i16;
    const LAS unsigned char* ar = at + 512 * i16;
    const LAS unsigned char* pa0 = ar + 16 * (0 ^ mA); const LAS unsigned char* pa1 = ar + 16 * (4 ^ mA); const LAS unsigned char* pa2 = ar + 16 * (8 ^ mA); const LAS unsigned char* pa3 = ar + 16 * (12 ^ mA);
    const GAS unsigned char* usrc[8];
    const int hrow = lane >> 5, hpos = lane & 31;
    struct UMeta { u32x2_t sc; float gate; unsigned ent; };
#define EU_PREP(WL, G, TOK0, M) { const LAS unsigned* wg_ = (WL) + 16 * (G); unsigned erw[8]; \
        _Pragma("unroll") for (int j = 0; j < 8; ++j) erw[j] = wg_[2 * j + hrow]; \
        M.ent = wg_[i16]; \
        asm volatile("s_waitcnt lgkmcnt(0)" : "+v"(erw[0]), "+v"(erw[1]), "+v"(erw[2]), "+v"(erw[3]), "+v"(erw[4]), "+v"(erw[5]), "+v"(erw[6]), "+v"(erw[7]), "+v"(M.ent) :: "memory"); \
        _Pragma("unroll") for (int j = 0; j < 8; ++j) { const int r = 2 * j + hrow; usrc[j] = UT + (size_t)(erw[j] & 0x3fffu) * 512 + 16 * (hpos ^ (r & 15)); } \
        { const GAS u32x2_t* sp_ = SC2 + (M.ent & 0x3fffu); const GAS float* gp_ = GATE + (size_t)(TOK0) * 128 + ((M.ent >> 14) & 1023u); \
          asm volatile("global_load_dwordx2 %0, %1, off" : "=v"(M.sc) : "v"(sp_) : "memory"); asm volatile("global_load_dword %0, %1, off" : "=v"(M.gate) : "v"(gp_) : "memory"); } }
#define EU_PIECE(j) { __builtin_amdgcn_sched_barrier(0); __builtin_amdgcn_global_load_lds((const GAS unsigned*)usrc[j], (LAS unsigned*)(at + 1024 * (j)), 16, 0, 0); __builtin_amdgcn_sched_barrier(0); }
#define EU_DMA(WL, G, TOK0, M) { EU_PREP(WL, G, TOK0, M) EU_PIECE(0) EU_PIECE(1) EU_PIECE(2) EU_PIECE(3) EU_PIECE(4) EU_PIECE(5) EU_PIECE(6) EU_PIECE(7) }
#define EU_MM(st) { const v8i_t bb = {(int)bR[2 * (st)][0], (int)bR[2 * (st)][1], (int)bR[2 * (st)][2], (int)bR[2 * (st)][3], (int)bR[2 * (st) + 1][0], (int)bR[2 * (st) + 1][1], (int)bR[2 * (st) + 1][2], (int)bR[2 * (st) + 1][3]}; \
        const v8i_t aa = {(int)aR[st][0], (int)aR[st][1], (int)aR[st][2], (int)aR[st][3], 0, 0, 0, 0}; \
        d = __builtin_amdgcn_mfma_scale_f32_16x16x128_f8f6f4(aa, bb, d, 4, 0, 0, 0x7f7f7f7f, 0, 0x7f7f7f7f); }
#define EU_LOADB() { _Pragma("unroll") for (int st = 0; st < 8; ++st) { bR[2 * st] = *(const LAS v4u*)(((st) & 1 ? p10 : p00) + 256 * ((st) >> 1)); bR[2 * st + 1] = *(const LAS v4u*)(((st) & 1 ? p11 : p01) + 256 * ((st) >> 1)); } \
        asm volatile("s_waitcnt lgkmcnt(0)" ::: "memory"); }
#define EU_UNIT(CUR, NXT) { \
        asm volatile("s_waitcnt vmcnt(0)" : "+v"(CUR.sc), "+v"(CUR.gate) :: "memory");     \
        v4u aR[8]; \
        _Pragma("unroll") for (int st = 0; st < 8; ++st) aR[st] = *(const LAS v4u*)((((st) & 3) == 0 ? pa0 : (((st) & 3) == 1 ? pa1 : (((st) & 3) == 2 ? pa2 : pa3))) + 256 * ((st) >> 2)); \
        asm volatile("s_waitcnt lgkmcnt(0)" ::: "memory"); \
        const bool last = g + 1 >= ng; const bool nextblk = last && hasn; \
        if (nextblk) nn = eu_build(EN, c, wl + (par ^ 1) * EU_CAP, lane); \
        { const LAS unsigned* wln = wl + (nextblk ? par ^ 1 : par) * EU_CAP; const int gn = last ? 0 : g + 1; const int tokn = nextblk ? blkn * EU_TOK : tok0; \
          EU_PREP(wln, gn, tokn, NXT) }     \
        f32x4 d = (f32x4){0.f, 0.f, 0.f, 0.f}; \
        EU_MM(0) asm volatile("" : "+v"(d)); EU_PIECE(0) EU_MM(1) asm volatile("" : "+v"(d)); EU_PIECE(1) EU_MM(2) asm volatile("" : "+v"(d)); EU_PIECE(2) EU_MM(3) asm volatile("" : "+v"(d)); EU_PIECE(3) \
        EU_MM(4) asm volatile("" : "+v"(d)); EU_PIECE(4) EU_MM(5) asm volatile("" : "+v"(d)); EU_PIECE(5) EU_MM(6) asm volatile("" : "+v"(d)); EU_PIECE(6) EU_MM(7) asm volatile("" : "+v"(d)); EU_PIECE(7)     \
        const unsigned ent = CUR.ent; const unsigned idx = (ent >> 14) & 1023u; \
        const int slot = (int)(ent >> 21) & 3; \
        const int src = (slot + 16 * (i16 >> 2)) << 2; \
        const float v0 = __int_as_float(__builtin_amdgcn_ds_bpermute(src, __float_as_int(d[0]))), v1 = __int_as_float(__builtin_amdgcn_ds_bpermute(src, __float_as_int(d[1]))); \
        const float v2 = __int_as_float(__builtin_amdgcn_ds_bpermute(src, __float_as_int(d[2]))), v3 = __int_as_float(__builtin_amdgcn_ds_bpermute(src, __float_as_int(d[3]))); \
        const int r4 = i16 & 3; const float val = r4 == 0 ? v0 : (r4 == 1 ? v1 : (r4 == 2 ? v2 : v3)); \
        const float rs = __int_as_float(__builtin_amdgcn_ds_bpermute(slot << 2, __float_as_int(rsl))); \
        const float coef = CUR.gate * __uint_as_float(CUR.sc.y) * gelu1(val * rs * __uint_as_float(CUR.sc.x)); \
        { const float c64 = __builtin_amdgcn_fmed3f(coef * 64.0f, -448.0f, 448.0f); const int c8 = __builtin_amdgcn_cvt_pk_fp8_f32(c64, c64, 0, false); \
          const unsigned pos = idx & 127u; \
          if (lane < 16 && (int)ent >= 0) COEF[(size_t)(tok0 + (idx >> 7)) * 128 + 16 * (pos & 7u) + (pos >> 3)] = (unsigned char)c8; } \
        asm volatile("s_waitcnt lgkmcnt(0)" ::: "memory"); \
        if (!last) ++g; \
        else { if (!hasn) break; \
              \
            _Pragma("unroll") for (int s = 0; s < EU_TOK; ++s) *(LAS v4u*)(xq + s * 1024 + 16 * (lane ^ ((s & 3) << 2))) = XN[s]; \
            EU_LOADB() rsl = eu_rstd(rsn); blk = blkn; tok0 = blk * EU_TOK; ng = nn > 16 ? (nn + 15) >> 4 : 1; g = 0; par ^= 1; \
            blkn = blk + NWC; hasn = blkn < NBLK; \
            if (hasn) eu_block_loads(EN, XN, rsn, EID, XQ, SSQ, blkn, lane); } }
    int par = 0, nn = 0, g = 0;
    int ng; { const int n0 = eu_build(EN, c, wl, lane); ng = n0 > 16 ? (n0 + 15) >> 4 : 1; }
#pragma unroll
    for (int s = 0; s < EU_TOK; ++s) *(LAS v4u*)(xq + s * 1024 + 16 * (lane ^ ((s & 3) << 2))) = XN[s];
    v4u bR[16]; EU_LOADB()
    float rsl = eu_rstd(rsn); int tok0 = blk * EU_TOK;
    int blkn = blk + NWC; bool hasn = blkn < NBLK;
    if (hasn) eu_block_loads(EN, XN, rsn, EID, XQ, SSQ, blkn, lane);
    UMeta MA, MB;
    EU_DMA(wl, 0, tok0, MA)
    while (true) {
        EU_UNIT(MA, MB)
        EU_UNIT(MB, MA)
    }
#undef EU_UNIT
#undef EU_MM
#undef EU_LOADB
#undef EU_DMA
#undef EU_PIECE
#undef EU_PREP
}

typedef int v2i_t __attribute__((ext_vector_type(2)));
__device__ __forceinline__ void ev_dma(LAS unsigned char* tile, const GAS unsigned char* VTl, const v4u e0, const v4u e1) {
#pragma unroll
    for (int it = 0; it < 4; ++it) __builtin_amdgcn_global_load_lds((const GAS unsigned*)(VTl + (size_t)(e0[it] << 6)), (LAS unsigned*)(tile + 1024 * it), 16, 0, 0);
#pragma unroll
    for (int it = 0; it < 4; ++it) __builtin_amdgcn_global_load_lds((const GAS unsigned*)(VTl + (size_t)(e1[it] << 6)), (LAS unsigned*)(tile + 1024 * (4 + it)), 16, 0, 0);
}
#define EV_TR(dst, base, off) asm volatile("ds_read_b64_tr_b4 %0, %1 offset:" #off : "=v"(dst) : "v"(base) : "memory")
#define EV_MMA(ct, T0, T1) { const v8i_t aa = {T0.x, T0.y, T1.x, T1.y, 0, 0, 0, 0}; \
        sel = __builtin_amdgcn_mfma_scale_f32_16x16x128_f8f6f4(aa, bb, sel, 4, 0, 0, 0x7f7f7f7f, 0, jc == (ct) ? 0x79797979 : 0); }
__device__ __forceinline__ void phase_experts_v(Ctx C, const Args& A, const bf16* hin, bf16* hbout, float* ssq_out) {
    PHASE_ENTER(C);
    const int lane = C.lane; const int ncls = C.G >> 3;
    if (C.bid >= ncls * 8) return;
    const int x = C.bid & 7; const int wi = (C.bid >> 3) * NWAVES + C.wave, NWC = ncls * NWAVES;
    const int ps = lane >> 2, q4 = lane & 3, r16 = lane & 15, kg = lane >> 4, jc = lane & 7;
    const GAS unsigned char* VTl = (const GAS unsigned char*)(C.ws + WS_VT4) + (size_t)x * 16384 * 64 + 16 * (q4 ^ ((ps >> 2) & 3));
    const GAS int* EID = (const GAS int*)WSP(int, WS_EID) + 8 * ps; const GAS unsigned char* COEF = (const GAS unsigned char*)(C.ws + WS_COEF) + 16 * kg;
    const int hoff = 128 * x + 16 * jc + 4 * kg;
    LAS unsigned char* tile0 = C.lds + C.wave * 16384;
    const int fsw = (r16 >> 2) & 3; const int rowoff = 64 * (32 * kg + r16);
    int t = wi; if (t >= NT) return;
    v4u ea0, ea1, eb0, eb1, cb0, cb1; u32x2_t hres, ypk = {0u, 0u}; float yss = 0.f; int tp = -1;
    { const GAS v4u* p = (const GAS v4u*)(EID + (size_t)t * 128); ea0 = p[0]; ea1 = p[1]; }
    ev_dma(tile0, VTl, ea0, ea1);
    { const GAS unsigned char* cp = COEF + (size_t)t * 128; cb0 = *(const GAS v4u*)cp; cb1 = *(const GAS v4u*)(cp + 64); hres = *(const GAS u32x2_t*)(hin + (size_t)t * DM + hoff); }
    int t1 = t + NWC < NT ? t + NWC : t;
    { const GAS v4u* p = (const GAS v4u*)(EID + (size_t)t1 * 128); eb0 = p[0]; eb1 = p[1]; }
    int par = 0;
    while (true) {
        asm volatile("s_waitcnt vmcnt(0)" ::: "memory");
        const v8i_t bb = {(int)cb0[0], (int)cb0[1], (int)cb0[2], (int)cb0[3], (int)cb1[0], (int)cb1[1], (int)cb1[2], (int)cb1[3]};
        const u32x2_t hcur = hres;
        LAS unsigned char* tile = tile0 + 8192 * par;
        const bool more = t + NWC < NT;
        const GAS unsigned char* dsrc[8];
#pragma unroll
        for (int it = 0; it < 4; ++it) { dsrc[it] = VTl + (size_t)(eb0[it] << 6); dsrc[4 + it] = VTl + (size_t)(eb1[it] << 6); }
#pragma unroll
        for (int it = 0; it < 8; ++it) asm volatile("" : "+v"(dsrc[it]));
        if (tp >= 0) { if ((lane & 8) == 0) *(GAS u32x2_t*)(hbout + (size_t)tp * DM + hoff) = ypk;
                       if (lane < 2) ((GAS float*)ssq_out)[(size_t)tp * 16 + 2 * x + lane] = lane == 0 ? yss : 0.f; }
        { const GAS unsigned char* cp = COEF + (size_t)t1 * 128; cb0 = *(const GAS v4u*)cp; cb1 = *(const GAS v4u*)(cp + 64); hres = *(const GAS u32x2_t*)(hin + (size_t)t1 * DM + hoff); }
        const int t2 = t1 + NWC < NT ? t1 + NWC : t1;
        { const GAS v4u* p = (const GAS v4u*)(EID + (size_t)t2 * 128); eb0 = p[0]; eb1 = p[1]; }
        LAS unsigned char* tilen = tile0 + 8192 * (par ^ 1);
        const unsigned o0 = (unsigned)(size_t)(tile + rowoff + 16 * (0 ^ fsw)), o1 = (unsigned)(size_t)(tile + rowoff + 16 * (1 ^ fsw));
        const unsigned o2 = (unsigned)(size_t)(tile + rowoff + 16 * (2 ^ fsw)), o3 = (unsigned)(size_t)(tile + rowoff + 16 * (3 ^ fsw));
        v2i_t a00, a01, a10, a11, a20, a21, a30, a31, a40, a41, a50, a51, a60, a61, a70, a71;
        EV_TR(a00, o0, 0); EV_TR(a01, o0, 1024); EV_TR(a10, o0, 8); EV_TR(a11, o0, 1032);
        EV_TR(a20, o1, 0); EV_TR(a21, o1, 1024); EV_TR(a30, o1, 8); EV_TR(a31, o1, 1032);
        EV_TR(a40, o2, 0); EV_TR(a41, o2, 1024); EV_TR(a50, o2, 8); EV_TR(a51, o2, 1032);
        EV_TR(a60, o3, 0); EV_TR(a61, o3, 1024); EV_TR(a70, o3, 8); EV_TR(a71, o3, 1032);
        asm volatile("s_waitcnt lgkmcnt(0)" : "+v"(a00), "+v"(a01), "+v"(a10), "+v"(a11), "+v"(a20), "+v"(a21), "+v"(a30), "+v"(a31), "+v"(a40), "+v"(a41), "+v"(a50), "+v"(a51), "+v"(a60), "+v"(a61), "+v"(a70), "+v"(a71) :: "memory");
        f32x4 sel = (f32x4){0.f, 0.f, 0.f, 0.f};
#define EV_PIECE(it, E) { asm volatile("" : "+v"(sel)); __builtin_amdgcn_sched_barrier(0); __builtin_amdgcn_global_load_lds((const GAS unsigned*)dsrc[it], (LAS unsigned*)(tilen + 1024 * (it)), 16, 0, 0); __builtin_amdgcn_sched_barrier(0); }
        EV_MMA(0, a00, a01) EV_PIECE(0, ec0[0]) EV_MMA(1, a10, a11) EV_PIECE(1, ec0[1]) EV_MMA(2, a20, a21) EV_PIECE(2, ec0[2]) EV_MMA(3, a30, a31) EV_PIECE(3, ec0[3])
        EV_MMA(4, a40, a41) EV_PIECE(4, ec1[0]) EV_MMA(5, a50, a51) EV_PIECE(5, ec1[1]) EV_MMA(6, a60, a61) EV_PIECE(6, ec1[2]) EV_MMA(7, a70, a71) EV_PIECE(7, ec1[3])
#undef EV_PIECE
        const float y0 = bflo(hcur.x) + sel[0], y1 = bfhi(hcur.x) + sel[1], y2 = bflo(hcur.y) + sel[2], y3 = bfhi(hcur.y) + sel[3];
        ypk.x = pg8::cvt_pk_bf16(y0, y1); ypk.y = pg8::cvt_pk_bf16(y2, y3);
        const float s2 = (lane & 8) == 0 ? (y0 * y0 + y1 * y1) + (y2 * y2 + y3 * y3) : 0.f;
        yss = wave_sum_fast(s2); tp = t;
        asm volatile("s_waitcnt lgkmcnt(0)" ::: "memory");
        if (!more) break;
        t = t1; t1 = t2; par ^= 1;
    }
    if ((lane & 8) == 0) *(GAS u32x2_t*)(hbout + (size_t)tp * DM + hoff) = ypk;
    if (lane < 2) ((GAS float*)ssq_out)[(size_t)tp * 16 + 2 * x + lane] = lane == 0 ? yss : 0.f;
}

template <int WIN> __device__ __forceinline__ void pool_run(const bf16* U, bf16* Y, int b, int p0, int cp) {
    const unsigned* ub = (const unsigned*)(U + (size_t)b * SEQ * DM + 2 * cp);
    unsigned w[16 + WIN - 1];
#pragma unroll
    for (int i = 0; i < 16 + WIN - 1; ++i) { const int pos = p0 - (WIN - 1) + i; w[i] = pos >= 0 ? ub[(size_t)pos * (DM / 2)] : 0u; }
    float s0 = 0.f, s1 = 0.f;
#pragma unroll
    for (int i = 0; i < WIN - 1; ++i) { s0 += bflo(w[i]); s1 += bfhi(w[i]); }
    unsigned* yb = (unsigned*)(Y + (size_t)b * SEQ * DM + 2 * cp);
#pragma unroll
    for (int t = 0; t < 16; ++t) { const int pos = p0 + t; const float c0 = bflo(w[WIN - 1 + t]), c1 = bfhi(w[WIN - 1 + t]); s0 += c0; s1 += c1;
        const float inv = 1.0f / (float)(pos + 1 < WIN ? pos + 1 : WIN);
        yb[(size_t)pos * (DM / 2)] = pk2(s0 * inv - c0, s1 * inv - c1);
        s0 -= bflo(w[t]); s1 -= bfhi(w[t]); }
}
__device__ __forceinline__ void phase_pool(Ctx C, const Args& A) {
    PHASE_ENTER(C);
    const bf16* U = WSP(bf16, WS_U); bf16* Y = WSP(bf16, WS_A1);
    const int cp = C.tid & 255, th = C.tid >> 8, grp = (C.wave & 3);
    for (int it = C.bid; it < 1024; it += C.G) { const int b = it >> 8, p0 = (it & 255) * 32 + th * 16;
        if (grp == 0) pool_run<2>(U, Y, b, p0, cp); else if (grp == 1) pool_run<4>(U, Y, b, p0, cp); else if (grp == 2) pool_run<8>(U, Y, b, p0, cp); else pool_run<16>(U, Y, b, p0, cp); }
}
__device__ __forceinline__ void s5_wave_consts(const Ctx& C, int g, int lane, float& abr, float& abi, bf16x8 (&bfr)[8]) {
    const float* s5 = WSP(float, WS_S5C); const int idx = g * 64 + lane, fr = lane & 15, fq = lane >> 4;
    abr = s5[S5_ABAR / 4 + 2 * idx]; abi = s5[S5_ABAR / 4 + 2 * idx + 1];
    const bf16* BB = (const bf16*)(C.ws + WS_S5C + S5_BB16) + (size_t)g * 128 * 16;
#pragma unroll
    for (int ct = 0; ct < 8; ++ct) { bf16x8 z = {0, 0, 0, 0, 0, 0, 0, 0}; if (fq < 2) z = *(const bf16x8*)(BB + (16 * ct + fr) * 16 + 8 * fq); bfr[ct] = z; }
}
__device__ __forceinline__ void s5_bu_tile(const bf16x8 afr, const bf16x8 (&bfr)[8], LAS float* BUL, int fr, int fq) {
#pragma unroll
    for (int ct = 0; ct < 8; ++ct) { const f32x4 d = __builtin_amdgcn_mfma_f32_16x16x32_bf16(afr, bfr[ct], (f32x4){0.f, 0.f, 0.f, 0.f}, 0, 0, 0);
#pragma unroll
        for (int r = 0; r < 4; ++r) BUL[(4 * fq + r) * 132 + (ct >> 2) * 64 + (ct & 3) * 16 + fr] = d[r]; }
}
__device__ __forceinline__ void phase_s5_local(Ctx C, const Args& A) {
    PHASE_ENTER(C);
    const int lane = C.lane, fr = lane & 15, fq = lane >> 4; const int gw = C.bid * NWAVES + C.wave, NGW = C.G * NWAVES;
    LAS float* BUL = (LAS float*)(C.lds + C.wave * 8448);
    int gprev = -1; float abr = 0.f, abi = 0.f; bf16x8 bfr[8];
    for (int it = gw; it < 16384; it += NGW) { const int g = it & 31, bn = it >> 5;
        if (g != gprev) { s5_wave_consts(C, g, lane, abr, abi, bfr); gprev = g; }
        const bf16* ubase = WSP(bf16, WS_U) + (size_t)bn * 64 * DM + 512 + g * 16;
        bf16x8 afr[4];
#pragma unroll
        for (int sub = 0; sub < 4; ++sub) { bf16x8 z = {0, 0, 0, 0, 0, 0, 0, 0}; if (fq < 2) z = *(const bf16x8*)(ubase + (size_t)(sub * 16 + fr) * DM + 8 * fq); afr[sub] = z; }
        float xr = 0.f, xi = 0.f;
#pragma unroll
        for (int sub = 0; sub < 4; ++sub) {
            s5_bu_tile(afr[sub], bfr, BUL, fr, fq);
            asm volatile("s_waitcnt lgkmcnt(0)" ::: "memory");
#pragma unroll
            for (int tt = 0; tt < 16; ++tt) { const float br = BUL[tt * 132 + lane], bi = BUL[tt * 132 + 64 + lane]; const float nr = abr * xr - abi * xi + br, ni = abr * xi + abi * xr + bi; xr = nr; xi = ni; }
            asm volatile("s_waitcnt lgkmcnt(0)" ::: "memory");
        }
        float* e = WSP(float, WS_E) + ((size_t)(bn * 32 + g) * 64 + lane) * 2; e[0] = xr; e[1] = xi; }
}
__device__ __forceinline__ void phase_s5_carry(Ctx C, const Args& A) {
    PHASE_ENTER(C);
    for (int gid = C.bid * NTHREADS + C.tid; gid < 8192; gid += C.G * NTHREADS) { const int p = gid & 63, g = (gid >> 6) & 31, b = gid >> 11;
        const float* s5 = WSP(float, WS_S5C); const float ar = s5[S5_A64 / 4 + 2 * (g * 64 + p)], ai = s5[S5_A64 / 4 + 2 * (g * 64 + p) + 1];
        float2* e = (float2*)WSP(float, WS_E) + ((size_t)(b * 128) * 32 + g) * 64 + p; float cr = 0.f, ci = 0.f;
#pragma unroll 8
        for (int n = 0; n < NCHUNK; ++n) { const float2 tv = e[(size_t)n * 2048]; e[(size_t)n * 2048] = make_float2(cr, ci); const float nr = ar * cr - ai * ci + tv.x, ni = ar * ci + ai * cr + tv.y; cr = nr; ci = ni; } }
}
__device__ __forceinline__ void phase_s5_out(Ctx C, const Args& A) {
    PHASE_ENTER(C);
    const int lane = C.lane, fr = lane & 15, fq = lane >> 4; const int gw = C.bid * NWAVES + C.wave, NGW = C.G * NWAVES;
    LAS float* BUL = (LAS float*)(C.lds + C.wave * 12800);
    LAS bf16* XL = (LAS bf16*)(C.lds + C.wave * 12800 + 8448);
    int gprev = -1; float abr = 0.f, abi = 0.f; bf16x8 bfr[8]; bf16x8 cm[4]; float dsk = 0.f;
    for (int it = gw; it < 16384; it += NGW) { const int g = it & 31, bn = it >> 5;
        if (g != gprev) { s5_wave_consts(C, g, lane, abr, abi, bfr); gprev = g;
            const bf16* CM = (const bf16*)(C.ws + WS_S5C + S5_CM) + (size_t)(g * 16 + fr) * 128;
#pragma unroll
            for (int kk = 0; kk < 4; ++kk) cm[kk] = *(const bf16x8*)(CM + kk * 32 + 8 * fq);
            dsk = IN(I_DSK)[g * 16 + fr]; }
        const bf16* ubase = WSP(bf16, WS_U) + (size_t)bn * 64 * DM + 512 + g * 16;
        bf16x8 afr[4];
#pragma unroll
        for (int sub = 0; sub < 4; ++sub) { bf16x8 z = {0, 0, 0, 0, 0, 0, 0, 0}; if (fq < 2) z = *(const bf16x8*)(ubase + (size_t)(sub * 16 + fr) * DM + 8 * fq); afr[sub] = z; }
        const float* e = WSP(float, WS_E) + ((size_t)(bn * 32 + g) * 64 + lane) * 2; float xr = e[0], xi = e[1];
        unsigned short uskip[4][4];
#pragma unroll
        for (int sub = 0; sub < 4; ++sub)
#pragma unroll
            for (int r = 0; r < 4; ++r) uskip[sub][r] = ubase[(size_t)(sub * 16 + 4 * fq + r) * DM + fr];
#pragma unroll
        for (int sub = 0; sub < 4; ++sub) {
            s5_bu_tile(afr[sub], bfr, BUL, fr, fq);
            asm volatile("s_waitcnt lgkmcnt(0)" ::: "memory");
#pragma unroll
            for (int tt = 0; tt < 16; ++tt) { const float br = BUL[tt * 132 + lane], bi = BUL[tt * 132 + 64 + lane]; const float nr = abr * xr - abi * xi + br, ni = abr * xi + abi * xr + bi; xr = nr; xi = ni;
                XL[tt * 136 + lane] = (bf16)f2bf(xr); XL[tt * 136 + 64 + lane] = (bf16)f2bf(xi); }
            asm volatile("s_waitcnt lgkmcnt(0)" ::: "memory");
            f32x4 acc = (f32x4){0.f, 0.f, 0.f, 0.f};
#pragma unroll
            for (int kk = 0; kk < 4; ++kk) { const bf16x8 a = *(const LAS bf16x8*)(XL + fr * 136 + kk * 32 + 8 * fq); acc = __builtin_amdgcn_mfma_f32_16x16x32_bf16(a, cm[kk], acc, 0, 0, 0); }
#pragma unroll
            for (int r = 0; r < 4; ++r) { const size_t tok = (size_t)bn * 64 + sub * 16 + 4 * fq + r; const float uv = bf2f(uskip[sub][r]);
                WSP(bf16, WS_Z)[tok * 512 + g * 16 + fr] = (bf16)f2bf(gelu1(acc[r] + dsk * uv)); }
            asm volatile("s_waitcnt lgkmcnt(0)" ::: "memory");
        } }
}
__device__ __forceinline__ void phase_final_norm(Ctx C, const Args& A, const bf16* hin) {
    PHASE_ENTER(C);
    const int lane = C.lane; const int gw = C.bid * NWAVES + C.wave, NGW = C.G * NWAVES; const f32x4* wv = (const f32x4*)IN(I_FNW) + 4 * lane;
#pragma unroll 4
    for (int m = gw; m < NT; m += NGW) { const v4u* hr = (const v4u*)(hin + (size_t)m * DM + 16 * lane); f32x4 v[4]; float s = 0.f;
#pragma unroll
        for (int c = 0; c < 2; ++c) { const v4u hw = hr[c]; v[2 * c] = (f32x4){bflo(hw[0]), bfhi(hw[0]), bflo(hw[1]), bfhi(hw[1])}; v[2 * c + 1] = (f32x4){bflo(hw[2]), bfhi(hw[2]), bflo(hw[3]), bfhi(hw[3])}; }
#pragma unroll
        for (int j = 0; j < 4; ++j) s += (v[j][0] * v[j][0] + v[j][1] * v[j][1]) + (v[j][2] * v[j][2] + v[j][3] * v[j][3]);
        const float rs = 1.0f / sqrtf(wave_sum(s) * (1.0f / DM) + EPS);
        f32x4* o = (f32x4*)(C.h + (size_t)m * DM + 16 * lane);
#pragma unroll
        for (int j = 0; j < 4; ++j) o[j] = v[j] * rs * wv[j]; }
}

constexpr int CW_BAR = 1024;

__global__ void __launch_bounds__(NTHREADS, 2) mk_fwd(Args A) {
    extern __shared__ __attribute__((aligned(16))) unsigned char lds_raw[];
    Ctx C;
    C.lds = (LAS unsigned char*)lds_raw; C.tid = threadIdx.x; C.lane = C.tid & 63; C.wave = __builtin_amdgcn_readfirstlane(C.tid >> 6); C.G = gridDim.x; C.bid = blockIdx.x;
    C.h = A.out; C.ws = A.ws;
    volatile LAS unsigned* MISC = (volatile LAS unsigned*)(C.lds + MISC_OFF);
    for (int u = C.tid; u < (LDS_BYTES - RING_BYTES) / 4; u += NTHREADS) ((LAS unsigned*)(C.lds + RING_BYTES))[u] = 0u;
    __syncthreads();
    if (C.tid == 0) {
#pragma unroll
        for (int i = 0; i < N_IN; ++i) ((LAS unsigned long long*)(C.lds + PTR_OFF))[i] = (unsigned long long)A.in[i];
    }
    __syncthreads();
    XcdBarrier bar = xcd_barrier_post((unsigned*)(C.ws + WS_CTL) + CW_BAR, MISC + 8);
#define GBAR() xcd_barrier(bar)
#define FRESH() do { asm volatile("" : "+s"(C.ws), "+s"(C.h)); C.ws = (unsigned char*)(GAS unsigned char*)C.ws; C.h = (float*)(GAS float*)C.h; } while (0)
#define GEMM(EpiT, E, Ap, Bp, Mv, Nv, Kv) do { pg8::Gemm g_{(const pg8::bf16_t*)(Ap), (const pg8::bf16_t*)(Bp), Mv, Nv, Kv}; pg8::StaticOrder S_; S_.init(Mv, Nv, C.G, C.bid); \
        pg8::gemm_phase<EpiT, pg8::StaticOrder, true, true>(C.lds, g_, S_, E); } while (0)
    float* SSQ0 = WSP(float, WS_SSQ0); float* SSQ1 = WSP(float, WS_SSQ1);
    bf16* A0 = WSP(bf16, WS_A0); bf16* A1 = WSP(bf16, WS_A1);

#ifndef PROBE_MASK
#define PROBE_MASK 0
#endif
#define REP(k) for (int rep_ = 0; rep_ < (((PROBE_MASK) >> (k)) & 1 ? 2 : 1); ++rep_)
    REP(4) phase_prologue(C, A);
    GBAR();
    REP(0) { FRESH(); { pg8::EpiBf16<0> E{(pg8::bf16_t*)WSP(bf16, WS_PROJ), PROJW, nullptr, 0, 0, 1.f}; GEMM(pg8::EpiBf16<0>, E, A0, WSP(bf16, WS_WIN0), NT, PROJW, DM); } }
    GBAR();
    REP(1) phase_kv(C, A);
    GBAR();
    phase_scan(C, A); GBAR();
    REP(1) phase_mix0_out(C, A);
    GBAR();
    REP(0) { FRESH(); { pg8::EpiRes E{IN(I_X), nullptr, (pg8::bf16_t*)A0, SSQ0, C.ws + WS_XQ}; GEMM(pg8::EpiRes, E, A1, WSP(bf16, WS_WOUT0), NT, DM, DM); } }
    GBAR();
    REP(0) { FRESH(); { pg8::EpiScoreT E{(pg8::bf16_t*)WSP(bf16, WS_SC), SSQ0}; GEMM(pg8::EpiScoreT, E, A0, WSP(bf16, WS_WEFF) + (size_t)0 * 2048 * 1024, NT, 2048, DM); } }
    GBAR();
    REP(2) phase_topk(C, A);
    REP(5) phase_convert_peer(C, A, 0, 0, C.G);
    GBAR();
    REP(8) phase_experts_u(C, A);
    GBAR();
    REP(9) phase_experts_v(C, A, A0, A1, SSQ1);
    __syncthreads();
    REP(0) { FRESH(); { pg8::EpiBf16<0> E{(pg8::bf16_t*)WSP(bf16, WS_PP), DM, nullptr, 0, 0, 1.f}; GEMM(pg8::EpiBf16<0>, E, WSP(bf16, WS_PB), WSP(bf16, WS_WP) + (size_t)0 * 1024 * 256, NT, DM, 256); } }
    GBAR();
    FRESH(); { pg8::EpiPle E{(const pg8::bf16_t*)A1, (const pg8::bf16_t*)WSP(bf16, WS_PP), (pg8::bf16_t*)A0, SSQ1, SSQ0}; GEMM(pg8::EpiPle, E, A1, WSP(bf16, WS_WG) + (size_t)0 * 1024 * 1024, NT, DM, DM); }
    GBAR();

    REP(0) { FRESH(); { pg8::EpiScaleBf16 E{(pg8::bf16_t*)WSP(bf16, WS_U), DM, SSQ0}; GEMM(pg8::EpiScaleBf16, E, A0, WSP(bf16, WS_WIN1), NT, DM, DM); } }
    GBAR();
    REP(6) { phase_s5_local(C, A); phase_pool(C, A); }
    GBAR();
    phase_s5_carry(C, A);
    phase_convert_peer(C, A, 1, 16, C.G - 16); GBAR();
    REP(7) phase_s5_out(C, A);
    GBAR();
    REP(0) { FRESH(); { pg8::EpiGlu E{(const pg8::bf16_t*)WSP(bf16, WS_Z), 512, IN(I_BGLU), (pg8::bf16_t*)A1, DM, 512}; GEMM(pg8::EpiGlu, E, WSP(bf16, WS_Z), WSP(bf16, WS_WGLU), NT, 512, 512); } }
    GBAR();
    FRESH(); { pg8::EpiRes E{nullptr, (const pg8::bf16_t*)A0, (pg8::bf16_t*)A0, SSQ0, C.ws + WS_XQ}; GEMM(pg8::EpiRes, E, A1, WSP(bf16, WS_WOUT1), NT, DM, DM); }
    GBAR();

    REP(0) { FRESH(); { pg8::EpiScoreT E{(pg8::bf16_t*)WSP(bf16, WS_SC), SSQ0}; GEMM(pg8::EpiScoreT, E, A0, WSP(bf16, WS_WEFF) + (size_t)1 * 2048 * 1024, NT, 2048, DM); } }
    GBAR();
    REP(2) phase_topk(C, A);
    GBAR();
    REP(8) phase_experts_u(C, A);
    GBAR();
    REP(9) phase_experts_v(C, A, A0, A1, SSQ1);
    __syncthreads();
    REP(0) { FRESH(); { pg8::EpiBf16<0> E{(pg8::bf16_t*)WSP(bf16, WS_PP), DM, nullptr, 0, 0, 1.f}; GEMM(pg8::EpiBf16<0>, E, WSP(bf16, WS_PB), WSP(bf16, WS_WP) + (size_t)1 * 1024 * 256, NT, DM, 256); } }
    GBAR();
    FRESH(); { pg8::EpiPle E{(const pg8::bf16_t*)A1, (const pg8::bf16_t*)WSP(bf16, WS_PP), (pg8::bf16_t*)A0, SSQ1, SSQ0}; GEMM(pg8::EpiPle, E, A1, WSP(bf16, WS_WG) + (size_t)1 * 1024 * 1024, NT, DM, DM); }
    GBAR();

    phase_final_norm(C, A, A0);
}

extern "C" void kernel_launch(void* const* d_in, const int* in_sizes, int n_in, void* d_out, int out_size, void* d_ws, size_t ws_size, hipStream_t stream) {
    static int grid = 0;
    if (grid == 0) {
        if (n_in != N_IN || out_size != NT * DM || ws_size < WS_END) { fprintf(stderr, "kernel_launch: unexpected shapes (n_in %d, out %d, ws %zu, need %zu)\n", n_in, out_size, ws_size, (size_t)WS_END); grid = -1; return; }
        int dev = 0, cus = 0, per_cu = 0;
        if (hipGetDevice(&dev) != hipSuccess || hipDeviceGetAttribute(&cus, hipDeviceAttributeMultiprocessorCount, dev) != hipSuccess) { grid = -1; return; }
        if (hipFuncSetAttribute((const void*)mk_fwd, hipFuncAttributeMaxDynamicSharedMemorySize, LDS_BYTES) != hipSuccess) { fprintf(stderr, "kernel_launch: hipFuncSetAttribute failed\n"); grid = -1; return; }
        if (hipOccupancyMaxActiveBlocksPerMultiprocessor(&per_cu, (const void*)mk_fwd, NTHREADS, LDS_BYTES) != hipSuccess || per_cu < 1) { fprintf(stderr, "kernel_launch: occupancy query says %d blocks per CU\n", per_cu); grid = -1; return; }
        grid = cus;
    }
    if (grid < 0) return;
    if (hipMemsetAsync((char*)d_ws + WS_CTL, 0, CTL_ZERO_BYTES, stream) != hipSuccess) return;
    Args a{};
    for (int i = 0; i < N_IN; ++i) a.in[i] = d_in[i];
    a.out = (float*)d_out; a.ws = (unsigned char*)d_ws;
    void* kargs[] = {&a};
    const hipError_t le = hipLaunchCooperativeKernel((const void*)mk_fwd, dim3(grid), dim3(NTHREADS), kargs, LDS_BYTES, stream);
    if (le != hipSuccess) fprintf(stderr, "kernel_launch: cooperative launch failed: %s (grid %d)\n", hipGetErrorString(le), grid);
}
```

```cpp
#include <hip/hip_runtime.h>
#include <hip/hip_cooperative_groups.h>
#include <cstdio>
#include <cstdint>
namespace cg = cooperative_groups;
namespace pg8 {
#define PG8_LAS __attribute__((address_space(3)))
typedef unsigned short bf16_t;
typedef short bf16x8 __attribute__((ext_vector_type(8)));
typedef float f32x4 __attribute__((ext_vector_type(4)));
typedef unsigned u32x4 __attribute__((ext_vector_type(4)));
constexpr int BM = 256, BK = 64, HALF = 128, HTB = HALF * BK * 2  , STAGE_BYTES = 8 * HTB, NXCD = 8, WGM = 8;

__host__ __device__ __forceinline__ int lds_byte(int r, int c) { const int st = (r >> 4) * 2 + (c >> 5), rr = r & 15, cc = c & 31, ob = rr * 64 + cc * 2; return st * 1024 + (ob ^ (((ob >> 9) & 1) << 5)); }
__host__ __device__ __forceinline__ void stage_rc(int b, int& R, int& C) { const int st = b / 1024, sb = b % 1024, swz = sb ^ (((sb >> 9) & 1) << 5); R = (st >> 1) * 16 + swz / 64; C = (st & 1) * 32 + (swz % 64) / 2; }
__host__ __device__ __forceinline__ int perm32(int rho) { const int n = rho >> 4, i = rho & 15; return 8 * (i >> 2) + 4 * n + (i & 3); }

struct Unit { int pm, pn; };
struct Gemm { const bf16_t* A; const bf16_t* Bt; int M, N, K; };

struct StaticOrder {
    int nM, nN, nwg, G, c;
    __host__ __device__ void init(int M, int N, int G_, int c_) { nM = M / BM; nN = N / BM; nwg = nM * nN; G = G_; c = c_; }
    __host__ __device__ bool next(int i, Unit& u) const {
        const long L = (long)i * G + c; if (L >= nwg) return false;
        int wgid = (int)L; { const int q = nwg / NXCD, r = nwg % NXCD, xcd = wgid % NXCD, off = wgid / NXCD; wgid = (xcd < r ? xcd * (q + 1) : r * (q + 1) + (xcd - r) * q) + off; }
        const int nig = WGM * nN, gid = wgid / nig, fm = gid * WGM, gsz = (nM - fm) < WGM ? (nM - fm) : WGM;
        u.pm = fm + ((wgid % nig) % gsz); u.pn = (wgid % nig) / gsz; return true;
    }
    __device__ __forceinline__ void a_ready(const Unit&) const {}
    __device__ __forceinline__ void done(const Unit&) const {}
};

__device__ __forceinline__ unsigned cvt_pk_bf16(float lo, float hi) { unsigned r; asm volatile("v_cvt_pk_bf16_f32 %0, %1, %2" : "=v"(r) : "v"(lo), "v"(hi)); return r; }
typedef float f32x2 __attribute__((ext_vector_type(2)));
__device__ __forceinline__ f32x2 gelu_pk(f32x2 v) {
    const f32x2 av = __builtin_elementwise_abs(v), d = av * 0.2316418882f + 1.0f;
    f32x2 t; t.x = __builtin_amdgcn_rcpf(d.x); t.y = __builtin_amdgcn_rcpf(d.y);
    f32x2 q = t * 0.5307027145f + (-0.7265760135f); q = q * t + 0.7107068705f; q = q * t + (-0.142248368f); q = q * t + 0.127414796f; q = q * t;
    const f32x2 s = (v * v) * (-0.72134752044f);
    f32x2 e; e.x = __builtin_amdgcn_exp2f(s.x); e.y = __builtin_amdgcn_exp2f(s.y);
    const f32x2 m = v * (q * e), r = v - m;
    f32x2 o; o.x = v.x < 0.f ? m.x : r.x; o.y = v.y < 0.f ? m.y : r.y; return o;
}

template <int ACT  > struct EpiBf16 {
    static constexpr bool PERM = true, AFTER_DRAIN = false; static_assert(ACT == 0 || ACT == 1, "EpiBf16: ACT is 0 (none) or 1 (gelu_pk)");
    bf16_t* O; int ldc; const float* bias; int split_cols; size_t split_stride; float scale0;
    __device__ __forceinline__ void operator()(const f32x4 (&acc)[2][2][4][2], const Unit& u, int wr, int wc, int fr, int fq) const {
        const int row0 = u.pm * BM + wr * 64 + fr; int colt = u.pn * BM; bf16_t* base = O;
        float sc = 1.f; if (split_cols) { const int t = colt / split_cols; base += (size_t)t * split_stride; colt -= t * split_cols; if (t == 0) sc = scale0; }
        const int col0 = colt + wc * 32 + 8 * fq, bcol0 = u.pn * BM + wc * 32 + 8 * fq;
        f32x4 bv[2][2];
#pragma unroll
        for (int bj = 0; bj < 2; ++bj)
#pragma unroll
            for (int n = 0; n < 2; ++n) bv[bj][n] = bias ? *(const f32x4*)(bias + bcol0 + bj * HALF + 4 * n) : (f32x4){0.f, 0.f, 0.f, 0.f};
#pragma unroll
        for (int ai = 0; ai < 2; ++ai)
#pragma unroll
            for (int m = 0; m < 4; ++m) { bf16_t* rowp = base + (size_t)(row0 + ai * HALF + m * 16) * ldc + col0;
#pragma unroll
                for (int bj = 0; bj < 2; ++bj) { f32x4 v0 = acc[ai][bj][m][0] + bv[bj][0], v1 = acc[ai][bj][m][1] + bv[bj][1];
                    if (ACT == 1) { f32x2 a = gelu_pk((f32x2){v0[0], v0[1]}), b = gelu_pk((f32x2){v0[2], v0[3]}), c = gelu_pk((f32x2){v1[0], v1[1]}), d = gelu_pk((f32x2){v1[2], v1[3]});
                        v0 = (f32x4){a.x, a.y, b.x, b.y}; v1 = (f32x4){c.x, c.y, d.x, d.y}; }
                    v0 = v0 * sc; v1 = v1 * sc; u32x4 w; w.x = cvt_pk_bf16(v0[0], v0[1]); w.y = cvt_pk_bf16(v0[2], v0[3]); w.z = cvt_pk_bf16(v1[0], v1[1]); w.w = cvt_pk_bf16(v1[2], v1[3]);
                    *(u32x4*)(rowp + bj * HALF) = w; } }
    }
};

__device__ __forceinline__ float row_rstd(const float* ssq, int row) {
    const f32x4* p = (const f32x4*)(ssq + (size_t)row * 16);
    const f32x4 a = p[0], b = p[1], c = p[2], d = p[3];
    const float s = (((a[0] + a[1]) + (a[2] + a[3])) + ((b[0] + b[1]) + (b[2] + b[3]))) + (((c[0] + c[1]) + (c[2] + c[3])) + ((d[0] + d[1]) + (d[2] + d[3])));
    return 1.0f / sqrtf(s * (1.0f / 1024.0f) + 1e-6f);
}
__device__ __forceinline__ float sigmoidf_(float x) { return __builtin_amdgcn_rcpf(1.0f + __expf(-x)); }
typedef unsigned u32x2 __attribute__((ext_vector_type(2)));

struct EpiRes {
    static constexpr bool PERM = false, AFTER_DRAIN = false;
    const float* base32; const bf16_t* base16; bf16_t* hb; float* ssq; unsigned char* xq8;
    __device__ __forceinline__ void operator()(const f32x4 (&acc)[2][2][4][2], const Unit& u, int wr, int wc, int fr, int fq) const {
        const int row0 = u.pm * BM + wr * 64 + fr, col0 = u.pn * BM + wc * 32 + 4 * fq;
#pragma unroll
        for (int ai = 0; ai < 2; ++ai)
#pragma unroll
            for (int m = 0; m < 4; ++m) { const int row = row0 + ai * HALF + m * 16; const size_t off = (size_t)row * 1024 + col0; float ss = 0.f;
#pragma unroll
                for (int bj = 0; bj < 2; ++bj)
#pragma unroll
                    for (int n = 0; n < 2; ++n) { const size_t o2 = off + bj * HALF + n * 16; f32x4 b;
                        if (base32) b = *(const f32x4*)(base32 + o2);
                        else { const u32x2 bw = *(const u32x2*)(base16 + o2); b = (f32x4){__uint_as_float(bw.x << 16), __uint_as_float(bw.x & 0xffff0000u), __uint_as_float(bw.y << 16), __uint_as_float(bw.y & 0xffff0000u)}; }
                        const f32x4 o = b + acc[ai][bj][m][n];
                        ss += (o[0] * o[0] + o[1] * o[1]) + (o[2] * o[2] + o[3] * o[3]);
                        u32x2 w; w.x = cvt_pk_bf16(o[0], o[1]); w.y = cvt_pk_bf16(o[2], o[3]); *(u32x2*)(hb + o2) = w;
                        int w8 = __builtin_amdgcn_cvt_pk_fp8_f32(o[0], o[1], 0, false); w8 = __builtin_amdgcn_cvt_pk_fp8_f32(o[2], o[3], w8, true); *(unsigned*)(xq8 + o2) = (unsigned)w8; }
                ss += __shfl_xor(ss, 16); ss += __shfl_xor(ss, 32);
                if (fq == 0) ssq[(size_t)row * 16 + u.pn * 4 + wc] = ss; }
    }
};
struct EpiScaleF32 {
    static constexpr bool PERM = false, AFTER_DRAIN = false;
    float* C; int ldc; const float* ssq;
    __device__ __forceinline__ void operator()(const f32x4 (&acc)[2][2][4][2], const Unit& u, int wr, int wc, int fr, int fq) const {
        const int row0 = u.pm * BM + wr * 64 + fr, col0 = u.pn * BM + wc * 32 + 4 * fq;
#pragma unroll
        for (int ai = 0; ai < 2; ++ai)
#pragma unroll
            for (int m = 0; m < 4; ++m) { const int row = row0 + ai * HALF + m * 16; const float rs = row_rstd(ssq, row); float* rowp = C + (size_t)row * ldc + col0;
#pragma unroll
                for (int bj = 0; bj < 2; ++bj)
#pragma unroll
                    for (int n = 0; n < 2; ++n) *(f32x4*)(rowp + bj * HALF + n * 16) = acc[ai][bj][m][n] * rs; }
    }
};
struct EpiScaleBf16 {
    static constexpr bool PERM = false, AFTER_DRAIN = false;
    bf16_t* O; int ldc; const float* ssq;
    __device__ __forceinline__ void operator()(const f32x4 (&acc)[2][2][4][2], const Unit& u, int wr, int wc, int fr, int fq) const {
        const int row0 = u.pm * BM + wr * 64 + fr, col0 = u.pn * BM + wc * 32 + 4 * fq;
#pragma unroll
        for (int ai = 0; ai < 2; ++ai)
#pragma unroll
            for (int m = 0; m < 4; ++m) { const int row = row0 + ai * HALF + m * 16; const float rs = row_rstd(ssq, row); bf16_t* rowp = O + (size_t)row * ldc + col0;
#pragma unroll
                for (int bj = 0; bj < 2; ++bj)
#pragma unroll
                    for (int n = 0; n < 2; ++n) { const f32x4 o = acc[ai][bj][m][n] * rs; u32x2 w; w.x = cvt_pk_bf16(o[0], o[1]); w.y = cvt_pk_bf16(o[2], o[3]); *(u32x2*)(rowp + bj * HALF + n * 16) = w; } }
    }
};
struct EpiPle {
    static constexpr bool PERM = false, AFTER_DRAIN = false;
    const bf16_t* hin; const bf16_t* pp; bf16_t* hb; const float* ssq_in; float* ssq_out;
    __device__ __forceinline__ void operator()(const f32x4 (&acc)[2][2][4][2], const Unit& u, int wr, int wc, int fr, int fq) const {
        const int row0 = u.pm * BM + wr * 64 + fr, col0 = u.pn * BM + wc * 32 + 4 * fq;
#pragma unroll
        for (int ai = 0; ai < 2; ++ai)
#pragma unroll
            for (int m = 0; m < 4; ++m) { const int row = row0 + ai * HALF + m * 16; const float rs = row_rstd(ssq_in, row); const size_t off = (size_t)row * 1024 + col0; float ss = 0.f;
#pragma unroll
                for (int bj = 0; bj < 2; ++bj)
#pragma unroll
                    for (int n = 0; n < 2; ++n) { const size_t o2 = off + bj * HALF + n * 16; const f32x4 a = acc[ai][bj][m][n] * rs; const u32x2 pw = *(const u32x2*)(pp + o2); const u32x2 hw = *(const u32x2*)(hin + o2);
                        f32x4 o;
                        o[0] = __uint_as_float(hw.x << 16) + __uint_as_float(pw.x << 16) * sigmoidf_(a[0]); o[1] = __uint_as_float(hw.x & 0xffff0000u) + __uint_as_float(pw.x & 0xffff0000u) * sigmoidf_(a[1]);
                        o[2] = __uint_as_float(hw.y << 16) + __uint_as_float(pw.y << 16) * sigmoidf_(a[2]); o[3] = __uint_as_float(hw.y & 0xffff0000u) + __uint_as_float(pw.y & 0xffff0000u) * sigmoidf_(a[3]);
                        ss += (o[0] * o[0] + o[1] * o[1]) + (o[2] * o[2] + o[3] * o[3]);
                        u32x2 w; w.x = cvt_pk_bf16(o[0], o[1]); w.y = cvt_pk_bf16(o[2], o[3]); *(u32x2*)(hb + o2) = w; }
                ss += __shfl_xor(ss, 16); ss += __shfl_xor(ss, 32);
                if (fq == 0) ssq_out[(size_t)row * 16 + u.pn * 4 + wc] = ss; }
    }
};
struct EpiGlu {
    static constexpr bool PERM = false, AFTER_DRAIN = false;
    const bf16_t* Z; int ldz; const float* bias; bf16_t* O; int ldo; int ocol0;
    __device__ __forceinline__ void operator()(const f32x4 (&acc)[2][2][4][2], const Unit& u, int wr, int wc, int fr, int fq) const {
        const int row0 = u.pm * BM + wr * 64 + fr, col0 = u.pn * BM + wc * 32 + 4 * fq;
        f32x4 bv[2][2];
#pragma unroll
        for (int bj = 0; bj < 2; ++bj)
#pragma unroll
            for (int n = 0; n < 2; ++n) bv[bj][n] = *(const f32x4*)(bias + col0 + bj * HALF + n * 16);
#pragma unroll
        for (int ai = 0; ai < 2; ++ai)
#pragma unroll
            for (int m = 0; m < 4; ++m) { const int row = row0 + ai * HALF + m * 16;
#pragma unroll
                for (int bj = 0; bj < 2; ++bj)
#pragma unroll
                    for (int n = 0; n < 2; ++n) { const int col = col0 + bj * HALF + n * 16; const f32x4 a = acc[ai][bj][m][n] + bv[bj][n]; const u32x2 zw = *(const u32x2*)(Z + (size_t)row * ldz + col);
                        const float o0 = __uint_as_float(zw.x << 16) * sigmoidf_(a[0]), o1 = __uint_as_float(zw.x & 0xffff0000u) * sigmoidf_(a[1]);
                        const float o2 = __uint_as_float(zw.y << 16) * sigmoidf_(a[2]), o3 = __uint_as_float(zw.y & 0xffff0000u) * sigmoidf_(a[3]);
                        u32x2 w; w.x = cvt_pk_bf16(o0, o1); w.y = cvt_pk_bf16(o2, o3); *(u32x2*)(O + (size_t)row * ldo + ocol0 + col) = w; } }
    }
};
template <class Epi, class Sched, bool ALIGN_EPI = false, bool SP2 = false>
__device__ __forceinline__ void gemm_phase(PG8_LAS unsigned char* lds, const Gemm g, const Sched& S, const Epi& E) {
    int tid_o = threadIdx.x; asm volatile("" : "+v"(tid_o));
    const int tid = tid_o, wid = __builtin_amdgcn_readfirstlane(tid >> 6), lane = tid & 63, wr = wid >> 2, wc = wid & 3, fr = lane & 15, fq = lane >> 4;
    const int K = g.K, nt = K / BK;
    unsigned voffA[2], voffB[2];
#pragma unroll
    for (int i = 0; i < 2; ++i) { int R, C; stage_rc(tid * 16 + i * 8192, R, C); const int Rb = Epi::PERM ? ((R & ~31) + perm32(R & 31)) : R;
        voffA[i] = (unsigned)(R * K + C) * 2u; voffB[i] = (unsigned)(Rb * K + C) * 2u; }
    const size_t kstep = (size_t)(BK * 2);
    const size_t hstep = (size_t)HALF * K * 2;
    const size_t tstep = 2 * hstep;
    const unsigned ldsw = (unsigned)wid * 1024u;
    const int aoff = lds_byte(wr * 64 + fr, fq * 8), boff = lds_byte(wc * 32 + fr, fq * 8);
#define PG8_SA(b, h) (((b) * 2 + (h)) * HTB)
#define PG8_SB(b, h) ((4 + (b) * 2 + (h)) * HTB)
#define PG8_STAGE(bufoff, gbase, voff) do { _Pragma("unroll") for (int _i = 0; _i < 2; ++_i) \
        __builtin_amdgcn_global_load_lds((const unsigned*)((const char*)(gbase) + (voff)[_i]), (PG8_LAS unsigned*)(lds + (bufoff) + ldsw + _i * 8192), 16, 0, 0); } while (0)
#define PG8_LDA(dst, b, h) do { _Pragma("unroll") for (int m = 0; m < 4; ++m) _Pragma("unroll") for (int k = 0; k < 2; ++k) dst[m][k] = *(const PG8_LAS bf16x8*)(lds + PG8_SA(b, h) + aoff + m * 2048 + k * 1024); } while (0)
#define PG8_LDB(dst, b, h) do { _Pragma("unroll") for (int n = 0; n < 2; ++n) _Pragma("unroll") for (int k = 0; k < 2; ++k) dst[n][k] = *(const PG8_LAS bf16x8*)(lds + PG8_SB(b, h) + boff + n * 2048 + k * 1024); } while (0)
#define PG8_MMA(ai, bj, At, Bt) do { __builtin_amdgcn_s_setprio(1); _Pragma("unroll") for (int m = 0; m < 4; ++m) _Pragma("unroll") for (int n = 0; n < 2; ++n) _Pragma("unroll") for (int k = 0; k < 2; ++k) \
        acc[ai][bj][m][n] = __builtin_amdgcn_mfma_f32_16x16x32_bf16(Bt[n][k], At[m][k], acc[ai][bj][m][n], 0, 0, 0); __builtin_amdgcn_s_setprio(0); } while (0)
#define PG8_WAIT_V(n) asm volatile("s_waitcnt vmcnt(" #n ")" ::: "memory")
#define PG8_WAIT_L(n) asm volatile("s_waitcnt lgkmcnt(" #n ")" ::: "memory")
#define PG8_BAR __builtin_amdgcn_s_barrier()
#define PG8_SCHED __builtin_amdgcn_sched_barrier(0)
    Unit cur, nxt; int ui = 0;
    if (!S.next(0, cur)) return;
    f32x4 acc[2][2][4][2];
#pragma unroll
    for (int a = 0; a < 2; ++a)
#pragma unroll
        for (int b = 0; b < 2; ++b)
#pragma unroll
            for (int m = 0; m < 4; ++m)
#pragma unroll
                for (int n = 0; n < 2; ++n) acc[a][b][m][n] = (f32x4){0.f, 0.f, 0.f, 0.f};
    bf16x8 At[4][2], B0[2][2], B1[2][2];
    const char* cA = (const char*)g.A + (size_t)cur.pm * tstep; const char* cB = (const char*)g.Bt + (size_t)cur.pn * tstep;
    S.a_ready(cur);
    if constexpr (SP2) {
        PG8_STAGE(PG8_SB(0, 0), cB, voffB); PG8_STAGE(PG8_SB(0, 1), cB + hstep, voffB); PG8_STAGE(PG8_SA(0, 0), cA, voffA); PG8_STAGE(PG8_SA(0, 1), cA + hstep, voffA);
        if (wr == 1) PG8_BAR;
        PG8_WAIT_V(2); PG8_BAR;
        PG8_STAGE(PG8_SB(1, 0), cB + kstep, voffB); PG8_STAGE(PG8_SA(1, 0), cA + kstep, voffA); PG8_STAGE(PG8_SB(1, 1), cB + hstep + kstep, voffB);
        PG8_WAIT_V(6); PG8_BAR;
    } else {
        PG8_STAGE(PG8_SB(0, 0), cB, voffB); PG8_STAGE(PG8_SA(0, 0), cA, voffA); PG8_STAGE(PG8_SB(0, 1), cB + hstep, voffB); PG8_STAGE(PG8_SA(0, 1), cA + hstep, voffA);
        if (wr == 1) PG8_BAR;
        PG8_WAIT_V(4); PG8_BAR;
        PG8_STAGE(PG8_SB(1, 0), cB + kstep, voffB); PG8_STAGE(PG8_SA(1, 0), cA + kstep, voffA); PG8_STAGE(PG8_SB(1, 1), cB + hstep + kstep, voffB);
        PG8_WAIT_V(6); PG8_BAR;
    }
    for (;;) {
        const bool has_next = S.next(ui + 1, nxt);
        const char* nA = has_next ? (const char*)g.A + (size_t)nxt.pm * tstep : cA; const char* nB = has_next ? (const char*)g.Bt + (size_t)nxt.pn * tstep : cB;
        for (int t = 0; t < nt; t += 2) {
            const bool last = (t == nt - 2);
            const char* a1 = cA + (size_t)(t + 1) * kstep;
            const char* a2 = last ? nA : cA + (size_t)(t + 2) * kstep; const char* b2 = last ? nB : cB + (size_t)(t + 2) * kstep;
            const char* a3 = a2 + kstep; const char* b3 = b2 + kstep;
            if (last && has_next) S.a_ready(nxt);
            if constexpr (SP2) {
            PG8_LDB(B0, 0, 0); PG8_LDB(B1, 0, 1); PG8_SCHED; PG8_LDA(At, 0, 0); PG8_STAGE(PG8_SA(1, 1), a1 + hstep, voffA);
            PG8_WAIT_V(8); PG8_WAIT_L(0); PG8_BAR; PG8_MMA(0, 0, At, B0); PG8_MMA(0, 1, At, B1); PG8_BAR; PG8_SCHED;
            PG8_LDA(At, 0, 1); PG8_STAGE(PG8_SB(0, 0), b2, voffB); PG8_STAGE(PG8_SB(0, 1), b2 + hstep, voffB); PG8_STAGE(PG8_SA(0, 0), a2, voffA);
            PG8_WAIT_V(8); PG8_WAIT_L(0); PG8_BAR; PG8_MMA(1, 0, At, B0); PG8_MMA(1, 1, At, B1); PG8_BAR; PG8_SCHED;
            PG8_LDB(B0, 1, 0); PG8_LDB(B1, 1, 1); PG8_SCHED; PG8_LDA(At, 1, 0); PG8_STAGE(PG8_SA(0, 1), a2 + hstep, voffA);
            PG8_WAIT_V(8); PG8_WAIT_L(0); PG8_BAR; PG8_MMA(0, 0, At, B0); PG8_MMA(0, 1, At, B1); PG8_BAR; PG8_SCHED;
            PG8_LDA(At, 1, 1); PG8_STAGE(PG8_SB(1, 0), b3, voffB); PG8_STAGE(PG8_SB(1, 1), b3 + hstep, voffB); PG8_STAGE(PG8_SA(1, 0), a3, voffA);
            PG8_WAIT_V(8); PG8_WAIT_L(0); PG8_BAR; PG8_MMA(1, 0, At, B0); PG8_MMA(1, 1, At, B1); PG8_BAR; PG8_SCHED;
            } else {
            PG8_LDB(B0, 0, 0); PG8_SCHED; PG8_LDA(At, 0, 0); PG8_STAGE(PG8_SA(1, 1), a1 + hstep, voffA);
            PG8_WAIT_L(8); PG8_BAR; PG8_WAIT_L(0); PG8_MMA(0, 0, At, B0); PG8_BAR; PG8_SCHED;
            PG8_LDB(B1, 0, 1); PG8_STAGE(PG8_SB(0, 0), b2, voffB);
            PG8_BAR; PG8_WAIT_L(0); PG8_MMA(0, 1, At, B1); PG8_BAR;
            PG8_LDA(At, 0, 1); PG8_STAGE(PG8_SA(0, 0), a2, voffA);
            PG8_BAR; PG8_WAIT_L(0); PG8_MMA(1, 0, At, B0); PG8_BAR; PG8_SCHED;
            PG8_STAGE(PG8_SB(0, 1), b2 + hstep, voffB);
            PG8_WAIT_V(6); PG8_BAR; PG8_MMA(1, 1, At, B1); PG8_BAR;
            PG8_LDB(B0, 1, 0); PG8_SCHED; PG8_LDA(At, 1, 0); PG8_STAGE(PG8_SA(0, 1), a2 + hstep, voffA);
            PG8_WAIT_L(8); PG8_BAR; PG8_WAIT_L(0); PG8_MMA(0, 0, At, B0); PG8_BAR; PG8_SCHED;
            PG8_LDB(B1, 1, 1); PG8_STAGE(PG8_SB(1, 0), b3, voffB);
            PG8_BAR; PG8_WAIT_L(0); PG8_MMA(0, 1, At, B1); PG8_BAR;
            PG8_LDA(At, 1, 1); PG8_STAGE(PG8_SA(1, 0), a3, voffA);
            PG8_BAR; PG8_WAIT_L(0); PG8_MMA(1, 0, At, B0); PG8_BAR; PG8_SCHED;
            PG8_STAGE(PG8_SB(1, 1), b3 + hstep, voffB);
            PG8_WAIT_V(6); PG8_BAR; PG8_MMA(1, 1, At, B1); PG8_BAR;
            }
        }
        if constexpr (ALIGN_EPI) { if (wr == 0) PG8_BAR; }
        if constexpr (!Epi::AFTER_DRAIN) { E(acc, cur, wr, wc, fr, fq); S.done(cur); }
        if (!has_next) break;
#pragma unroll
        for (int a = 0; a < 2; ++a)
#pragma unroll
            for (int b = 0; b < 2; ++b)
#pragma unroll
                for (int m = 0; m < 4; ++m)
#pragma unroll
                    for (int n = 0; n < 2; ++n) acc[a][b][m][n] = (f32x4){0.f, 0.f, 0.f, 0.f};
        cur = nxt; cA = nA; cB = nB; ++ui;
        if constexpr (ALIGN_EPI) { if (wr == 1) PG8_BAR; }
    }
    PG8_WAIT_V(0);
    if constexpr (!ALIGN_EPI) { if (wr == 0) PG8_BAR; }
    PG8_BAR;
    if constexpr (Epi::AFTER_DRAIN) { E.fused(acc, cur, wr, wc, fr, fq, lds, wid, lane); S.done(cur); }
#undef PG8_SA
#undef PG8_SB
#undef PG8_STAGE
#undef PG8_LDA
#undef PG8_LDB
#undef PG8_MMA
#undef PG8_WAIT_V
#undef PG8_WAIT_L
#undef PG8_BAR
#undef PG8_SCHED
}
}
#define GAS __attribute__((address_space(1)))
#define LAS __attribute__((address_space(3)))
typedef unsigned short bf16;
typedef unsigned v4u __attribute__((ext_vector_type(4)));
typedef float f32x4 __attribute__((ext_vector_type(4)));
typedef short bf16x8 __attribute__((ext_vector_type(8)));
typedef GAS unsigned gu32;
typedef GAS unsigned long long gu64;
#define RLX_AGENT __ATOMIC_RELAXED, __HIP_MEMORY_SCOPE_AGENT
#define LDS_WAIT() asm volatile("s_waitcnt lgkmcnt(0)" ::: "memory")
#define VM_WAIT() asm volatile("s_waitcnt vmcnt(0)" ::: "memory")
__device__ __forceinline__ unsigned long long rt() { return __builtin_amdgcn_s_memrealtime(); }
__device__ __forceinline__ unsigned f2bf(float f) { unsigned u = __builtin_bit_cast(unsigned, f); return (u + 0x7fffu + ((u >> 16) & 1u)) >> 16; }
__device__ __forceinline__ unsigned pk2(float lo, float hi) { return f2bf(lo) | (f2bf(hi) << 16); }
#define XB_TMO      128
#define XB_XCNT(j)  (256  + 64 * (j))
#define XB_XSUB(j)  (1280 + 64 * (j))
#define XB_XGEN(j)  (2304 + 64 * (j))
#define XB_TOP      3328
#define XB_TOPGEN   3392
#define XCD_BAR_WORDS 3456
#define XB_SPIN_CAP (1u << 18)

__device__ __forceinline__ unsigned xb_ld(unsigned* p)              { return __hip_atomic_load(p, __ATOMIC_RELAXED, __HIP_MEMORY_SCOPE_AGENT); }
__device__ __forceinline__ unsigned xb_add(unsigned* p, unsigned v) { return __hip_atomic_fetch_add(p, v, __ATOMIC_RELAXED, __HIP_MEMORY_SCOPE_AGENT); }
__device__ __forceinline__ unsigned xb_xcc_id() { return (unsigned)__builtin_amdgcn_s_getreg((3 << 11) | 20) & 0xFu; }
#define XB_SPIN(cond, bar) do { unsigned _sp = 0; while (cond) { __builtin_amdgcn_s_sleep(1); \
    if ((++_sp & 255u) == 0u) { if (xb_ld(&(bar)[XB_TMO])) break; if (_sp > XB_SPIN_CAP) { atomicAdd(&(bar)[XB_TMO], 1u); break; } } } } while (0)

struct XcdBarrier {
    unsigned* bar; unsigned x;
    volatile LAS unsigned* st;
};

__device__ __forceinline__ XcdBarrier xcd_barrier_post(unsigned* bar, volatile LAS unsigned* st) {
    XcdBarrier b; b.bar = bar; b.x = xb_xcc_id(); b.st = st;
    if (threadIdx.x == 0) (void)xb_add(&bar[XB_XCNT(b.x)], 1u);
    return b;
}
__device__ __forceinline__ void xcd_barrier_complete(unsigned* bar, unsigned x, unsigned& nloc, unsigned& nx) {
    const unsigned G = gridDim.x * gridDim.y * gridDim.z;
    unsigned sum, cnt, mine, sp = 0u;
    for (;;) {
        sum = 0u; cnt = 0u; mine = 0u;
#pragma unroll
        for (unsigned j = 0; j < 16; ++j) { const unsigned c = xb_ld(&bar[XB_XCNT(j)]); sum += c; cnt += (c > 0u) ? 1u : 0u; mine = (j == x) ? c : mine; }
        if (sum == G) break;
        __builtin_amdgcn_s_sleep(1);
        if ((++sp & 255u) == 0u) { if (xb_ld(&bar[XB_TMO])) break; if (sp > XB_SPIN_CAP) { atomicAdd(&bar[XB_TMO], 1u); break; } }
    }
    nloc = mine > 0u ? mine : 1u; nx = cnt > 0u ? cnt : 1u;
}

__device__ __forceinline__ void xcd_barrier(const XcdBarrier& b) {
    asm volatile("s_waitcnt vmcnt(0)" ::: "memory");
    __syncthreads();
    if (threadIdx.x == 0) {
        unsigned* bar = b.bar;
        __builtin_amdgcn_s_waitcnt(0);
        unsigned nloc = b.st[0], nx = b.st[1];
        if (nloc == 0u) { xcd_barrier_complete(bar, b.x, nloc, nx); b.st[0] = nloc; b.st[1] = nx; }
        const unsigned old = xb_add(&bar[XB_XSUB(b.x)], 1u);
        const unsigned gen = old / nloc;
        if (old + 1u == (gen + 1u) * nloc) {
            __builtin_amdgcn_fence(__ATOMIC_RELEASE, "agent");
            asm volatile("s_waitcnt vmcnt(0)" ::: "memory");
            const unsigned og = xb_add(&bar[XB_TOP], 1u);
            const unsigned tg = og / nx;
            if (og + 1u == (tg + 1u) * nx) xb_add(&bar[XB_TOPGEN], 1u);
            else XB_SPIN(xb_ld(&bar[XB_TOPGEN]) == tg, bar);
            __builtin_amdgcn_fence(__ATOMIC_ACQUIRE, "agent");
            xb_add(&bar[XB_XGEN(b.x)], 1u);
            asm volatile("s_waitcnt vmcnt(0)" ::: "memory");
        } else {
            XB_SPIN(xb_ld(&bar[XB_XGEN(b.x)]) == gen, bar);
            __builtin_amdgcn_fence(__ATOMIC_ACQUIRE, "agent");
            asm volatile("s_waitcnt vmcnt(0)" ::: "memory");
        }
    }
    __syncthreads();
}

constexpr int NWAVES = 8, NTHREADS = 512;
constexpr int NT = 32768, DM = 1024, SEQ = 8192, NCHUNK = 128, PROJW = 3328;
constexpr float EPS = 1e-6f;
enum { I_X = 0, I_P, I_POS, I_NMW, I_NFW, I_NPW, I_FNW, I_EWIN, I_GWUP, I_GBUP, I_GNW, I_RNW, I_EWOUT, I_OWIN, I_POOLW, I_POOLS, I_ARE, I_AIM, I_LDT, I_BRE, I_BIM, I_CRE, I_CIM, I_DSK,
       I_WGLU, I_BGLU, I_OWOUT, I_PWQ, I_PKEYS, I_PU, I_PV, I_PLEP, I_PLEG, N_IN };
constexpr size_t MiB = 1u << 20;
constexpr size_t WS_CTL = 0, CTL_ZERO_BYTES = 64 * 1024;
constexpr size_t WS_WIN0 = 1 * MiB, WS_WOUT0 = 8 * MiB, WS_WEFF = 10 * MiB  , WS_WG = 18 * MiB  , WS_WP = 22 * MiB  , WS_WIN1 = 23 * MiB, WS_WGLU = 25 * MiB, WS_WOUT1 = 26 * MiB;
constexpr size_t WS_ROT = 28 * MiB, WS_S5C = 30 * MiB, WS_SSQ0 = 31 * MiB, WS_SSQ1 = 33 * MiB, WS_DEC = 35 * MiB;
constexpr size_t S5_ABAR = 0, S5_A64 = 16384, S5_BBAR = 32768  , S5_CM = 32768 + 262144  , S5_BB16 = S5_CM + 131072  ;
constexpr size_t WS_A0 = 36 * MiB, WS_A1 = 100 * MiB, WS_R1 = 164 * MiB;
constexpr size_t WS_PROJ = WS_R1, WS_KV = WS_R1 + 208 * MiB;
constexpr size_t WS_SC = WS_R1, WS_EID = WS_R1 + 256 * MiB, WS_GATE = WS_R1 + 272 * MiB;
constexpr size_t WS_COEF = WS_R1 + 160 * MiB;
constexpr size_t WS_XQ = WS_R1 + 224 * MiB;
constexpr size_t WS_UT4 = WS_R1 + 288 * MiB, WS_VT4 = WS_UT4 + 8 * MiB, WS_SCL = WS_UT4 + 16 * MiB, WS_PB = WS_UT4 + 18 * MiB, WS_PP = WS_R1 + 80 * MiB;
constexpr size_t WS_U = WS_R1, WS_Z = WS_R1 + 64 * MiB, WS_E = WS_R1 + 96 * MiB;
constexpr size_t WS_END = WS_R1 + 288 * MiB + 34 * MiB;
constexpr int RING_BYTES = 131072, MISC_OFF = RING_BYTES + 320, LDS_BYTES = 147456;

__device__ __forceinline__ float bf2f(unsigned short b) { return __uint_as_float((unsigned)b << 16); }
__device__ __forceinline__ float bf2f(unsigned b) { return __uint_as_float(b << 16); }
__device__ __forceinline__ float bflo(unsigned w) { return __uint_as_float(w << 16); }
__device__ __forceinline__ float bfhi(unsigned w) { return __uint_as_float(w & 0xffff0000u); }
__device__ __forceinline__ float wave_sum(float v) {
#pragma unroll
    for (int o = 1; o < 64; o <<= 1) v += __shfl_xor(v, o);
    return v;
}
__device__ __forceinline__ float gelu1(float v) {
    const float av = fabsf(v), t = __builtin_amdgcn_rcpf(av * 0.2316418882f + 1.0f);
    float q = t * 0.5307027145f + (-0.7265760135f); q = q * t + 0.7107068705f; q = q * t + (-0.142248368f); q = q * t + 0.127414796f; q = q * t;
    const float e = __builtin_amdgcn_exp2f((v * v) * (-0.72134752044f));
    const float m = v * (q * e);
    return v < 0.f ? m : v - m;
}
__device__ __forceinline__ float logsigf(float x) { return fminf(x, 0.f) - __logf(1.0f + __expf(-fabsf(x))); }
__device__ __forceinline__ float siluf(float x) { return x * __builtin_amdgcn_rcpf(1.0f + __expf(-x)); }

struct Ctx {
    LAS unsigned char* lds;
    int tid, lane, wave, G, bid;
    float* h;
    unsigned char* ws;
};
struct Args { const void* in[N_IN]; float* out; unsigned char* ws; };
constexpr int PTR_OFF = 131072 + 1024;
#define IN(i) inptr(C, (i))
#define WSP(T, off) ((T*)(C.ws + (off)))
#define PHASE_ENTER(C) do { int t_ = threadIdx.x; asm volatile("" : "+v"(t_)); C.tid = t_; C.lane = t_ & 63; C.wave = __builtin_amdgcn_readfirstlane(t_ >> 6); asm volatile("" : "+s"(C.ws), "+s"(C.h)); C.ws = (unsigned char*)(GAS unsigned char*)C.ws; C.h = (float*)(GAS float*)C.h; } while (0)
__device__ __forceinline__ const float* inptr(const Ctx& C, int i) { const LAS unsigned* t = (const LAS unsigned*)(C.lds + PTR_OFF) + 2 * i;
    const unsigned lo = __builtin_amdgcn_readfirstlane(t[0]), hi = __builtin_amdgcn_readfirstlane(t[1]); return (const float*)(const GAS float*)(((unsigned long long)hi << 32) | lo); }

__device__ __forceinline__ void tr_item(const float* W, int ldw, int c0, bf16* WT, int K, int r0, const float* ks, float cs, LAS float* scr, int item, int nblk, int lane) {
    const int kb = item / nblk, nb = item % nblk, k0 = 64 * kb, n0 = 32 * nb;
#pragma unroll 8
    for (int i = 0; i < 32; ++i) { const int kk = 2 * i + (lane >> 5); float v = W[(size_t)(k0 + kk) * ldw + c0 + n0 + (lane & 31)]; if (ks) v *= ks[k0 + kk]; scr[kk * 33 + (lane & 31)] = v * cs; }
    LDS_WAIT(); asm volatile("" ::: "memory");
    const int c = lane & 7;
#pragma unroll
    for (int j = 0; j < 4; ++j) { const int n = (lane >> 3) + 8 * j; const LAS float* s = scr + (8 * c) * 33 + n;
        v4u o; o.x = pk2(s[0 * 33], s[1 * 33]); o.y = pk2(s[2 * 33], s[3 * 33]); o.z = pk2(s[4 * 33], s[5 * 33]); o.w = pk2(s[6 * 33], s[7 * 33]);
        *(v4u*)(WT + (size_t)(r0 + n0 + n) * K + k0 + 8 * c) = o; }
    LDS_WAIT(); asm volatile("" ::: "memory");
}
__device__ __forceinline__ void fold_item(const float* KM, int sk, int sc, const float* W, int ldw, int wc0, int kb, bf16* OUT, const float* kscale, const float* nscale, LAS float* lds, int tid) {
    LAS float* KL = lds;
    LAS float* WL = lds + 128 * 132;
    if (sc == 1) { for (int idx = tid; idx < 16384; idx += NTHREADS) { const int key = idx >> 7, c = idx & 127; KL[key * 132 + c] = KM[(size_t)key * sk + c]; } }
    else         { for (int idx = tid; idx < 16384; idx += NTHREADS) { const int c = idx >> 7, key = idx & 127; KL[key * 132 + c] = KM[(size_t)key * sk + (size_t)c * sc]; } }
    for (int idx = tid; idx < 8192; idx += NTHREADS) { const int k = idx >> 7, c = idx & 127; WL[k * 132 + c] = W[(size_t)(kb * 64 + k) * ldw + wc0 + c]; }
    __syncthreads();
    const int ty = tid >> 4, tx = tid & 15;
    float acc[4][4];
#pragma unroll
    for (int i = 0; i < 4; ++i)
#pragma unroll
        for (int j = 0; j < 4; ++j) acc[i][j] = 0.f;
    for (int c4 = 0; c4 < 32; ++c4) {
        f32x4 a[4], b[4];
#pragma unroll
        for (int i = 0; i < 4; ++i) a[i] = *(const LAS f32x4*)(KL + (4 * ty + i) * 132 + 4 * c4);
#pragma unroll
        for (int j = 0; j < 4; ++j) b[j] = *(const LAS f32x4*)(WL + (tx + 16 * j) * 132 + 4 * c4);
#pragma unroll
        for (int i = 0; i < 4; ++i)
#pragma unroll
            for (int j = 0; j < 4; ++j) acc[i][j] += (a[i][0] * b[j][0] + a[i][1] * b[j][1]) + (a[i][2] * b[j][2] + a[i][3] * b[j][3]);
    }
#pragma unroll
    for (int i = 0; i < 4; ++i) { const int key = 4 * ty + i; const float ns = nscale ? nscale[key] : 1.0f;
#pragma unroll
        for (int j = 0; j < 4; ++j) { const int k = kb * 64 + tx + 16 * j; OUT[(size_t)key * 1024 + k] = (bf16)f2bf(acc[i][j] * kscale[k] * ns); } }
    __syncthreads();
}

__device__ __forceinline__ void phase_prologue(Ctx C, const Args& A) {
    PHASE_ENTER(C);
    const int tid = C.tid, lane = C.lane;
    const bool split = C.G >= 192; const int NF = split ? 96 : C.G;
    const bool do_fold = !split || C.bid < NF, do_rest = !split || C.bid >= NF;
    const int wb = split ? C.bid - NF : C.bid, nwb = split ? C.G - NF : C.G;
    const int gw = wb * NWAVES + C.wave, NGW = nwb * NWAVES;
    const int gt = wb * NTHREADS + tid, NGT = nwb * NTHREADS;
    if (do_fold) for (int it = C.bid; it < 576; it += NF) {
        if (it < 512) { const int l = it >> 8, hp = (it >> 4) & 15, kb = it & 15;
            fold_item(IN(I_PKEYS) + (size_t)(l * 16 + hp) * 16384, 128, 1, IN(I_PWQ) + (size_t)l * 1024 * 2048, 2048, hp * 128, kb,
                      WSP(bf16, WS_WEFF) + (size_t)l * 2048 * 1024 + (size_t)hp * 128 * 1024, IN(I_NFW) + l * 1024, nullptr, (LAS float*)C.lds, tid);
        } else { const int r = it - 512, g = r >> 4, kb = r & 15;
            fold_item(IN(I_POOLW) + (size_t)g * 16384, 1, 128, IN(I_OWIN), 1024, g * 128, kb,
                      WSP(bf16, WS_WIN1) + (size_t)g * 128 * 1024, IN(I_NMW) + 1024, IN(I_POOLS) + g * 128, (LAS float*)C.lds, tid);
        }
    }
    if (do_rest) {
    LAS float* scr = (LAS float*)(C.lds + C.wave * 8448);
    constexpr int TR_ITEMS = 128 + 640 + 128 + 128 + 512 + 512 + 512 + 512 + 128 + 128 + 256 + 128 + 512;
    for (int it = gw; it < TR_ITEMS; it += NGW) {
        int r = it;
#define TRJOB(W, ldw, c0, ncols, Krows, WT, r0, ks, cs) { constexpr int nb_ = (ncols) / 32, ni_ = ((Krows) / 64) * nb_; if (r < ni_) { tr_item(W, ldw, c0, WT, Krows, r0, ks, cs, scr, r, nb_, lane); continue; } r -= ni_; }
        TRJOB(IN(I_EWIN), 3088, 0,    256,  1024, WSP(bf16, WS_WIN0), 0,    IN(I_NMW), 0.125f)
        TRJOB(IN(I_EWIN), 3088, 256,  1280, 1024, WSP(bf16, WS_WIN0), 256,  IN(I_NMW), 1.0f)
        TRJOB(IN(I_EWIN), 3088, 1552, 256,  1024, WSP(bf16, WS_WIN0), 1792, IN(I_NMW), 1.0f)
        TRJOB(IN(I_EWIN), 3088, 1808, 256,  1024, WSP(bf16, WS_WIN0), 2048, IN(I_NMW), 0.125f)
        TRJOB(IN(I_EWIN), 3088, 2064, 1024, 1024, WSP(bf16, WS_WIN0), 2304, IN(I_NMW), 1.0f)
        TRJOB(IN(I_EWOUT), 1024, 0, 1024, 1024, WSP(bf16, WS_WOUT0), 0, (const float*)nullptr, 1.0f)
        TRJOB(IN(I_PLEG), 1024, 0, 1024, 1024, WSP(bf16, WS_WG), 0, IN(I_NPW), 1.0f)
        TRJOB(IN(I_PLEG) + 1024 * 1024, 1024, 0, 1024, 1024, WSP(bf16, WS_WG) + 1024 * 1024, 0, IN(I_NPW) + 1024, 1.0f)
        TRJOB(IN(I_PLEP), 1024, 0, 1024, 256, WSP(bf16, WS_WP), 0, (const float*)nullptr, 1.0f)
        TRJOB(IN(I_PLEP) + 256 * 1024, 1024, 0, 1024, 256, WSP(bf16, WS_WP) + 1024 * 256, 0, (const float*)nullptr, 1.0f)
        TRJOB(IN(I_OWIN), 1024, 512, 512, 1024, WSP(bf16, WS_WIN1), 512, IN(I_NMW) + 1024, 1.0f)
        TRJOB(IN(I_WGLU), 512, 0, 512, 512, WSP(bf16, WS_WGLU), 0, (const float*)nullptr, 1.0f)
        TRJOB(IN(I_OWOUT), 1024, 0, 1024, 1024, WSP(bf16, WS_WOUT1), 0, (const float*)nullptr, 1.0f)
#undef TRJOB
    }
    for (int idx = gt; idx < 256 * 1024; idx += NGT) { const int j = idx >> 10, k = idx & 1023; const float* wr = IN(I_EWIN) + (size_t)k * 3088 + 1536; const float* wu = IN(I_GWUP) + j; float s = 0.f;
#pragma unroll
        for (int r = 0; r < 16; ++r) s += wr[r] * wu[r * 256];
        WSP(bf16, WS_WIN0)[(size_t)(1536 + j) * 1024 + k] = (bf16)f2bf(s * IN(I_NMW)[k]); }
    for (int idx = gt; idx < SEQ * 32; idx += NGT) { const int s = idx >> 5, i = idx & 31; const double pos = (double)((const int*)IN(I_POS))[s];
        const double ang = pos * exp2(-(double)i * (13.287712379549449 / 32.0)); const double r = ang - 6.283185307179586 * rint(ang * 0.15915494309189535);
        float sn, cs; sincosf((float)r, &sn, &cs); WSP(float, WS_ROT)[2 * idx] = cs; WSP(float, WS_ROT)[2 * idx + 1] = sn; }
    for (int idx = gt; idx < 2048; idx += NGT) { const int g = idx >> 6;
        const double dt = exp((double)IN(I_LDT)[g]), are = (double)IN(I_ARE)[idx], aim = (double)IN(I_AIM)[idx];
        const double mag = exp(are * dt); double th = aim * dt; th -= 6.283185307179586 * rint(th * 0.15915494309189535);
        const double abr = mag * cos(th), abi = mag * sin(th);
        const double den = are * are + aim * aim, nr = abr - 1.0, ni = abi;
        const double cre = (nr * are + ni * aim) / den, cim = (ni * are - nr * aim) / den;
        const double m64 = exp(64.0 * are * dt); double t64 = 64.0 * aim * dt; t64 -= 6.283185307179586 * rint(t64 * 0.15915494309189535);
        float* s5 = WSP(float, WS_S5C);
        s5[S5_ABAR / 4 + 2 * idx] = (float)abr; s5[S5_ABAR / 4 + 2 * idx + 1] = (float)abi;
        s5[S5_A64 / 4 + 2 * idx] = (float)(m64 * cos(t64)); s5[S5_A64 / 4 + 2 * idx + 1] = (float)(m64 * sin(t64));
        for (int hh = 0; hh < 16; ++hh) { const double br = (double)IN(I_BRE)[idx * 16 + hh], bi = (double)IN(I_BIM)[idx * 16 + hh];
            s5[S5_BBAR / 4 + (idx * 16 + hh) * 2] = (float)(cre * br - cim * bi); s5[S5_BBAR / 4 + (idx * 16 + hh) * 2 + 1] = (float)(cre * bi + cim * br);
            bf16* bb = (bf16*)(C.ws + WS_S5C + S5_BB16) + (size_t)g * 128 * 16; const int pp_ = idx & 63;
            bb[(pp_) * 16 + hh] = (bf16)f2bf((float)(cre * br - cim * bi)); bb[(64 + pp_) * 16 + hh] = (bf16)f2bf((float)(cre * bi + cim * br)); } }
    for (int idx = gt; idx < 32 * 16 * 128; idx += NGT) { const int k = idx & 127, gh = idx >> 7;
        const float v = k < 64 ? IN(I_CRE)[gh * 64 + k] : -IN(I_CIM)[gh * 64 + k - 64]; ((bf16*)(C.ws + WS_S5C + S5_CM))[idx] = (bf16)f2bf(v); }
#pragma unroll 4
    for (int m = gw; m < NT; m += NGW) { const f32x4* xr = (const f32x4*)(IN(I_X) + (size_t)m * DM) + lane; f32x4 v[4]; float s = 0.f;
#pragma unroll
        for (int j = 0; j < 4; ++j) { v[j] = xr[64 * j]; s += (v[j][0] * v[j][0] + v[j][1] * v[j][1]) + (v[j][2] * v[j][2] + v[j][3] * v[j][3]); }
        const float rs = 1.0f / sqrtf(wave_sum(s) * (1.0f / DM) + EPS);
        unsigned long long* o8 = (unsigned long long*)(WSP(bf16, WS_A0) + (size_t)m * DM) + lane;
#pragma unroll
        for (int j = 0; j < 4; ++j) o8[64 * j] = (unsigned long long)pk2(v[j][0] * rs, v[j][1] * rs) | ((unsigned long long)pk2(v[j][2] * rs, v[j][3] * rs) << 32); }
    }
}

__device__ __forceinline__ float lg2gamma(int hh) { return __log2f(1.0f - exp2f(-5.0f - (float)hh)); }

__device__ __forceinline__ void gla_gate_local(const unsigned (&rla)[16], float bu, float (&g)[16]) {
    float run = 0.f;
#pragma unroll
    for (int c = 0; c < 16; ++c) { const float x = bf2f(rla[c]) + bu; run += logsigf(x) * (1.0f / 16.0f); g[c] = run; }
}
__device__ __forceinline__ void stage_vt(const unsigned (&v0)[16], const unsigned (&v1)[16], LAS bf16* Vt, int c0, int lane) {
    unsigned w[8];
#pragma unroll
    for (int c = 0; c < 16; c += 2) w[c >> 1] = (unsigned)v0[c] | ((unsigned)v0[c + 1] << 16);
    *(LAS v4u*)(Vt + lane * 72 + c0) = (v4u){w[0], w[1], w[2], w[3]}; *(LAS v4u*)(Vt + lane * 72 + c0 + 8) = (v4u){w[4], w[5], w[6], w[7]};
#pragma unroll
    for (int c = 0; c < 16; c += 2) w[c >> 1] = (unsigned)v1[c] | ((unsigned)v1[c + 1] << 16);
    *(LAS v4u*)(Vt + (lane + 64) * 72 + c0) = (v4u){w[0], w[1], w[2], w[3]}; *(LAS v4u*)(Vt + (lane + 64) * 72 + c0 + 8) = (v4u){w[4], w[5], w[6], w[7]};
}

__device__ __forceinline__ void phase_kv(Ctx C, const Args& A) {
    PHASE_ENTER(C);
    const int half = C.wave >> 2;
    LAS unsigned char* hb = C.lds + half * 28672;
    LAS bf16* Kt = (LAS bf16*)hb; LAS bf16* Vt = (LAS bf16*)(hb + 9216); LAS float* TOT = (LAS float*)(hb + 27648);
    const bf16* PROJ = WSP(bf16, WS_PROJ);
    unsigned r_la[16], r_k[16], r_kx[16], r_v0[16], r_v1[16]; float r_cs[16], r_sn[16]; float bu = 0.f;
#pragma unroll
    for (int c = 0; c < 16; ++c) { r_la[c] = 0u; r_kx[c] = 0u; r_cs[c] = 0.f; r_sn[c] = 0.f; r_k[c] = 0u; r_v0[c] = 0u; r_v1[c] = 0u; }
#define KV_LOAD(IT, LANE, C0) do { const int pair_ = (IT) & 3, n_ = ((IT) >> 2) & 127, b_ = (IT) >> 9; const bool ret_ = pair_ >= 2; const int hh_ = (pair_ & 1) * 2 + half; \
        const bf16* prow_ = PROJ + (size_t)(b_ * SEQ + n_ * 64 + (C0)) * PROJW; const int xoff_ = (LANE) < 32 ? 32 : -32; \
        const bf16* bK_ = prow_ + (ret_ ? 2048 + hh_ * 64 : 256 + hh_ * 64); const bf16* bV_ = prow_ + (ret_ ? 2304 + hh_ * 128 : 512 + hh_ * 128); const bf16* bL_ = prow_ + 1536 + hh_ * 64; \
        if (!ret_) { bu = IN(I_GBUP)[hh_ * 64 + (LANE)]; _Pragma("unroll") for (int c = 0; c < 16; ++c) r_la[c] = bL_[c * PROJW + (LANE)]; } \
        else { const float* rot_ = WSP(float, WS_ROT) + ((size_t)(n_ * 64 + (C0)) * 32 + ((LANE) & 31)) * 2; \
               _Pragma("unroll") for (int c = 0; c < 16; ++c) { r_kx[c] = bK_[c * PROJW + (LANE) + xoff_]; r_cs[c] = rot_[c * 64]; r_sn[c] = rot_[c * 64 + 1]; } } \
        _Pragma("unroll") for (int c = 0; c < 16; ++c) { r_k[c] = bK_[c * PROJW + (LANE)]; r_v0[c] = bV_[c * PROJW + (LANE)]; r_v1[c] = bV_[c * PROJW + (LANE) + 64]; } } while (0)
    if (C.bid < 2048) KV_LOAD(C.bid, C.lane, 16 * (C.wave & 3));
    for (int item = C.bid; item < 2048; item += C.G) {
        int lane_o = C.lane, w4_o = C.wave & 3; asm volatile("" : "+v"(lane_o), "+s"(w4_o));
        const int lane = lane_o, w4 = w4_o, fr = lane & 15, fq = lane >> 4, c0 = 16 * w4;
        const int pair = item & 3, n = (item >> 2) & 127, b = item >> 9; const bool isret = pair >= 2;
        const int hh = (pair & 1) * 2 + half, t0 = b * SEQ + n * 64;
        const bf16* prow = PROJ + (size_t)(t0 + c0) * PROJW;
        float g[16]; float glast = 0.f, off = 0.f;
        if (!isret) { gla_gate_local(r_la, bu, g); TOT[w4 * 64 + lane] = g[15]; }
        __syncthreads();
        if (!isret) {
#pragma unroll
            for (int w = 0; w < 4; ++w) { const float tv = TOT[w * 64 + lane]; glast += tv; if (w < w4) off += tv; } }
        unsigned kw[8];
        if (!isret) {
#pragma unroll
            for (int c = 0; c < 16; c += 2) { const float k0 = bf2f(r_k[c]) * __expf(glast - (off + g[c])), k1 = bf2f(r_k[c + 1]) * __expf(glast - (off + g[c + 1])); kw[c >> 1] = pk2(k0, k1); }
        } else { const float lg = lg2gamma(hh); float kv[2];
#pragma unroll
            for (int c = 0; c < 16; ++c) { const float own = bf2f(r_k[c]), oth = bf2f(r_kx[c]); const float cs = r_cs[c], sn = r_sn[c];
                const float r = lane < 32 ? own * cs - oth * sn : own * cs + oth * sn; kv[c & 1] = r * exp2f(lg * (float)(63 - (c0 + c))); if (c & 1) kw[c >> 1] = pk2(kv[0], kv[1]); } }
        *(LAS v4u*)(Kt + lane * 72 + c0) = (v4u){kw[0], kw[1], kw[2], kw[3]}; *(LAS v4u*)(Kt + lane * 72 + c0 + 8) = (v4u){kw[4], kw[5], kw[6], kw[7]};
        stage_vt(r_v0, r_v1, Vt, c0, lane);
        if (!isret && w4 == 0) WSP(float, WS_DEC)[(size_t)((b * 4 + hh) * 128 + n) * 64 + lane] = __expf(glast);
        asm volatile("" ::: "memory");
        if (item + C.G < 2048) KV_LOAD(item + C.G, lane, c0);
        __syncthreads();
        f32x4 acc[2][4];
#pragma unroll
        for (int et = 0; et < 2; ++et)
#pragma unroll
            for (int dt = 0; dt < 4; ++dt) acc[et][dt] = (f32x4){0.f, 0.f, 0.f, 0.f};
#pragma unroll
        for (int kk = 0; kk < 2; ++kk) { bf16x8 bfr[4];
#pragma unroll
            for (int dt = 0; dt < 4; ++dt) bfr[dt] = *(const LAS bf16x8*)(Kt + (dt * 16 + fr) * 72 + kk * 32 + 8 * fq);
#pragma unroll
            for (int et = 0; et < 2; ++et) { const bf16x8 afr = *(const LAS bf16x8*)(Vt + ((2 * w4 + et) * 16 + fr) * 72 + kk * 32 + 8 * fq);
#pragma unroll
                for (int dt = 0; dt < 4; ++dt) acc[et][dt] = __builtin_amdgcn_mfma_f32_16x16x32_bf16(afr, bfr[dt], acc[et][dt], 0, 0, 0); } }
        bf16* KV = WSP(bf16, WS_KV) + (size_t)((b * 8 + (isret ? 4 + hh : hh)) * 128 + n) * 8192;
#pragma unroll
        for (int et = 0; et < 2; ++et)
#pragma unroll
            for (int dt = 0; dt < 4; ++dt)
#pragma unroll
                for (int r = 0; r < 4; ++r) KV[((2 * w4 + et) * 16 + 4 * fq + r) * 64 + dt * 16 + fr] = (bf16)f2bf(acc[et][dt][r]);
        __syncthreads();
    }
#undef KV_LOAD
}

__device__ __forceinline__ void phase_scan(Ctx C, const Args& A) {
    PHASE_ENTER(C);
    for (int gid = C.bid * NTHREADS + C.tid; gid < 131072; gid += C.G * NTHREADS) {
        const int dp = gid & 31, e = (gid >> 5) & 127, bh = gid >> 12, h8 = bh & 7, b = bh >> 3;
        unsigned* p = (unsigned*)(WSP(bf16, WS_KV) + (size_t)bh * 128 * 8192 + e * 64) + dp;
        float s0 = 0.f, s1 = 0.f;
        if (h8 < 4) { const float* dec = WSP(float, WS_DEC) + (size_t)(b * 4 + h8) * 128 * 64 + 2 * dp;
#pragma unroll 8
            for (int n = 0; n < NCHUNK; ++n) { const unsigned kv = p[(size_t)n * 4096]; const float d0 = dec[n * 64], d1 = dec[n * 64 + 1]; p[(size_t)n * 4096] = pk2(s0, s1); s0 = d0 * s0 + bflo(kv); s1 = d1 * s1 + bfhi(kv); }
        } else { const float d = exp2f(64.0f * lg2gamma(h8 - 4));
#pragma unroll 8
            for (int n = 0; n < NCHUNK; ++n) { const unsigned kv = p[(size_t)n * 4096]; p[(size_t)n * 4096] = pk2(s0, s1); s0 = d * s0 + bflo(kv); s1 = d * s1 + bfhi(kv); } }
    }
}

__device__ __forceinline__ void phase_mix0_out(Ctx C, const Args& A) {
    PHASE_ENTER(C);
    const int half = C.wave >> 2;
    LAS unsigned char* hb = C.lds + half * 56320;
    LAS bf16* Qp = (LAS bf16*)hb; LAS bf16* Kp = (LAS bf16*)(hb + 9216); LAS bf16* Qpp = (LAS bf16*)(hb + 18432); LAS bf16* Vt = (LAS bf16*)(hb + 27648); LAS bf16* Pm = (LAS bf16*)(hb + 46080);
    LAS float* TOT = (LAS float*)(hb + 55296);
    const bf16* PROJ = WSP(bf16, WS_PROJ); bf16* Y = WSP(bf16, WS_A1);
    for (int item = C.bid; item < 2048; item += C.G) {
        int lane_o = C.lane, w4_o = C.wave & 3; asm volatile("" : "+v"(lane_o), "+s"(w4_o));
        const int lane = lane_o, w4 = w4_o, fr = lane & 15, fq = lane >> 4, c0 = 16 * w4;
        const int pair = item & 3, n = (item >> 2) & 127, b = item >> 9; const bool isret = pair >= 2;
        const int hh = (pair & 1) * 2 + half, t0 = b * SEQ + n * 64;
        const bf16* prow = PROJ + (size_t)(t0 + c0) * PROJW;
        const float lg = lg2gamma(hh);
        const int gcol0 = isret ? 2816 + hh * 128 : 1024 + hh * 128, ycol0 = isret ? 512 + hh * 128 : hh * 128;
        const bf16* bQ = prow + (isret ? 1792 + hh * 64 : hh * 64); const bf16* bK = prow + (isret ? 2048 + hh * 64 : 256 + hh * 64); const bf16* bV = prow + (isret ? 2304 + hh * 128 : 512 + hh * 128); const bf16* bL = prow + 1536 + hh * 64;
        const int xoff = lane < 32 ? 32 : -32;
        unsigned r_la[16], r_q[16], r_k[16], r_qx[16], r_kx[16], r_v0[16], r_v1[16]; float bu = 0.f;
#pragma unroll
        for (int c = 0; c < 16; ++c) { r_la[c] = 0u; r_qx[c] = 0u; r_kx[c] = 0u; }
        const float* rot = WSP(float, WS_ROT) + ((size_t)(n * 64 + c0) * 32 + (lane & 31)) * 2;
        if (!isret) { bu = IN(I_GBUP)[hh * 64 + lane];
#pragma unroll
            for (int c = 0; c < 16; ++c) r_la[c] = bL[c * PROJW + lane];
        } else {
#pragma unroll
            for (int c = 0; c < 16; ++c) { r_qx[c] = bQ[c * PROJW + lane + xoff]; r_kx[c] = bK[c * PROJW + lane + xoff]; } }
#pragma unroll
        for (int c = 0; c < 16; ++c) { r_q[c] = bQ[c * PROJW + lane]; r_k[c] = bK[c * PROJW + lane]; r_v0[c] = bV[c * PROJW + lane]; r_v1[c] = bV[c * PROJW + lane + 64]; }
        float g[16]; float glast = 0.f, off = 0.f;
        if (!isret) { gla_gate_local(r_la, bu, g); TOT[w4 * 64 + lane] = g[15]; }
        __syncthreads();
        if (!isret) {
#pragma unroll
            for (int w = 0; w < 4; ++w) { const float tv = TOT[w * 64 + lane]; glast += tv; if (w < w4) off += tv; }
            const float ref = 0.5f * glast;
#pragma unroll
            for (int c = 0; c < 16; ++c) { const float gq = off + g[c], q = bf2f(r_q[c]), k = bf2f(r_k[c]); const int o = (c0 + c) * 72 + lane;
                Qp[o] = (bf16)f2bf(q * __expf(gq - ref)); Kp[o] = (bf16)f2bf(k * __expf(ref - gq)); Qpp[o] = (bf16)f2bf(q * __expf(gq)); }
        } else {
#pragma unroll
            for (int c = 0; c < 16; ++c) { const float cs = rot[c * 64], sn = rot[c * 64 + 1];
                const float qo = bf2f(r_q[c]), qx = bf2f(r_qx[c]), ko = bf2f(r_k[c]), kx = bf2f(r_kx[c]);
                const float qr = lane < 32 ? qo * cs - qx * sn : qo * cs + qx * sn, kr = lane < 32 ? ko * cs - kx * sn : ko * cs + kx * sn; const int o = (c0 + c) * 72 + lane;
                Qp[o] = (bf16)f2bf(qr); Kp[o] = (bf16)f2bf(kr); Qpp[o] = (bf16)f2bf(qr * exp2f(lg * (float)(c0 + c + 1))); } }
        stage_vt(r_v0, r_v1, Vt, c0, lane);
        asm volatile("" ::: "memory");
        const bf16* St = WSP(bf16, WS_KV) + (size_t)((b * 8 + (isret ? 4 + hh : hh)) * 128 + n) * 8192;
        bf16x8 sfr[2][8]; unsigned r_g[8][4];
#pragma unroll
        for (int kk = 0; kk < 2; ++kk)
#pragma unroll
            for (int et = 0; et < 8; ++et) sfr[kk][et] = *(const bf16x8*)(St + (16 * et + fr) * 64 + kk * 32 + 8 * fq);
#pragma unroll
        for (int et = 0; et < 8; ++et)
#pragma unroll
            for (int r = 0; r < 4; ++r) r_g[et][r] = (PROJ + (size_t)(t0 + 16 * w4) * PROJW + gcol0)[(4 * fq + r) * PROJW + 16 * et + fr];
        __syncthreads();
        { f32x4 sc[4];
#pragma unroll
            for (int jt = 0; jt < 4; ++jt) sc[jt] = (f32x4){0.f, 0.f, 0.f, 0.f};
#pragma unroll
            for (int kk = 0; kk < 2; ++kk) { const bf16x8 afr = *(const LAS bf16x8*)(Qp + (16 * w4 + fr) * 72 + kk * 32 + 8 * fq);
#pragma unroll
                for (int jt = 0; jt < 4; ++jt) { const bf16x8 bfr = *(const LAS bf16x8*)(Kp + (16 * jt + fr) * 72 + kk * 32 + 8 * fq); sc[jt] = __builtin_amdgcn_mfma_f32_16x16x32_bf16(afr, bfr, sc[jt], 0, 0, 0); } }
#pragma unroll
            for (int jt = 0; jt < 4; ++jt)
#pragma unroll
                for (int r = 0; r < 4; ++r) { const int i = 16 * w4 + 4 * fq + r, j = 16 * jt + fr; float v = sc[jt][r]; if (isret) v *= exp2f(lg * (float)(i - j)); if (j > i) v = 0.f; Pm[i * 72 + j] = (bf16)f2bf(v); } }
        asm volatile("s_waitcnt lgkmcnt(0)" ::: "memory");
        f32x4 o[8];
#pragma unroll
        for (int et = 0; et < 8; ++et) o[et] = (f32x4){0.f, 0.f, 0.f, 0.f};
#pragma unroll
        for (int kk = 0; kk < 2; ++kk) { const bf16x8 afr = *(const LAS bf16x8*)(Pm + (16 * w4 + fr) * 72 + kk * 32 + 8 * fq), afr2 = *(const LAS bf16x8*)(Qpp + (16 * w4 + fr) * 72 + kk * 32 + 8 * fq);
#pragma unroll
            for (int et = 0; et < 8; ++et) { const bf16x8 bfr = *(const LAS bf16x8*)(Vt + (16 * et + fr) * 72 + kk * 32 + 8 * fq);
                o[et] = __builtin_amdgcn_mfma_f32_16x16x32_bf16(afr, bfr, o[et], 0, 0, 0); o[et] = __builtin_amdgcn_mfma_f32_16x16x32_bf16(afr2, sfr[kk][et], o[et], 0, 0, 0); } }
        float mu[4], rs[4];
#pragma unroll
        for (int r = 0; r < 4; ++r) { float s1 = 0.f;
            if (isret) {
#pragma unroll
                for (int et = 0; et < 8; ++et) s1 += o[et][r];
                s1 += __shfl_xor(s1, 1); s1 += __shfl_xor(s1, 2); s1 += __shfl_xor(s1, 4); s1 += __shfl_xor(s1, 8); }
            mu[r] = s1 * (1.0f / 128.0f); float s2 = 0.f;
#pragma unroll
            for (int et = 0; et < 8; ++et) { const float d = o[et][r] - mu[r]; s2 += d * d; }
            s2 += __shfl_xor(s2, 1); s2 += __shfl_xor(s2, 2); s2 += __shfl_xor(s2, 4); s2 += __shfl_xor(s2, 8);
            rs[r] = 1.0f / sqrtf(s2 * (1.0f / 128.0f) + EPS); }
#pragma unroll
        for (int et = 0; et < 8; ++et) { const int e = 16 * et + fr; const float nw = isret ? IN(I_RNW)[hh * 128 + e] : IN(I_GNW)[e];
#pragma unroll
            for (int r = 0; r < 4; ++r) { const int t = t0 + 16 * w4 + 4 * fq + r; const float gate = siluf(bf2f(r_g[et][r]));
                Y[(size_t)t * DM + ycol0 + e] = (bf16)f2bf((o[et][r] - mu[r]) * rs[r] * nw * gate); } }
        __syncthreads();
    }
}

__device__ __forceinline__ unsigned mono_key(float v) { const unsigned u = __float_as_uint(v); return u ^ ((unsigned)((int)u >> 31) | 0x80000000u); }
__device__ __forceinline__ float mono_val(unsigned k) { return __uint_as_float((k & 0x80000000u) ? (k ^ 0x80000000u) : ~k); }
#define CE_DESC(a, b) { const unsigned hi_ = max((a), (b)), lo_ = min((a), (b)); (a) = hi_; (b) = lo_; }
__device__ __forceinline__ void sort16_desc(unsigned (&v)[16]) {
#pragma unroll
    for (int k = 2; k <= 16; k <<= 1)
#pragma unroll
        for (int j = k >> 1; j > 0; j >>= 1)
#pragma unroll
            for (int i = 0; i < 16; ++i) { const int l = i ^ j; if (l > i) { if ((i & k) == 0) { CE_DESC(v[i], v[l]); } else { CE_DESC(v[l], v[i]); } } }
}
__device__ __forceinline__ void merge_top16(unsigned (&T)[16], const unsigned (&G)[16]) {
#pragma unroll
    for (int i = 0; i < 16; ++i) T[i] = max(T[i], G[15 - i]);
#pragma unroll
    for (int j = 8; j > 0; j >>= 1)
#pragma unroll
        for (int i = 0; i < 16; ++i) { const int l = i ^ j; if (l > i) CE_DESC(T[i], T[l]); }
}
__device__ __forceinline__ void topk_load_chunk(const bf16* SC, int tok0, int X, int q, int lane, uint2 (&nxt)[8]) {
#pragma unroll
    for (int m = 0; m < 8; ++m) { const int li = m * 8 + (lane >> 3); nxt[m] = *(const uint2*)(SC + (size_t)(tok0 + (li >> 3)) * 2048 + (li & 7) * 256 + X * 128 + q * 32 + (lane & 7) * 4); }
}
__device__ __forceinline__ void top16_list(const bf16* SC, int tok0, int X, int tok0n, int Xn, LAS float* row, int lane, unsigned (&L)[16], uint2 (&nxt)[8]) {
#pragma unroll
    for (int q = 0; q < 4; ++q) {
#pragma unroll
        for (int m = 0; m < 8; ++m) { const int li = m * 8 + (lane >> 3); const uint2 v = nxt[m];
            LAS float* dst = row + li * 33 + (lane & 7) * 4; dst[0] = bflo(v.x); dst[1] = bfhi(v.x); dst[2] = bflo(v.y); dst[3] = bfhi(v.y); }
        if (q < 3) topk_load_chunk(SC, tok0, X, q + 1, lane, nxt); else topk_load_chunk(SC, tok0n, Xn, 0, lane, nxt);
        asm volatile("s_waitcnt lgkmcnt(0)" ::: "memory");
#pragma unroll
        for (int hgrp = 0; hgrp < 2; ++hgrp) { unsigned G[16];
#pragma unroll
            for (int i = 0; i < 16; ++i) { const float v = row[lane * 33 + hgrp * 16 + i]; G[i] = (mono_key(v) & ~127u) | (unsigned)(127 - (q * 32 + hgrp * 16 + i)); }
            sort16_desc(G);
            if (q == 0 && hgrp == 0) {
#pragma unroll
                for (int i = 0; i < 16; ++i) L[i] = G[i];
            } else merge_top16(L, G); }
        asm volatile("s_waitcnt lgkmcnt(0)" ::: "memory");
    }
}
__device__ __forceinline__ void phase_topk(Ctx C, const Args& A) {
    PHASE_ENTER(C);
    const int lane = C.lane; const int gw = C.bid * NWAVES + C.wave, NGW = C.G * NWAVES;
    LAS float* row = (LAS float*)(C.lds + C.wave * 8448);
    const bf16* SC = WSP(bf16, WS_SC);
    uint2 nxt[8]; if (gw < NT / 8) topk_load_chunk(SC, gw * 8, 0, 0, lane, nxt);
    for (int it = gw; it < NT / 8; it += NGW) {
        const int tok0 = it * 8, mytok = tok0 + (lane >> 3), myh = lane & 7;
        unsigned TA[16], TB[16];
        const int tok0n = (it + NGW < NT / 8) ? (it + NGW) * 8 : tok0;
        top16_list(SC, tok0, 0, tok0, 1, row, lane, TA, nxt);
        top16_list(SC, tok0, 1, tok0n, 0, row, lane, TB, nxt);
        float sa[16], sb[16]; LAS int* irow = (LAS int*)(row + lane * 33);
#pragma unroll
        for (int i = 0; i < 16; ++i) { sa[i] = mono_val(TA[i] & ~127u); sb[i] = mono_val(TB[i] & ~127u); irow[i] = 127 - (int)(TA[i] & 127u); irow[16 + i] = 127 - (int)(TB[i] & 127u); }
        unsigned B[16];
        {
            constexpr int NC = 50;
            unsigned Gp[16];
#pragma unroll
            for (int grp = 0; grp < 4; ++grp) {
                int cnt = 0, slot = 0;
#pragma unroll
                for (int i = 0; i < 16; ++i)
#pragma unroll
                    for (int j = 0; j < 16; ++j) if ((i + 1) * (j + 1) <= 16) { if (cnt >= grp * 16 && cnt < grp * 16 + 16) { Gp[slot] = (mono_key(sa[i] + sb[j]) & ~255u) | (unsigned)(255 - (i * 16 + j)); ++slot; } ++cnt; }
#pragma unroll
                for (int z = 0; z < 16; ++z) if (z >= NC - grp * 16) Gp[z] = 0u;
                sort16_desc(Gp);
                if (grp == 0) {
#pragma unroll
                    for (int i = 0; i < 16; ++i) B[i] = Gp[i];
                } else merge_top16(B, Gp);
            }
        }
        asm volatile("s_waitcnt lgkmcnt(0)" ::: "memory");
        const float mx = mono_val(B[0] & ~255u); float ex[16]; float zs = 0.f;
#pragma unroll
        for (int r = 0; r < 16; ++r) { ex[r] = __expf(mono_val(B[r] & ~255u) - mx); zs += ex[r]; }
        const float iz = 1.0f / zs;
        int* eo = WSP(int, WS_EID) + (size_t)mytok * 128 + myh * 16; float* go = WSP(float, WS_GATE) + (size_t)mytok * 128 + myh * 16;
#pragma unroll
        for (int r4 = 0; r4 < 4; ++r4) { int ev[4]; float gv[4];
#pragma unroll
            for (int r = 0; r < 4; ++r) { const int flat = 255 - (int)(B[r4 * 4 + r] & 255u); ev[r] = irow[flat >> 4] * 128 + irow[16 + (flat & 15)]; gv[r] = ex[r4 * 4 + r] * iz; }
            *(int4*)(eo + r4 * 4) = make_int4(ev[0], ev[1], ev[2], ev[3]); *(f32x4*)(go + r4 * 4) = (f32x4){gv[0], gv[1], gv[2], gv[3]}; }
        asm volatile("s_waitcnt lgkmcnt(0)" ::: "memory");
    }
}

__device__ __forceinline__ unsigned fp4_code(float y) {
    const float a = fabsf(y);
    const unsigned c = (a > 0.25f) + (a > 0.75f) + (a > 1.25f) + (a > 1.75f) + (a > 2.5f) + (a > 3.5f) + (a > 5.0f);
    return c | (y < 0.f ? 8u : 0u);
}
__device__ __forceinline__ float wave_max64(float v) {
#pragma unroll
    for (int o = 1; o < 64; o <<= 1) v = fmaxf(v, __shfl_xor(v, o));
    return v;
}
__device__ __forceinline__ void quant_row16(const f32x4 (&v)[4], float inv, unsigned& d0, unsigned& d1) {
    unsigned w[2] = {0u, 0u};
#pragma unroll
    for (int c = 0; c < 4; ++c)
#pragma unroll
        for (int j = 0; j < 4; ++j) w[c >> 1] |= fp4_code(v[c][j] * inv) << (4 * ((c & 1) * 4 + j));
    d0 = w[0]; d1 = w[1];
}
__device__ __forceinline__ void phase_convert_peer(Ctx C, const Args& A, int l, int wg0, int nwg) {
    PHASE_ENTER(C);
    if (C.bid < wg0) return;
    const int gt = (C.bid - wg0) * NTHREADS + C.tid, NGT = nwg * NTHREADS;
    const float* U = IN(I_PU) + (size_t)l * 16384 * 1024; const float* V = IN(I_PV) + (size_t)l * 16384 * 1024; const float* nw = IN(I_NFW) + l * 1024;
#pragma unroll 2
    for (int i = gt; i < 16384 * 64; i += NGT) {
        const f32x4* up = (const f32x4*)(U + (size_t)i * 16); const f32x4* wp = (const f32x4*)(nw + (i & 63) * 16); const f32x4* vp = (const f32x4*)(V + (size_t)i * 16);
        f32x4 a[4], b[4];
#pragma unroll
        for (int c = 0; c < 4; ++c) { a[c] = up[c] * wp[c]; b[c] = vp[c]; }
        float au = 0.f, av = 0.f;
#pragma unroll
        for (int c = 0; c < 4; ++c) { au = fmaxf(au, fmaxf(fmaxf(fabsf(a[c][0]), fabsf(a[c][1])), fmaxf(fabsf(a[c][2]), fabsf(a[c][3])))); av = fmaxf(av, fmaxf(fmaxf(fabsf(b[c][0]), fabsf(b[c][1])), fmaxf(fabsf(b[c][2]), fabsf(b[c][3])))); }
        au = wave_max64(au); av = wave_max64(av);
        const float su = au > 0.f ? au * (1.0f / 6.0f) : 1.0f, sv = av > 0.f ? av * (1.0f / 6.0f) : 1.0f;
        unsigned u0, u1, v0, v1;
        quant_row16(a, 1.0f / su, u0, u1); quant_row16(b, 1.0f / sv, v0, v1);
        const int e = i >> 6, bl = i & 63;
        *(uint2*)(C.ws + WS_UT4 + (size_t)e * 512 + bl * 8) = make_uint2(u0, u1);
        *(uint2*)(C.ws + WS_VT4 + ((size_t)(bl >> 3) * 16384 + e) * 64 + (bl & 7) * 8) = make_uint2(v0, v1);
        if (bl == 0) *(float2*)(C.ws + WS_SCL + (size_t)e * 8) = make_float2(su, sv); }
    const float* P = IN(I_P) + (size_t)l * NT * 256;
#pragma unroll 4
    for (int i = gt; i < NT * 32; i += NGT) { const f32x4 a = *(const f32x4*)(P + (size_t)i * 8), b = *(const f32x4*)(P + (size_t)i * 8 + 4);
        *(v4u*)(WSP(bf16, WS_PB) + (size_t)i * 8) = (v4u){pk2(a[0], a[1]), pk2(a[2], a[3]), pk2(b[0], b[1]), pk2(b[2], b[3])}; }
}

typedef float f32x2 __attribute__((ext_vector_type(2)));
#define DPP_ADD(v, ctrl) ((v) + __builtin_bit_cast(float, __builtin_amdgcn_update_dpp(0, __builtin_bit_cast(int, (v)), (ctrl), 0xF, 0xF, true)))
__device__ __forceinline__ float row16_sum(float v) {
    v = DPP_ADD(v, 0xB1); v = DPP_ADD(v, 0x4E); v = DPP_ADD(v, 0x141); v = DPP_ADD(v, 0x140); return v;
}
__device__ __forceinline__ float wave_sum_fast(float v) { v = row16_sum(v); v += __shfl_xor(v, 16); v += __shfl_xor(v, 32); return v; }
typedef int v8i_t __attribute__((ext_vector_type(8)));
#define FP4X2(w, b) __builtin_amdgcn_cvt_scalef32_pk_f32_fp4((w), 1.0f, (b))

typedef unsigned u32x2_t __attribute__((ext_vector_type(2)));
constexpr int EU_TOK = 4, EU_CAP = 128 * EU_TOK, EU_WAVE_LDS = 8192 + 1024 * EU_TOK + 2 * 4 * EU_CAP;
__device__ __forceinline__ int eu_build(const v4u (&E)[2], LAS unsigned* wl, int lane) {
#pragma unroll
    for (int q = 0; q < 2; ++q) { v4u w;
#pragma unroll
        for (int j = 0; j < 4; ++j) w[j] = E[q][j] | ((unsigned)(q * 256 + 4 * lane + j) << 14);
        *(LAS v4u*)(wl + q * 256 + 4 * lane) = w; }
    return EU_CAP;
}
#define EU_STEP(st) { const v4u a_ = *(const LAS v4u*)((((st) & 3) == 0 ? pa0 : (((st) & 3) == 1 ? pa1 : (((st) & 3) == 2 ? pa2 : pa3))) + 256 * ((st) >> 2)); \
        const v4u b0 = *(const LAS v4u*)(((st) & 1 ? p10 : p00) + 256 * ((st) >> 1)), b1 = *(const LAS v4u*)(((st) & 1 ? p11 : p01) + 256 * ((st) >> 1)); \
        const v8i_t bb = {(int)b0[0], (int)b0[1], (int)b0[2], (int)b0[3], (int)b1[0], (int)b1[1], (int)b1[2], (int)b1[3]}; \
        const v8i_t aa = {(int)a_[0], (int)a_[1], (int)a_[2], (int)a_[3], 0, 0, 0, 0}; \
        d = __builtin_amdgcn_mfma_scale_f32_16x16x128_f8f6f4(aa, bb, d, 4, 0, 0, 0x7f7f7f7f, 0, 0x7f7f7f7f); }
__device__ __forceinline__ void eu_block_loads(v4u (&EN)[2], v4u (&XN)[EU_TOK], f32x4 (&sq)[4], const int* EID, const unsigned char* XQ, const float* SSQ, int blk, int lane) {
    const GAS v4u* ep = (const GAS v4u*)(EID + (size_t)blk * EU_CAP) + lane;
#pragma unroll
    for (int q = 0; q < 2; ++q) EN[q] = ep[64 * q];
    const GAS v4u* xp = (const GAS v4u*)(XQ + (size_t)blk * (1024 * EU_TOK)) + lane;
#pragma unroll
    for (int s = 0; s < EU_TOK; ++s) XN[s] = xp[64 * s];
    { const GAS f32x4* sp = (const GAS f32x4*)(SSQ + (size_t)(blk * EU_TOK + (lane & 3)) * 16); sq[0] = sp[0]; sq[1] = sp[1]; sq[2] = sp[2]; sq[3] = sp[3]; }
}
__device__ __forceinline__ float eu_rstd(const f32x4 (&sq)[4]) {
    const f32x4 a = sq[0], b = sq[1], c = sq[2], d = sq[3];
    const float s = (((a[0] + a[1]) + (a[2] + a[3])) + ((b[0] + b[1]) + (b[2] + b[3]))) + (((c[0] + c[1]) + (c[2] + c[3])) + ((d[0] + d[1]) + (d[2] + d[3])));
    return 1.0f / sqrtf(s * (1.0f / 1024.0f) + 1e-6f);
}
__device__ __forceinline__ void phase_experts_u(Ctx C, const Args& A) {
    PHASE_ENTER(C);
    const int lane = C.lane; const int ncls = C.G >> 3;
    if (C.bid >= ncls * 8) return;
    const int wi = C.bid * NWAVES + C.wave, NWC = ncls * 8 * NWAVES;
    const GAS unsigned char* UT = (const GAS unsigned char*)(C.ws + WS_UT4); const GAS u32x2_t* SC2 = (const GAS u32x2_t*)(C.ws + WS_SCL);
    const int* EID = WSP(int, WS_EID); const GAS float* GATE = (const GAS float*)WSP(float, WS_GATE); GAS unsigned char* COEF = (GAS unsigned char*)(C.ws + WS_COEF);
    const unsigned char* XQ = C.ws + WS_XQ; const float* SSQ = WSP(float, WS_SSQ0);
    LAS unsigned char* at = C.lds + C.wave * EU_WAVE_LDS; LAS unsigned char* xq = at + 8192; LAS unsigned* wl = (LAS unsigned*)(xq + 1024 * EU_TOK);
    constexpr int NBLK = NT / EU_TOK;
    int blk = wi; if (blk >= NBLK) return;
    v4u EN[2], XN[EU_TOK]; f32x4 rsn[4];
    eu_block_loads(EN, XN, rsn, EID, XQ, SSQ, blk, lane);
    const int kg = lane >> 4, i16 = lane & 15, s4 = lane & 3;
    const int mB = kg | (s4 << 2);
    const LAS unsigned char* xr = xq + s4 * 1024;
    const LAS unsigned char* p00 = xr + 16 * (0 ^ mB); const LAS unsigned char* p01 = xr + 16 * (4 ^ mB); const LAS unsigned char* p10 = xr + 16 * (8 ^ mB); const LAS unsigned char* p11 = xr + 16 * (12 ^ mB);
    const int mA = kg ^ i16;
    const LAS unsigned char* ar = at + 512 * i16;
    const LAS unsigned char* pa0 = ar + 16 * (0 ^ mA); const LAS unsigned char* pa1 = ar + 16 * (4 ^ mA); const LAS unsigned char* pa2 = ar + 16 * (8 ^ mA); const LAS unsigned char* pa3 = ar + 16 * (12 ^ mA);
    const GAS unsigned char* usrc[8];
    const int hrow = lane >> 5, hpos = lane & 31;
    struct UMeta { u32x2_t sc; float gate; unsigned ent; };
#define EU_PREP(WL, G, TOK0, M) { const LAS unsigned* wg_ = (WL) + 16 * (G); unsigned erw[8]; \
        _Pragma("unroll") for (int j = 0; j < 8; ++j) erw[j] = wg_[2 * j + hrow]; \
        M.ent = wg_[i16]; \
        asm volatile("s_waitcnt lgkmcnt(0)" : "+v"(erw[0]), "+v"(erw[1]), "+v"(erw[2]), "+v"(erw[3]), "+v"(erw[4]), "+v"(erw[5]), "+v"(erw[6]), "+v"(erw[7]), "+v"(M.ent) :: "memory"); \
        _Pragma("unroll") for (int j = 0; j < 8; ++j) { const int r = 2 * j + hrow; usrc[j] = UT + (size_t)(erw[j] & 0x3fffu) * 512 + 16 * (hpos ^ (r & 15)); } \
        { const GAS u32x2_t* sp_ = SC2 + (M.ent & 0x3fffu); const GAS float* gp_ = GATE + (size_t)(TOK0) * 128 + ((M.ent >> 14) & 1023u); \
          asm volatile("global_load_dwordx2 %0, %1, off" : "=v"(M.sc) : "v"(sp_) : "memory"); asm volatile("global_load_dword %0, %1, off" : "=v"(M.gate) : "v"(gp_) : "memory"); } }
#define EU_PIECE(j) { __builtin_amdgcn_sched_barrier(0); __builtin_amdgcn_global_load_lds((const GAS unsigned*)usrc[j], (LAS unsigned*)(at + 1024 * (j)), 16, 0, 0); __builtin_amdgcn_sched_barrier(0); }
#define EU_DMA(WL, G, TOK0, M) { EU_PREP(WL, G, TOK0, M) EU_PIECE(0) EU_PIECE(1) EU_PIECE(2) EU_PIECE(3) EU_PIECE(4) EU_PIECE(5) EU_PIECE(6) EU_PIECE(7) }
#define EU_MM(st) { const v8i_t bb = {(int)bR[2 * (st)][0], (int)bR[2 * (st)][1], (int)bR[2 * (st)][2], (int)bR[2 * (st)][3], (int)bR[2 * (st) + 1][0], (int)bR[2 * (st) + 1][1], (int)bR[2 * (st) + 1][2], (int)bR[2 * (st) + 1][3]}; \
        const v8i_t aa = {(int)aR[st][0], (int)aR[st][1], (int)aR[st][2], (int)aR[st][3], 0, 0, 0, 0}; \
        d = __builtin_amdgcn_mfma_scale_f32_16x16x128_f8f6f4(aa, bb, d, 4, 0, 0, 0x7f7f7f7f, 0, 0x7f7f7f7f); }
#define EU_LOADB() { _Pragma("unroll") for (int st = 0; st < 8; ++st) { bR[2 * st] = *(const LAS v4u*)(((st) & 1 ? p10 : p00) + 256 * ((st) >> 1)); bR[2 * st + 1] = *(const LAS v4u*)(((st) & 1 ? p11 : p01) + 256 * ((st) >> 1)); } \
        asm volatile("s_waitcnt lgkmcnt(0)" ::: "memory"); }
#define EU_UNIT(CUR, NXT) { \
        asm volatile("s_waitcnt vmcnt(0)" : "+v"(CUR.sc), "+v"(CUR.gate) :: "memory");     \
        v4u aR[8]; \
        _Pragma("unroll") for (int st = 0; st < 8; ++st) aR[st] = *(const LAS v4u*)((((st) & 3) == 0 ? pa0 : (((st) & 3) == 1 ? pa1 : (((st) & 3) == 2 ? pa2 : pa3))) + 256 * ((st) >> 2)); \
        asm volatile("s_waitcnt lgkmcnt(0)" ::: "memory"); \
        const bool last = g + 1 >= ng; const bool nextblk = last && hasn; \
        if (nextblk) nn = eu_build(EN, wl + (par ^ 1) * EU_CAP, lane); \
        { const LAS unsigned* wln = wl + (nextblk ? par ^ 1 : par) * EU_CAP; const int gn = last ? 0 : g + 1; const int tokn = nextblk ? blkn * EU_TOK : tok0; \
          EU_PREP(wln, gn, tokn, NXT) }     \
        f32x4 d = (f32x4){0.f, 0.f, 0.f, 0.f}; \
        EU_MM(0) asm volatile("" : "+v"(d)); EU_PIECE(0) EU_MM(1) asm volatile("" : "+v"(d)); EU_PIECE(1) EU_MM(2) asm volatile("" : "+v"(d)); EU_PIECE(2) EU_MM(3) asm volatile("" : "+v"(d)); EU_PIECE(3) \
        EU_MM(4) asm volatile("" : "+v"(d)); EU_PIECE(4) EU_MM(5) asm volatile("" : "+v"(d)); EU_PIECE(5) EU_MM(6) asm volatile("" : "+v"(d)); EU_PIECE(6) EU_MM(7) asm volatile("" : "+v"(d)); EU_PIECE(7)     \
        const unsigned ent = CUR.ent; const unsigned idx = (ent >> 14) & 1023u; \
        const int slot = (int)(ent >> 21) & 3; \
        const int src = (slot + 16 * (i16 >> 2)) << 2; \
        const float v0 = __int_as_float(__builtin_amdgcn_ds_bpermute(src, __float_as_int(d[0]))), v1 = __int_as_float(__builtin_amdgcn_ds_bpermute(src, __float_as_int(d[1]))); \
        const float v2 = __int_as_float(__builtin_amdgcn_ds_bpermute(src, __float_as_int(d[2]))), v3 = __int_as_float(__builtin_amdgcn_ds_bpermute(src, __float_as_int(d[3]))); \
        const int r4 = i16 & 3; const float val = r4 == 0 ? v0 : (r4 == 1 ? v1 : (r4 == 2 ? v2 : v3)); \
        const float rs = __int_as_float(__builtin_amdgcn_ds_bpermute(slot << 2, __float_as_int(rsl))); \
        const float coef = CUR.gate * __uint_as_float(CUR.sc.y) * gelu1(val * rs * __uint_as_float(CUR.sc.x)); \
        { const float c64 = __builtin_amdgcn_fmed3f(coef * 64.0f, -448.0f, 448.0f); const int c8 = __builtin_amdgcn_cvt_pk_fp8_f32(c64, c64, 0, false); \
          const unsigned pos = idx & 127u; \
          if (lane < 16 && (int)ent >= 0) COEF[(size_t)(tok0 + (idx >> 7)) * 128 + 16 * (pos & 7u) + (pos >> 3)] = (unsigned char)c8; } \
        asm volatile("s_waitcnt lgkmcnt(0)" ::: "memory"); \
        if (!last) ++g; \
        else { if (!hasn) break; \
              \
            _Pragma("unroll") for (int s = 0; s < EU_TOK; ++s) *(LAS v4u*)(xq + s * 1024 + 16 * (lane ^ ((s & 3) << 2))) = XN[s]; \
            EU_LOADB() rsl = eu_rstd(rsn); blk = blkn; tok0 = blk * EU_TOK; ng = nn > 16 ? (nn + 15) >> 4 : 1; g = 0; par ^= 1; \
            blkn = blk + NWC; hasn = blkn < NBLK; \
            if (hasn) eu_block_loads(EN, XN, rsn, EID, XQ, SSQ, blkn, lane); } }
    int par = 0, nn = 0, g = 0;
    int ng; { const int n0 = eu_build(EN, wl, lane); ng = n0 > 16 ? (n0 + 15) >> 4 : 1; }
#pragma unroll
    for (int s = 0; s < EU_TOK; ++s) *(LAS v4u*)(xq + s * 1024 + 16 * (lane ^ ((s & 3) << 2))) = XN[s];
    v4u bR[16]; EU_LOADB()
    float rsl = eu_rstd(rsn); int tok0 = blk * EU_TOK;
    int blkn = blk + NWC; bool hasn = blkn < NBLK;
    if (hasn) eu_block_loads(EN, XN, rsn, EID, XQ, SSQ, blkn, lane);
    UMeta MA, MB;
    EU_DMA(wl, 0, tok0, MA)
    while (true) {
        EU_UNIT(MA, MB)
        EU_UNIT(MB, MA)
    }
#undef EU_UNIT
#undef EU_MM
#undef EU_LOADB
#undef EU_DMA
#undef EU_PIECE
#undef EU_PREP
}

typedef int v2i_t __attribute__((ext_vector_type(2)));
__device__ __forceinline__ void ev_dma(LAS unsigned char* tile, const GAS unsigned char* VTl, const v4u e0, const v4u e1) {
#pragma unroll
    for (int it = 0; it < 4; ++it) __builtin_amdgcn_global_load_lds((const GAS unsigned*)(VTl + (size_t)(e0[it] << 6)), (LAS unsigned*)(tile + 1024 * it), 16, 0, 0);
#pragma unroll
    for (int it = 0; it < 4; ++it) __builtin_amdgcn_global_load_lds((const GAS unsigned*)(VTl + (size_t)(e1[it] << 6)), (LAS unsigned*)(tile + 1024 * (4 + it)), 16, 0, 0);
}
#define EV_TR(dst, base, off) asm volatile("ds_read_b64_tr_b4 %0, %1 offset:" #off : "=v"(dst) : "v"(base) : "memory")
#define EV_MMA(ct, T0, T1) { const v8i_t aa = {T0.x, T0.y, T1.x, T1.y, 0, 0, 0, 0}; \
        sel = __builtin_amdgcn_mfma_scale_f32_16x16x128_f8f6f4(aa, bb, sel, 4, 0, 0, 0x7f7f7f7f, 0, jc == (ct) ? 0x79797979 : 0); }
__device__ __forceinline__ void phase_experts_v(Ctx C, const Args& A, const bf16* hin, bf16* hbout, float* ssq_out) {
    PHASE_ENTER(C);
    const int lane = C.lane; const int ncls = C.G >> 3;
    if (C.bid >= ncls * 8) return;
    const int x = C.bid & 7; const int wi = (C.bid >> 3) * NWAVES + C.wave, NWC = ncls * NWAVES;
    const int ps = lane >> 2, q4 = lane & 3, r16 = lane & 15, kg = lane >> 4, jc = lane & 7;
    const GAS unsigned char* VTl = (const GAS unsigned char*)(C.ws + WS_VT4) + (size_t)x * 16384 * 64 + 16 * (q4 ^ ((ps >> 2) & 3));
    const GAS int* EID = (const GAS int*)WSP(int, WS_EID) + 8 * ps; const GAS unsigned char* COEF = (const GAS unsigned char*)(C.ws + WS_COEF) + 16 * kg;
    const int hoff = 128 * x + 16 * jc + 4 * kg;
    LAS unsigned char* tile0 = C.lds + C.wave * 16384;
    const int fsw = (r16 >> 2) & 3; const int rowoff = 64 * (32 * kg + r16);
    int t = wi; if (t >= NT) return;
    v4u ea0, ea1, eb0, eb1, cb0, cb1; u32x2_t hres, ypk = {0u, 0u}; float yss = 0.f; int tp = -1;
    { const GAS v4u* p = (const GAS v4u*)(EID + (size_t)t * 128); ea0 = p[0]; ea1 = p[1]; }
    ev_dma(tile0, VTl, ea0, ea1);
    { const GAS unsigned char* cp = COEF + (size_t)t * 128; cb0 = *(const GAS v4u*)cp; cb1 = *(const GAS v4u*)(cp + 64); hres = *(const GAS u32x2_t*)(hin + (size_t)t * DM + hoff); }
    int t1 = t + NWC < NT ? t + NWC : t;
    { const GAS v4u* p = (const GAS v4u*)(EID + (size_t)t1 * 128); eb0 = p[0]; eb1 = p[1]; }
    int par = 0;
    while (true) {
        asm volatile("s_waitcnt vmcnt(0)" ::: "memory");
        const v8i_t bb = {(int)cb0[0], (int)cb0[1], (int)cb0[2], (int)cb0[3], (int)cb1[0], (int)cb1[1], (int)cb1[2], (int)cb1[3]};
        const u32x2_t hcur = hres;
        LAS unsigned char* tile = tile0 + 8192 * par;
        const bool more = t + NWC < NT;
        const GAS unsigned char* dsrc[8];
#pragma unroll
        for (int it = 0; it < 4; ++it) { dsrc[it] = VTl + (size_t)(eb0[it] << 6); dsrc[4 + it] = VTl + (size_t)(eb1[it] << 6); }
#pragma unroll
        for (int it = 0; it < 8; ++it) asm volatile("" : "+v"(dsrc[it]));
        if (tp >= 0) { if ((lane & 8) == 0) *(GAS u32x2_t*)(hbout + (size_t)tp * DM + hoff) = ypk;
                       if (lane < 2) ((GAS float*)ssq_out)[(size_t)tp * 16 + 2 * x + lane] = lane == 0 ? yss : 0.f; }
        { const GAS unsigned char* cp = COEF + (size_t)t1 * 128; cb0 = *(const GAS v4u*)cp; cb1 = *(const GAS v4u*)(cp + 64); hres = *(const GAS u32x2_t*)(hin + (size_t)t1 * DM + hoff); }
        const int t2 = t1 + NWC < NT ? t1 + NWC : t1;
        { const GAS v4u* p = (const GAS v4u*)(EID + (size_t)t2 * 128); eb0 = p[0]; eb1 = p[1]; }
        LAS unsigned char* tilen = tile0 + 8192 * (par ^ 1);
        const unsigned o0 = (unsigned)(size_t)(tile + rowoff + 16 * (0 ^ fsw)), o1 = (unsigned)(size_t)(tile + rowoff + 16 * (1 ^ fsw));
        const unsigned o2 = (unsigned)(size_t)(tile + rowoff + 16 * (2 ^ fsw)), o3 = (unsigned)(size_t)(tile + rowoff + 16 * (3 ^ fsw));
        v2i_t a00, a01, a10, a11, a20, a21, a30, a31, a40, a41, a50, a51, a60, a61, a70, a71;
        EV_TR(a00, o0, 0); EV_TR(a01, o0, 1024); EV_TR(a10, o0, 8); EV_TR(a11, o0, 1032);
        EV_TR(a20, o1, 0); EV_TR(a21, o1, 1024); EV_TR(a30, o1, 8); EV_TR(a31, o1, 1032);
        EV_TR(a40, o2, 0); EV_TR(a41, o2, 1024); EV_TR(a50, o2, 8); EV_TR(a51, o2, 1032);
        EV_TR(a60, o3, 0); EV_TR(a61, o3, 1024); EV_TR(a70, o3, 8); EV_TR(a71, o3, 1032);
        asm volatile("s_waitcnt lgkmcnt(0)" : "+v"(a00), "+v"(a01), "+v"(a10), "+v"(a11), "+v"(a20), "+v"(a21), "+v"(a30), "+v"(a31), "+v"(a40), "+v"(a41), "+v"(a50), "+v"(a51), "+v"(a60), "+v"(a61), "+v"(a70), "+v"(a71) :: "memory");
        f32x4 sel = (f32x4){0.f, 0.f, 0.f, 0.f};
#define EV_PIECE(it, E) { asm volatile("" : "+v"(sel)); __builtin_amdgcn_sched_barrier(0); __builtin_amdgcn_global_load_lds((const GAS unsigned*)dsrc[it], (LAS unsigned*)(tilen + 1024 * (it)), 16, 0, 0); __builtin_amdgcn_sched_barrier(0); }
        EV_MMA(0, a00, a01) EV_PIECE(0, ec0[0]) EV_MMA(1, a10, a11) EV_PIECE(1, ec0[1]) EV_MMA(2, a20, a21) EV_PIECE(2, ec0[2]) EV_MMA(3, a30, a31) EV_PIECE(3, ec0[3])
        EV_MMA(4, a40, a41) EV_PIECE(4, ec1[0]) EV_MMA(5, a50, a51) EV_PIECE(5, ec1[1]) EV_MMA(6, a60, a61) EV_PIECE(6, ec1[2]) EV_MMA(7, a70, a71) EV_PIECE(7, ec1[3])
#undef EV_PIECE
        const float y0 = bflo(hcur.x) + sel[0], y1 = bfhi(hcur.x) + sel[1], y2 = bflo(hcur.y) + sel[2], y3 = bfhi(hcur.y) + sel[3];
        ypk.x = pg8::cvt_pk_bf16(y0, y1); ypk.y = pg8::cvt_pk_bf16(y2, y3);
        const float s2 = (lane & 8) == 0 ? (y0 * y0 + y1 * y1) + (y2 * y2 + y3 * y3) : 0.f;
        yss = wave_sum_fast(s2); tp = t;
        asm volatile("s_waitcnt lgkmcnt(0)" ::: "memory");
        if (!more) break;
        t = t1; t1 = t2; par ^= 1;
    }
    if ((lane & 8) == 0) *(GAS u32x2_t*)(hbout + (size_t)tp * DM + hoff) = ypk;
    if (lane < 2) ((GAS float*)ssq_out)[(size_t)tp * 16 + 2 * x + lane] = lane == 0 ? yss : 0.f;
}

template <int WIN> __device__ __forceinline__ void pool_run(const bf16* U, bf16* Y, int b, int p0, int cp) {
    const unsigned* ub = (const unsigned*)(U + (size_t)b * SEQ * DM + 2 * cp);
    unsigned w[16 + WIN - 1];
#pragma unroll
    for (int i = 0; i < 16 + WIN - 1; ++i) { const int pos = p0 - (WIN - 1) + i; w[i] = pos >= 0 ? ub[(size_t)pos * (DM / 2)] : 0u; }
    float s0 = 0.f, s1 = 0.f;
#pragma unroll
    for (int i = 0; i < WIN - 1; ++i) { s0 += bflo(w[i]); s1 += bfhi(w[i]); }
    unsigned* yb = (unsigned*)(Y + (size_t)b * SEQ * DM + 2 * cp);
#pragma unroll
    for (int t = 0; t < 16; ++t) { const int pos = p0 + t; const float c0 = bflo(w[WIN - 1 + t]), c1 = bfhi(w[WIN - 1 + t]); s0 += c0; s1 += c1;
        const float inv = 1.0f / (float)(pos + 1 < WIN ? pos + 1 : WIN);
        yb[(size_t)pos * (DM / 2)] = pk2(s0 * inv - c0, s1 * inv - c1);
        s0 -= bflo(w[t]); s1 -= bfhi(w[t]); }
}
__device__ __forceinline__ void phase_pool(Ctx C, const Args& A) {
    PHASE_ENTER(C);
    const bf16* U = WSP(bf16, WS_U); bf16* Y = WSP(bf16, WS_A1);
    const int cp = C.tid & 255, th = C.tid >> 8, grp = (C.wave & 3);
    for (int it = C.bid; it < 1024; it += C.G) { const int b = it >> 8, p0 = (it & 255) * 32 + th * 16;
        if (grp == 0) pool_run<2>(U, Y, b, p0, cp); else if (grp == 1) pool_run<4>(U, Y, b, p0, cp); else if (grp == 2) pool_run<8>(U, Y, b, p0, cp); else pool_run<16>(U, Y, b, p0, cp); }
}
__device__ __forceinline__ void s5_wave_consts(const Ctx& C, int g, int lane, float& abr, float& abi, bf16x8 (&bfr)[8]) {
    const float* s5 = WSP(float, WS_S5C); const int idx = g * 64 + lane, fr = lane & 15, fq = lane >> 4;
    abr = s5[S5_ABAR / 4 + 2 * idx]; abi = s5[S5_ABAR / 4 + 2 * idx + 1];
    const bf16* BB = (const bf16*)(C.ws + WS_S5C + S5_BB16) + (size_t)g * 128 * 16;
#pragma unroll
    for (int ct = 0; ct < 8; ++ct) { bf16x8 z = {0, 0, 0, 0, 0, 0, 0, 0}; if (fq < 2) z = *(const bf16x8*)(BB + (16 * ct + fr) * 16 + 8 * fq); bfr[ct] = z; }
}
__device__ __forceinline__ void s5_bu_tile(const bf16x8 afr, const bf16x8 (&bfr)[8], LAS float* BUL, int fr, int fq) {
#pragma unroll
    for (int ct = 0; ct < 8; ++ct) { const f32x4 d = __builtin_amdgcn_mfma_f32_16x16x32_bf16(afr, bfr[ct], (f32x4){0.f, 0.f, 0.f, 0.f}, 0, 0, 0);
#pragma unroll
        for (int r = 0; r < 4; ++r) BUL[(4 * fq + r) * 132 + (ct >> 2) * 64 + (ct & 3) * 16 + fr] = d[r]; }
}
__device__ __forceinline__ void phase_s5_local(Ctx C, const Args& A) {
    PHASE_ENTER(C);
    const int lane = C.lane, fr = lane & 15, fq = lane >> 4; const int gw = C.bid * NWAVES + C.wave, NGW = C.G * NWAVES;
    LAS float* BUL = (LAS float*)(C.lds + C.wave * 8448);
    int gprev = -1; float abr = 0.f, abi = 0.f; bf16x8 bfr[8];
    for (int it = gw; it < 16384; it += NGW) { const int g = it & 31, bn = it >> 5;
        if (g != gprev) { s5_wave_consts(C, g, lane, abr, abi, bfr); gprev = g; }
        const bf16* ubase = WSP(bf16, WS_U) + (size_t)bn * 64 * DM + 512 + g * 16;
        bf16x8 afr[4];
#pragma unroll
        for (int sub = 0; sub < 4; ++sub) { bf16x8 z = {0, 0, 0, 0, 0, 0, 0, 0}; if (fq < 2) z = *(const bf16x8*)(ubase + (size_t)(sub * 16 + fr) * DM + 8 * fq); afr[sub] = z; }
        float xr = 0.f, xi = 0.f;
#pragma unroll
        for (int sub = 0; sub < 4; ++sub) {
            s5_bu_tile(afr[sub], bfr, BUL, fr, fq);
            asm volatile("s_waitcnt lgkmcnt(0)" ::: "memory");
#pragma unroll
            for (int tt = 0; tt < 16; ++tt) { const float br = BUL[tt * 132 + lane], bi = BUL[tt * 132 + 64 + lane]; const float nr = abr * xr - abi * xi + br, ni = abr * xi + abi * xr + bi; xr = nr; xi = ni; }
            asm volatile("s_waitcnt lgkmcnt(0)" ::: "memory");
        }
        float* e = WSP(float, WS_E) + ((size_t)(bn * 32 + g) * 64 + lane) * 2; e[0] = xr; e[1] = xi; }
}
__device__ __forceinline__ void phase_s5_carry(Ctx C, const Args& A) {
    PHASE_ENTER(C);
    for (int gid = C.bid * NTHREADS + C.tid; gid < 8192; gid += C.G * NTHREADS) { const int p = gid & 63, g = (gid >> 6) & 31, b = gid >> 11;
        const float* s5 = WSP(float, WS_S5C); const float ar = s5[S5_A64 / 4 + 2 * (g * 64 + p)], ai = s5[S5_A64 / 4 + 2 * (g * 64 + p) + 1];
        float2* e = (float2*)WSP(float, WS_E) + ((size_t)(b * 128) * 32 + g) * 64 + p; float cr = 0.f, ci = 0.f;
#pragma unroll 8
        for (int n = 0; n < NCHUNK; ++n) { const float2 tv = e[(size_t)n * 2048]; e[(size_t)n * 2048] = make_float2(cr, ci); const float nr = ar * cr - ai * ci + tv.x, ni = ar * ci + ai * cr + tv.y; cr = nr; ci = ni; } }
}
__device__ __forceinline__ void phase_s5_out(Ctx C, const Args& A) {
    PHASE_ENTER(C);
    const int lane = C.lane, fr = lane & 15, fq = lane >> 4; const int gw = C.bid * NWAVES + C.wave, NGW = C.G * NWAVES;
    LAS float* BUL = (LAS float*)(C.lds + C.wave * 12800);
    LAS bf16* XL = (LAS bf16*)(C.lds + C.wave * 12800 + 8448);
    int gprev = -1; float abr = 0.f, abi = 0.f; bf16x8 bfr[8]; bf16x8 cm[4]; float dsk = 0.f;
    for (int it = gw; it < 16384; it += NGW) { const int g = it & 31, bn = it >> 5;
        if (g != gprev) { s5_wave_consts(C, g, lane, abr, abi, bfr); gprev = g;
            const bf16* CM = (const bf16*)(C.ws + WS_S5C + S5_CM) + (size_t)(g * 16 + fr) * 128;
#pragma unroll
            for (int kk = 0; kk < 4; ++kk) cm[kk] = *(const bf16x8*)(CM + kk * 32 + 8 * fq);
            dsk = IN(I_DSK)[g * 16 + fr]; }
        const bf16* ubase = WSP(bf16, WS_U) + (size_t)bn * 64 * DM + 512 + g * 16;
        bf16x8 afr[4];
#pragma unroll
        for (int sub = 0; sub < 4; ++sub) { bf16x8 z = {0, 0, 0, 0, 0, 0, 0, 0}; if (fq < 2) z = *(const bf16x8*)(ubase + (size_t)(sub * 16 + fr) * DM + 8 * fq); afr[sub] = z; }
        const float* e = WSP(float, WS_E) + ((size_t)(bn * 32 + g) * 64 + lane) * 2; float xr = e[0], xi = e[1];
        unsigned short uskip[4][4];
#pragma unroll
        for (int sub = 0; sub < 4; ++sub)
#pragma unroll
            for (int r = 0; r < 4; ++r) uskip[sub][r] = ubase[(size_t)(sub * 16 + 4 * fq + r) * DM + fr];
#pragma unroll
        for (int sub = 0; sub < 4; ++sub) {
            s5_bu_tile(afr[sub], bfr, BUL, fr, fq);
            asm volatile("s_waitcnt lgkmcnt(0)" ::: "memory");
#pragma unroll
            for (int tt = 0; tt < 16; ++tt) { const float br = BUL[tt * 132 + lane], bi = BUL[tt * 132 + 64 + lane]; const float nr = abr * xr - abi * xi + br, ni = abr * xi + abi * xr + bi; xr = nr; xi = ni;
                XL[tt * 136 + lane] = (bf16)f2bf(xr); XL[tt * 136 + 64 + lane] = (bf16)f2bf(xi); }
            asm volatile("s_waitcnt lgkmcnt(0)" ::: "memory");
            f32x4 acc = (f32x4){0.f, 0.f, 0.f, 0.f};
#pragma unroll
            for (int kk = 0; kk < 4; ++kk) { const bf16x8 a = *(const LAS bf16x8*)(XL + fr * 136 + kk * 32 + 8 * fq); acc = __builtin_amdgcn_mfma_f32_16x16x32_bf16(a, cm[kk], acc, 0, 0, 0); }
#pragma unroll
            for (int r = 0; r < 4; ++r) { const size_t tok = (size_t)bn * 64 + sub * 16 + 4 * fq + r; const float uv = bf2f(uskip[sub][r]);
                WSP(bf16, WS_Z)[tok * 512 + g * 16 + fr] = (bf16)f2bf(gelu1(acc[r] + dsk * uv)); }
            asm volatile("s_waitcnt lgkmcnt(0)" ::: "memory");
        } }
}
__device__ __forceinline__ void phase_final_norm(Ctx C, const Args& A, const bf16* hin) {
    PHASE_ENTER(C);
    const int lane = C.lane; const int gw = C.bid * NWAVES + C.wave, NGW = C.G * NWAVES; const f32x4* wv = (const f32x4*)IN(I_FNW) + 4 * lane;
#pragma unroll 4
    for (int m = gw; m < NT; m += NGW) { const v4u* hr = (const v4u*)(hin + (size_t)m * DM + 16 * lane); f32x4 v[4]; float s = 0.f;
#pragma unroll
        for (int c = 0; c < 2; ++c) { const v4u hw = hr[c]; v[2 * c] = (f32x4){bflo(hw[0]), bfhi(hw[0]), bflo(hw[1]), bfhi(hw[1])}; v[2 * c + 1] = (f32x4){bflo(hw[2]), bfhi(hw[2]), bflo(hw[3]), bfhi(hw[3])}; }
#pragma unroll
        for (int j = 0; j < 4; ++j) s += (v[j][0] * v[j][0] + v[j][1] * v[j][1]) + (v[j][2] * v[j][2] + v[j][3] * v[j][3]);
        const float rs = 1.0f / sqrtf(wave_sum(s) * (1.0f / DM) + EPS);
        f32x4* o = (f32x4*)(C.h + (size_t)m * DM + 16 * lane);
#pragma unroll
        for (int j = 0; j < 4; ++j) o[j] = v[j] * rs * wv[j]; }
}

constexpr int CW_BAR = 1024;

__global__ void __launch_bounds__(NTHREADS, 2) mk_fwd(Args A) {
    extern __shared__ __attribute__((aligned(16))) unsigned char lds_raw[];
    Ctx C;
    C.lds = (LAS unsigned char*)lds_raw; C.tid = threadIdx.x; C.lane = C.tid & 63; C.wave = __builtin_amdgcn_readfirstlane(C.tid >> 6); C.G = gridDim.x; C.bid = blockIdx.x;
    C.h = A.out; C.ws = A.ws;
    volatile LAS unsigned* MISC = (volatile LAS unsigned*)(C.lds + MISC_OFF);
    for (int u = C.tid; u < (LDS_BYTES - RING_BYTES) / 4; u += NTHREADS) ((LAS unsigned*)(C.lds + RING_BYTES))[u] = 0u;
    __syncthreads();
    if (C.tid == 0) {
#pragma unroll
        for (int i = 0; i < N_IN; ++i) ((LAS unsigned long long*)(C.lds + PTR_OFF))[i] = (unsigned long long)A.in[i];
    }
    __syncthreads();
    XcdBarrier bar = xcd_barrier_post((unsigned*)(C.ws + WS_CTL) + CW_BAR, MISC + 8);
#define GBAR() xcd_barrier(bar)
#define FRESH() do { asm volatile("" : "+s"(C.ws), "+s"(C.h)); C.ws = (unsigned char*)(GAS unsigned char*)C.ws; C.h = (float*)(GAS float*)C.h; } while (0)
#define GEMM(EpiT, E, Ap, Bp, Mv, Nv, Kv) do { pg8::Gemm g_{(const pg8::bf16_t*)(Ap), (const pg8::bf16_t*)(Bp), Mv, Nv, Kv}; pg8::StaticOrder S_; S_.init(Mv, Nv, C.G, C.bid); \
        pg8::gemm_phase<EpiT, pg8::StaticOrder, true, true>(C.lds, g_, S_, E); } while (0)
    float* SSQ0 = WSP(float, WS_SSQ0); float* SSQ1 = WSP(float, WS_SSQ1);
    bf16* A0 = WSP(bf16, WS_A0); bf16* A1 = WSP(bf16, WS_A1);

#ifndef PROBE_MASK
#define PROBE_MASK 0
#endif
#define REP(k) for (int rep_ = 0; rep_ < (((PROBE_MASK) >> (k)) & 1 ? 2 : 1); ++rep_)
    REP(4) phase_prologue(C, A);
    GBAR();
    REP(0) { FRESH(); { pg8::EpiBf16<0> E{(pg8::bf16_t*)WSP(bf16, WS_PROJ), PROJW, nullptr, 0, 0, 1.f}; GEMM(pg8::EpiBf16<0>, E, A0, WSP(bf16, WS_WIN0), NT, PROJW, DM); } }
    GBAR();
    REP(1) phase_kv(C, A);
    GBAR();
    phase_scan(C, A); GBAR();
    REP(1) phase_mix0_out(C, A);
    GBAR();
    REP(0) { FRESH(); { pg8::EpiRes E{IN(I_X), nullptr, (pg8::bf16_t*)A0, SSQ0, C.ws + WS_XQ}; GEMM(pg8::EpiRes, E, A1, WSP(bf16, WS_WOUT0), NT, DM, DM); } }
    GBAR();
    REP(0) { FRESH(); { pg8::EpiScaleBf16 E{(pg8::bf16_t*)WSP(bf16, WS_SC), 2048, SSQ0}; GEMM(pg8::EpiScaleBf16, E, A0, WSP(bf16, WS_WEFF) + (size_t)0 * 2048 * 1024, NT, 2048, DM); } }
    GBAR();
    REP(2) phase_topk(C, A);
    REP(5) phase_convert_peer(C, A, 0, 0, C.G);
    GBAR();
    REP(8) phase_experts_u(C, A);
    GBAR();
    REP(9) phase_experts_v(C, A, A0, A1, SSQ1);
    __syncthreads();
    REP(0) { FRESH(); { pg8::EpiBf16<0> E{(pg8::bf16_t*)WSP(bf16, WS_PP), DM, nullptr, 0, 0, 1.f}; GEMM(pg8::EpiBf16<0>, E, WSP(bf16, WS_PB), WSP(bf16, WS_WP) + (size_t)0 * 1024 * 256, NT, DM, 256); } }
    GBAR();
    FRESH(); { pg8::EpiPle E{(const pg8::bf16_t*)A1, (const pg8::bf16_t*)WSP(bf16, WS_PP), (pg8::bf16_t*)A0, SSQ1, SSQ0}; GEMM(pg8::EpiPle, E, A1, WSP(bf16, WS_WG) + (size_t)0 * 1024 * 1024, NT, DM, DM); }
    GBAR();

    REP(0) { FRESH(); { pg8::EpiScaleBf16 E{(pg8::bf16_t*)WSP(bf16, WS_U), DM, SSQ0}; GEMM(pg8::EpiScaleBf16, E, A0, WSP(bf16, WS_WIN1), NT, DM, DM); } }
    GBAR();
    REP(6) { phase_s5_local(C, A); phase_pool(C, A); }
    GBAR();
    phase_s5_carry(C, A);
    phase_convert_peer(C, A, 1, 16, C.G - 16); GBAR();
    REP(7) phase_s5_out(C, A);
    GBAR();
    REP(0) { FRESH(); { pg8::EpiGlu E{(const pg8::bf16_t*)WSP(bf16, WS_Z), 512, IN(I_BGLU), (pg8::bf16_t*)A1, DM, 512}; GEMM(pg8::EpiGlu, E, WSP(bf16, WS_Z), WSP(bf16, WS_WGLU), NT, 512, 512); } }
    GBAR();
    FRESH(); { pg8::EpiRes E{nullptr, (const pg8::bf16_t*)A0, (pg8::bf16_t*)A0, SSQ0, C.ws + WS_XQ}; GEMM(pg8::EpiRes, E, A1, WSP(bf16, WS_WOUT1), NT, DM, DM); }
    GBAR();

    REP(0) { FRESH(); { pg8::EpiScaleBf16 E{(pg8::bf16_t*)WSP(bf16, WS_SC), 2048, SSQ0}; GEMM(pg8::EpiScaleBf16, E, A0, WSP(bf16, WS_WEFF) + (size_t)1 * 2048 * 1024, NT, 2048, DM); } }
    GBAR();
    REP(2) phase_topk(C, A);
    GBAR();
    REP(8) phase_experts_u(C, A);
    GBAR();
    REP(9) phase_experts_v(C, A, A0, A1, SSQ1);
    __syncthreads();
    REP(0) { FRESH(); { pg8::EpiBf16<0> E{(pg8::bf16_t*)WSP(bf16, WS_PP), DM, nullptr, 0, 0, 1.f}; GEMM(pg8::EpiBf16<0>, E, WSP(bf16, WS_PB), WSP(bf16, WS_WP) + (size_t)1 * 1024 * 256, NT, DM, 256); } }
    GBAR();
    FRESH(); { pg8::EpiPle E{(const pg8::bf16_t*)A1, (const pg8::bf16_t*)WSP(bf16, WS_PP), (pg8::bf16_t*)A0, SSQ1, SSQ0}; GEMM(pg8::EpiPle, E, A1, WSP(bf16, WS_WG) + (size_t)1 * 1024 * 1024, NT, DM, DM); }
    GBAR();

    phase_final_norm(C, A, A0);
}

extern "C" void kernel_launch(void* const* d_in, const int* in_sizes, int n_in, void* d_out, int out_size, void* d_ws, size_t ws_size, hipStream_t stream) {
    static int grid = 0;
    if (grid == 0) {
        if (n_in != N_IN || out_size != NT * DM || ws_size < WS_END) { fprintf(stderr, "kernel_launch: unexpected shapes (n_in %d, out %d, ws %zu, need %zu)\n", n_in, out_size, ws_size, (size_t)WS_END); grid = -1; return; }
        int dev = 0, cus = 0, per_cu = 0;
        if (hipGetDevice(&dev) != hipSuccess || hipDeviceGetAttribute(&cus, hipDeviceAttributeMultiprocessorCount, dev) != hipSuccess) { grid = -1; return; }
        if (hipFuncSetAttribute((const void*)mk_fwd, hipFuncAttributeMaxDynamicSharedMemorySize, LDS_BYTES) != hipSuccess) { fprintf(stderr, "kernel_launch: hipFuncSetAttribute failed\n"); grid = -1; return; }
        if (hipOccupancyMaxActiveBlocksPerMultiprocessor(&per_cu, (const void*)mk_fwd, NTHREADS, LDS_BYTES) != hipSuccess || per_cu < 1) { fprintf(stderr, "kernel_launch: occupancy query says %d blocks per CU\n", per_cu); grid = -1; return; }
        grid = cus;
    }
    if (grid < 0) return;
    if (hipMemsetAsync((char*)d_ws + WS_CTL, 0, CTL_ZERO_BYTES, stream) != hipSuccess) return;
    Args a{};
    for (int i = 0; i < N_IN; ++i) a.in[i] = d_in[i];
    a.out = (float*)d_out; a.ws = (unsigned char*)d_ws;
    void* kargs[] = {&a};
    const hipError_t le = hipLaunchCooperativeKernel((const void*)mk_fwd, dim3(grid), dim3(NTHREADS), kargs, LDS_BYTES, stream);
    if (le != hipSuccess) fprintf(stderr, "kernel_launch: cooperative launch failed: %s (grid %d)\n", hipGetErrorString(le), grid);
}
```

```cpp
#include <hip/hip_runtime.h>
#include <hip/hip_cooperative_groups.h>
#include <cstdio>
#include <cstdint>
namespace cg = cooperative_groups;
namespace pg8 {
#define PG8_LAS __attribute__((address_space(3)))
typedef unsigned short bf16_t;
typedef short bf16x8 __attribute__((ext_vector_type(8)));
typedef float f32x4 __attribute__((ext_vector_type(4)));
typedef unsigned u32x4 __attribute__((ext_vector_type(4)));
constexpr int BM = 256, BK = 64, HALF = 128, HTB = HALF * BK * 2  , STAGE_BYTES = 8 * HTB, NXCD = 8, WGM = 8;

__host__ __device__ __forceinline__ int lds_byte(int r, int c) { const int st = (r >> 4) * 2 + (c >> 5), rr = r & 15, cc = c & 31, ob = rr * 64 + cc * 2; return st * 1024 + (ob ^ (((ob >> 9) & 1) << 5)); }
__host__ __device__ __forceinline__ void stage_rc(int b, int& R, int& C) { const int st = b / 1024, sb = b % 1024, swz = sb ^ (((sb >> 9) & 1) << 5); R = (st >> 1) * 16 + swz / 64; C = (st & 1) * 32 + (swz % 64) / 2; }
__host__ __device__ __forceinline__ int perm32(int rho) { const int n = rho >> 4, i = rho & 15; return 8 * (i >> 2) + 4 * n + (i & 3); }

struct Unit { int pm, pn; };
struct Gemm { const bf16_t* A; const bf16_t* Bt; int M, N, K; };

struct StaticOrder {
    int nM, nN, nwg, G, c;
    __host__ __device__ void init(int M, int N, int G_, int c_) { nM = M / BM; nN = N / BM; nwg = nM * nN; G = G_; c = c_; }
    __host__ __device__ bool next(int i, Unit& u) const {
        const long L = (long)i * G + c; if (L >= nwg) return false;
        int wgid = (int)L; { const int q = nwg / NXCD, r = nwg % NXCD, xcd = wgid % NXCD, off = wgid / NXCD; wgid = (xcd < r ? xcd * (q + 1) : r * (q + 1) + (xcd - r) * q) + off; }
        const int nig = WGM * nN, gid = wgid / nig, fm = gid * WGM, gsz = (nM - fm) < WGM ? (nM - fm) : WGM;
        u.pm = fm + ((wgid % nig) % gsz); u.pn = (wgid % nig) / gsz; return true;
    }
    __device__ __forceinline__ void a_ready(const Unit&) const {}
    __device__ __forceinline__ void done(const Unit&) const {}
};

__device__ __forceinline__ unsigned cvt_pk_bf16(float lo, float hi) { unsigned r; asm volatile("v_cvt_pk_bf16_f32 %0, %1, %2" : "=v"(r) : "v"(lo), "v"(hi)); return r; }
typedef float f32x2 __attribute__((ext_vector_type(2)));
__device__ __forceinline__ f32x2 gelu_pk(f32x2 v) {
    const f32x2 av = __builtin_elementwise_abs(v), d = av * 0.2316418882f + 1.0f;
    f32x2 t; t.x = __builtin_amdgcn_rcpf(d.x); t.y = __builtin_amdgcn_rcpf(d.y);
    f32x2 q = t * 0.5307027145f + (-0.7265760135f); q = q * t + 0.7107068705f; q = q * t + (-0.142248368f); q = q * t + 0.127414796f; q = q * t;
    const f32x2 s = (v * v) * (-0.72134752044f);
    f32x2 e; e.x = __builtin_amdgcn_exp2f(s.x); e.y = __builtin_amdgcn_exp2f(s.y);
    const f32x2 m = v * (q * e), r = v - m;
    f32x2 o; o.x = v.x < 0.f ? m.x : r.x; o.y = v.y < 0.f ? m.y : r.y; return o;
}

template <int ACT  > struct EpiBf16 {
    static constexpr bool PERM = true, AFTER_DRAIN = false; static_assert(ACT == 0 || ACT == 1, "EpiBf16: ACT is 0 (none) or 1 (gelu_pk)");
    bf16_t* O; int ldc; const float* bias; int split_cols; size_t split_stride; float scale0;
    __device__ __forceinline__ void operator()(const f32x4 (&acc)[2][2][4][2], const Unit& u, int wr, int wc, int fr, int fq) const {
        const int row0 = u.pm * BM + wr * 64 + fr; int colt = u.pn * BM; bf16_t* base = O;
        float sc = 1.f; if (split_cols) { const int t = colt / split_cols; base += (size_t)t * split_stride; colt -= t * split_cols; if (t == 0) sc = scale0; }
        const int col0 = colt + wc * 32 + 8 * fq, bcol0 = u.pn * BM + wc * 32 + 8 * fq;
        f32x4 bv[2][2];
#pragma unroll
        for (int bj = 0; bj < 2; ++bj)
#pragma unroll
            for (int n = 0; n < 2; ++n) bv[bj][n] = bias ? *(const f32x4*)(bias + bcol0 + bj * HALF + 4 * n) : (f32x4){0.f, 0.f, 0.f, 0.f};
#pragma unroll
        for (int ai = 0; ai < 2; ++ai)
#pragma unroll
            for (int m = 0; m < 4; ++m) { bf16_t* rowp = base + (size_t)(row0 + ai * HALF + m * 16) * ldc + col0;
#pragma unroll
                for (int bj = 0; bj < 2; ++bj) { f32x4 v0 = acc[ai][bj][m][0] + bv[bj][0], v1 = acc[ai][bj][m][1] + bv[bj][1];
                    if (ACT == 1) { f32x2 a = gelu_pk((f32x2){v0[0], v0[1]}), b = gelu_pk((f32x2){v0[2], v0[3]}), c = gelu_pk((f32x2){v1[0], v1[1]}), d = gelu_pk((f32x2){v1[2], v1[3]});
                        v0 = (f32x4){a.x, a.y, b.x, b.y}; v1 = (f32x4){c.x, c.y, d.x, d.y}; }
                    v0 = v0 * sc; v1 = v1 * sc; u32x4 w; w.x = cvt_pk_bf16(v0[0], v0[1]); w.y = cvt_pk_bf16(v0[2], v0[3]); w.z = cvt_pk_bf16(v1[0], v1[1]); w.w = cvt_pk_bf16(v1[2], v1[3]);
                    *(u32x4*)(rowp + bj * HALF) = w; } }
    }
};

__device__ __forceinline__ float row_rstd(const float* ssq, int row) {
    const f32x4* p = (const f32x4*)(ssq + (size_t)row * 16);
    const f32x4 a = p[0], b = p[1], c = p[2], d = p[3];
    const float s = (((a[0] + a[1]) + (a[2] + a[3])) + ((b[0] + b[1]) + (b[2] + b[3]))) + (((c[0] + c[1]) + (c[2] + c[3])) + ((d[0] + d[1]) + (d[2] + d[3])));
    return 1.0f / sqrtf(s * (1.0f / 1024.0f) + 1e-6f);
}
__device__ __forceinline__ float sigmoidf_(float x) { return __builtin_amdgcn_rcpf(1.0f + __expf(-x)); }
typedef unsigned u32x2 __attribute__((ext_vector_type(2)));

struct EpiRes {
    static constexpr bool PERM = false, AFTER_DRAIN = false;
    const float* base32; const bf16_t* base16; bf16_t* hb; float* ssq; unsigned char* xq8;
    __device__ __forceinline__ void operator()(const f32x4 (&acc)[2][2][4][2], const Unit& u, int wr, int wc, int fr, int fq) const {
        const int row0 = u.pm * BM + wr * 64 + fr, col0 = u.pn * BM + wc * 32 + 4 * fq;
#pragma unroll
        for (int ai = 0; ai < 2; ++ai)
#pragma unroll
            for (int m = 0; m < 4; ++m) { const int row = row0 + ai * HALF + m * 16; const size_t off = (size_t)row * 1024 + col0; float ss = 0.f;
#pragma unroll
                for (int bj = 0; bj < 2; ++bj)
#pragma unroll
                    for (int n = 0; n < 2; ++n) { const size_t o2 = off + bj * HALF + n * 16; f32x4 b;
                        if (base32) b = *(const f32x4*)(base32 + o2);
                        else { const u32x2 bw = *(const u32x2*)(base16 + o2); b = (f32x4){__uint_as_float(bw.x << 16), __uint_as_float(bw.x & 0xffff0000u), __uint_as_float(bw.y << 16), __uint_as_float(bw.y & 0xffff0000u)}; }
                        const f32x4 o = b + acc[ai][bj][m][n];
                        ss += (o[0] * o[0] + o[1] * o[1]) + (o[2] * o[2] + o[3] * o[3]);
                        u32x2 w; w.x = cvt_pk_bf16(o[0], o[1]); w.y = cvt_pk_bf16(o[2], o[3]); *(u32x2*)(hb + o2) = w;
                        int w8 = __builtin_amdgcn_cvt_pk_fp8_f32(o[0], o[1], 0, false); w8 = __builtin_amdgcn_cvt_pk_fp8_f32(o[2], o[3], w8, true); *(unsigned*)(xq8 + o2) = (unsigned)w8; }
                ss += __shfl_xor(ss, 16); ss += __shfl_xor(ss, 32);
                if (fq == 0) ssq[(size_t)row * 16 + u.pn * 4 + wc] = ss; }
    }
};
struct EpiScaleF32 {
    static constexpr bool PERM = false, AFTER_DRAIN = false;
    float* C; int ldc; const float* ssq;
    __device__ __forceinline__ void operator()(const f32x4 (&acc)[2][2][4][2], const Unit& u, int wr, int wc, int fr, int fq) const {
        const int row0 = u.pm * BM + wr * 64 + fr, col0 = u.pn * BM + wc * 32 + 4 * fq;
#pragma unroll
        for (int ai = 0; ai < 2; ++ai)
#pragma unroll
            for (int m = 0; m < 4; ++m) { const int row = row0 + ai * HALF + m * 16; const float rs = row_rstd(ssq, row); float* rowp = C + (size_t)row * ldc + col0;
#pragma unroll
                for (int bj = 0; bj < 2; ++bj)
#pragma unroll
                    for (int n = 0; n < 2; ++n) *(f32x4*)(rowp + bj * HALF + n * 16) = acc[ai][bj][m][n] * rs; }
    }
};
struct EpiScaleBf16 {
    static constexpr bool PERM = false, AFTER_DRAIN = false;
    bf16_t* O; int ldc; const float* ssq;
    __device__ __forceinline__ void operator()(const f32x4 (&acc)[2][2][4][2], const Unit& u, int wr, int wc, int fr, int fq) const {
        const int row0 = u.pm * BM + wr * 64 + fr, col0 = u.pn * BM + wc * 32 + 4 * fq;
#pragma unroll
        for (int ai = 0; ai < 2; ++ai)
#pragma unroll
            for (int m = 0; m < 4; ++m) { const int row = row0 + ai * HALF + m * 16; const float rs = row_rstd(ssq, row); bf16_t* rowp = O + (size_t)row * ldc + col0;
#pragma unroll
                for (int bj = 0; bj < 2; ++bj)
#pragma unroll
                    for (int n = 0; n < 2; ++n) { const f32x4 o = acc[ai][bj][m][n] * rs; u32x2 w; w.x = cvt_pk_bf16(o[0], o[1]); w.y = cvt_pk_bf16(o[2], o[3]); *(u32x2*)(rowp + bj * HALF + n * 16) = w; } }
    }
};
struct EpiPle {
    static constexpr bool PERM = false, AFTER_DRAIN = false;
    const bf16_t* hin; const bf16_t* pp; bf16_t* hb; const float* ssq_in; float* ssq_out;
    __device__ __forceinline__ void operator()(const f32x4 (&acc)[2][2][4][2], const Unit& u, int wr, int wc, int fr, int fq) const {
        const int row0 = u.pm * BM + wr * 64 + fr, col0 = u.pn * BM + wc * 32 + 4 * fq;
#pragma unroll
        for (int ai = 0; ai < 2; ++ai)
#pragma unroll
            for (int m = 0; m < 4; ++m) { const int row = row0 + ai * HALF + m * 16; const float rs = row_rstd(ssq_in, row); const size_t off = (size_t)row * 1024 + col0; float ss = 0.f;
#pragma unroll
                for (int bj = 0; bj < 2; ++bj)
#pragma unroll
                    for (int n = 0; n < 2; ++n) { const size_t o2 = off + bj * HALF + n * 16; const f32x4 a = acc[ai][bj][m][n] * rs; const u32x2 pw = *(const u32x2*)(pp + o2); const u32x2 hw = *(const u32x2*)(hin + o2);
                        f32x4 o;
                        o[0] = __uint_as_float(hw.x << 16) + __uint_as_float(pw.x << 16) * sigmoidf_(a[0]); o[1] = __uint_as_float(hw.x & 0xffff0000u) + __uint_as_float(pw.x & 0xffff0000u) * sigmoidf_(a[1]);
                        o[2] = __uint_as_float(hw.y << 16) + __uint_as_float(pw.y << 16) * sigmoidf_(a[2]); o[3] = __uint_as_float(hw.y & 0xffff0000u) + __uint_as_float(pw.y & 0xffff0000u) * sigmoidf_(a[3]);
                        ss += (o[0] * o[0] + o[1] * o[1]) + (o[2] * o[2] + o[3] * o[3]);
                        u32x2 w; w.x = cvt_pk_bf16(o[0], o[1]); w.y = cvt_pk_bf16(o[2], o[3]); *(u32x2*)(hb + o2) = w; }
                ss += __shfl_xor(ss, 16); ss += __shfl_xor(ss, 32);
                if (fq == 0) ssq_out[(size_t)row * 16 + u.pn * 4 + wc] = ss; }
    }
};
struct EpiGlu {
    static constexpr bool PERM = false, AFTER_DRAIN = false;
    const bf16_t* Z; int ldz; const float* bias; bf16_t* O; int ldo; int ocol0;
    __device__ __forceinline__ void operator()(const f32x4 (&acc)[2][2][4][2], const Unit& u, int wr, int wc, int fr, int fq) const {
        const int row0 = u.pm * BM + wr * 64 + fr, col0 = u.pn * BM + wc * 32 + 4 * fq;
        f32x4 bv[2][2];
#pragma unroll
        for (int bj = 0; bj < 2; ++bj)
#pragma unroll
            for (int n = 0; n < 2; ++n) bv[bj][n] = *(const f32x4*)(bias + col0 + bj * HALF + n * 16);
#pragma unroll
        for (int ai = 0; ai < 2; ++ai)
#pragma unroll
            for (int m = 0; m < 4; ++m) { const int row = row0 + ai * HALF + m * 16;
#pragma unroll
                for (int bj = 0; bj < 2; ++bj)
#pragma unroll
                    for (int n = 0; n < 2; ++n) { const int col = col0 + bj * HALF + n * 16; const f32x4 a = acc[ai][bj][m][n] + bv[bj][n]; const u32x2 zw = *(const u32x2*)(Z + (size_t)row * ldz + col);
                        const float o0 = __uint_as_float(zw.x << 16) * sigmoidf_(a[0]), o1 = __uint_as_float(zw.x & 0xffff0000u) * sigmoidf_(a[1]);
                        const float o2 = __uint_as_float(zw.y << 16) * sigmoidf_(a[2]), o3 = __uint_as_float(zw.y & 0xffff0000u) * sigmoidf_(a[3]);
                        u32x2 w; w.x = cvt_pk_bf16(o0, o1); w.y = cvt_pk_bf16(o2, o3); *(u32x2*)(O + (size_t)row * ldo + ocol0 + col) = w; } }
    }
};
template <class Epi, class Sched, bool ALIGN_EPI = false, bool SP2 = false>
__device__ __forceinline__ void gemm_phase(PG8_LAS unsigned char* lds, const Gemm g, const Sched& S, const Epi& E) {
    int tid_o = threadIdx.x; asm volatile("" : "+v"(tid_o));
    const int tid = tid_o, wid = __builtin_amdgcn_readfirstlane(tid >> 6), lane = tid & 63, wr = wid >> 2, wc = wid & 3, fr = lane & 15, fq = lane >> 4;
    const int K = g.K, nt = K / BK;
    unsigned voffA[2], voffB[2];
#pragma unroll
    for (int i = 0; i < 2; ++i) { int R, C; stage_rc(tid * 16 + i * 8192, R, C); const int Rb = Epi::PERM ? ((R & ~31) + perm32(R & 31)) : R;
        voffA[i] = (unsigned)(R * K + C) * 2u; voffB[i] = (unsigned)(Rb * K + C) * 2u; }
    const size_t kstep = (size_t)(BK * 2);
    const size_t hstep = (size_t)HALF * K * 2;
    const size_t tstep = 2 * hstep;
    const unsigned ldsw = (unsigned)wid * 1024u;
    const int aoff = lds_byte(wr * 64 + fr, fq * 8), boff = lds_byte(wc * 32 + fr, fq * 8);
#define PG8_SA(b, h) (((b) * 2 + (h)) * HTB)
#define PG8_SB(b, h) ((4 + (b) * 2 + (h)) * HTB)
#define PG8_STAGE(bufoff, gbase, voff) do { _Pragma("unroll") for (int _i = 0; _i < 2; ++_i) \
        __builtin_amdgcn_global_load_lds((const unsigned*)((const char*)(gbase) + (voff)[_i]), (PG8_LAS unsigned*)(lds + (bufoff) + ldsw + _i * 8192), 16, 0, 0); } while (0)
#define PG8_LDA(dst, b, h) do { _Pragma("unroll") for (int m = 0; m < 4; ++m) _Pragma("unroll") for (int k = 0; k < 2; ++k) dst[m][k] = *(const PG8_LAS bf16x8*)(lds + PG8_SA(b, h) + aoff + m * 2048 + k * 1024); } while (0)
#define PG8_LDB(dst, b, h) do { _Pragma("unroll") for (int n = 0; n < 2; ++n) _Pragma("unroll") for (int k = 0; k < 2; ++k) dst[n][k] = *(const PG8_LAS bf16x8*)(lds + PG8_SB(b, h) + boff + n * 2048 + k * 1024); } while (0)
#define PG8_MMA(ai, bj, At, Bt) do { __builtin_amdgcn_s_setprio(1); _Pragma("unroll") for (int m = 0; m < 4; ++m) _Pragma("unroll") for (int n = 0; n < 2; ++n) _Pragma("unroll") for (int k = 0; k < 2; ++k) \
        acc[ai][bj][m][n] = __builtin_amdgcn_mfma_f32_16x16x32_bf16(Bt[n][k], At[m][k], acc[ai][bj][m][n], 0, 0, 0); __builtin_amdgcn_s_setprio(0); } while (0)
#define PG8_WAIT_V(n) asm volatile("s_waitcnt vmcnt(" #n ")" ::: "memory")
#define PG8_WAIT_L(n) asm volatile("s_waitcnt lgkmcnt(" #n ")" ::: "memory")
#define PG8_BAR __builtin_amdgcn_s_barrier()
#define PG8_SCHED __builtin_amdgcn_sched_barrier(0)
    Unit cur, nxt; int ui = 0;
    if (!S.next(0, cur)) return;
    f32x4 acc[2][2][4][2];
#pragma unroll
    for (int a = 0; a < 2; ++a)
#pragma unroll
        for (int b = 0; b < 2; ++b)
#pragma unroll
            for (int m = 0; m < 4; ++m)
#pragma unroll
                for (int n = 0; n < 2; ++n) acc[a][b][m][n] = (f32x4){0.f, 0.f, 0.f, 0.f};
    bf16x8 At[4][2], B0[2][2], B1[2][2];
    const char* cA = (const char*)g.A + (size_t)cur.pm * tstep; const char* cB = (const char*)g.Bt + (size_t)cur.pn * tstep;
    S.a_ready(cur);
    if constexpr (SP2) {
        PG8_STAGE(PG8_SB(0, 0), cB, voffB); PG8_STAGE(PG8_SB(0, 1), cB + hstep, voffB); PG8_STAGE(PG8_SA(0, 0), cA, voffA); PG8_STAGE(PG8_SA(0, 1), cA + hstep, voffA);
        if (wr == 1) PG8_BAR;
        PG8_WAIT_V(2); PG8_BAR;
        PG8_STAGE(PG8_SB(1, 0), cB + kstep, voffB); PG8_STAGE(PG8_SA(1, 0), cA + kstep, voffA); PG8_STAGE(PG8_SB(1, 1), cB + hstep + kstep, voffB);
        PG8_WAIT_V(6); PG8_BAR;
    } else {
        PG8_STAGE(PG8_SB(0, 0), cB, voffB); PG8_STAGE(PG8_SA(0, 0), cA, voffA); PG8_STAGE(PG8_SB(0, 1), cB + hstep, voffB); PG8_STAGE(PG8_SA(0, 1), cA + hstep, voffA);
        if (wr == 1) PG8_BAR;
        PG8_WAIT_V(4); PG8_BAR;
        PG8_STAGE(PG8_SB(1, 0), cB + kstep, voffB); PG8_STAGE(PG8_SA(1, 0), cA + kstep, voffA); PG8_STAGE(PG8_SB(1, 1), cB + hstep + kstep, voffB);
        PG8_WAIT_V(6); PG8_BAR;
    }
    for (;;) {
        const bool has_next = S.next(ui + 1, nxt);
        const char* nA = has_next ? (const char*)g.A + (size_t)nxt.pm * tstep : cA; const char* nB = has_next ? (const char*)g.Bt + (size_t)nxt.pn * tstep : cB;
        for (int t = 0; t < nt; t += 2) {
            const bool last = (t == nt - 2);
            const char* a1 = cA + (size_t)(t + 1) * kstep;
            const char* a2 = last ? nA : cA + (size_t)(t + 2) * kstep; const char* b2 = last ? nB : cB + (size_t)(t + 2) * kstep;
            const char* a3 = a2 + kstep; const char* b3 = b2 + kstep;
            if (last && has_next) S.a_ready(nxt);
            if constexpr (SP2) {
            PG8_LDB(B0, 0, 0); PG8_LDB(B1, 0, 1); PG8_SCHED; PG8_LDA(At, 0, 0); PG8_STAGE(PG8_SA(1, 1), a1 + hstep, voffA);
            PG8_WAIT_V(8); PG8_WAIT_L(0); PG8_BAR; PG8_MMA(0, 0, At, B0); PG8_MMA(0, 1, At, B1); PG8_BAR; PG8_SCHED;
            PG8_LDA(At, 0, 1); PG8_STAGE(PG8_SB(0, 0), b2, voffB); PG8_STAGE(PG8_SB(0, 1), b2 + hstep, voffB); PG8_STAGE(PG8_SA(0, 0), a2, voffA);
            PG8_WAIT_V(8); PG8_WAIT_L(0); PG8_BAR; PG8_MMA(1, 0, At, B0); PG8_MMA(1, 1, At, B1); PG8_BAR; PG8_SCHED;
            PG8_LDB(B0, 1, 0); PG8_LDB(B1, 1, 1); PG8_SCHED; PG8_LDA(At, 1, 0); PG8_STAGE(PG8_SA(0, 1), a2 + hstep, voffA);
            PG8_WAIT_V(8); PG8_WAIT_L(0); PG8_BAR; PG8_MMA(0, 0, At, B0); PG8_MMA(0, 1, At, B1); PG8_BAR; PG8_SCHED;
            PG8_LDA(At, 1, 1); PG8_STAGE(PG8_SB(1, 0), b3, voffB); PG8_STAGE(PG8_SB(1, 1), b3 + hstep, voffB); PG8_STAGE(PG8_SA(1, 0), a3, voffA);
            PG8_WAIT_V(8); PG8_WAIT_L(0); PG8_BAR; PG8_MMA(1, 0, At, B0); PG8_MMA(1, 1, At, B1); PG8_BAR; PG8_SCHED;
            } else {
            PG8_LDB(B0, 0, 0); PG8_SCHED; PG8_LDA(At, 0, 0); PG8_STAGE(PG8_SA(1, 1), a1 + hstep, voffA);
            PG8_WAIT_L(8); PG8_BAR; PG8_WAIT_L(0); PG8_MMA(0, 0, At, B0); PG8_BAR; PG8_SCHED;
            PG8_LDB(B1, 0, 1); PG8_STAGE(PG8_SB(0, 0), b2, voffB);
            PG8_BAR; PG8_WAIT_L(0); PG8_MMA(0, 1, At, B1); PG8_BAR;
            PG8_LDA(At, 0, 1); PG8_STAGE(PG8_SA(0, 0), a2, voffA);
            PG8_BAR; PG8_WAIT_L(0); PG8_MMA(1, 0, At, B0); PG8_BAR; PG8_SCHED;
            PG8_STAGE(PG8_SB(0, 1), b2 + hstep, voffB);
            PG8_WAIT_V(6); PG8_BAR; PG8_MMA(1, 1, At, B1); PG8_BAR;
            PG8_LDB(B0, 1, 0); PG8_SCHED; PG8_LDA(At, 1, 0); PG8_STAGE(PG8_SA(0, 1), a2 + hstep, voffA);
            PG8_WAIT_L(8); PG8_BAR; PG8_WAIT_L(0); PG8_MMA(0, 0, At, B0); PG8_BAR; PG8_SCHED;
            PG8_LDB(B1, 1, 1); PG8_STAGE(PG8_SB(1, 0), b3, voffB);
            PG8_BAR; PG8_WAIT_L(0); PG8_MMA(0, 1, At, B1); PG8_BAR;
            PG8_LDA(At, 1, 1); PG8_STAGE(PG8_SA(1, 0), a3, voffA);
            PG8_BAR; PG8_WAIT_L(0); PG8_MMA(1, 0, At, B0); PG8_BAR; PG8_SCHED;
            PG8_STAGE(PG8_SB(1, 1), b3 + hstep, voffB);
            PG8_WAIT_V(6); PG8_BAR; PG8_MMA(1, 1, At, B1); PG8_BAR;
            }
        }
        if constexpr (ALIGN_EPI) { if (wr == 0) PG8_BAR; }
        if constexpr (!Epi::AFTER_DRAIN) { E(acc, cur, wr, wc, fr, fq); S.done(cur); }
        if (!has_next) break;
#pragma unroll
        for (int a = 0; a < 2; ++a)
#pragma unroll
            for (int b = 0; b < 2; ++b)
#pragma unroll
                for (int m = 0; m < 4; ++m)
#pragma unroll
                    for (int n = 0; n < 2; ++n) acc[a][b][m][n] = (f32x4){0.f, 0.f, 0.f, 0.f};
        cur = nxt; cA = nA; cB = nB; ++ui;
        if constexpr (ALIGN_EPI) { if (wr == 1) PG8_BAR; }
    }
    PG8_WAIT_V(0);
    if constexpr (!ALIGN_EPI) { if (wr == 0) PG8_BAR; }
    PG8_BAR;
    if constexpr (Epi::AFTER_DRAIN) { E.fused(acc, cur, wr, wc, fr, fq, lds, wid, lane); S.done(cur); }
#undef PG8_SA
#undef PG8_SB
#undef PG8_STAGE
#undef PG8_LDA
#undef PG8_LDB
#undef PG8_MMA
#undef PG8_WAIT_V
#undef PG8_WAIT_L
#undef PG8_BAR
#undef PG8_SCHED
}
}
#define GAS __attribute__((address_space(1)))
#define LAS __attribute__((address_space(3)))
typedef unsigned short bf16;
typedef unsigned v4u __attribute__((ext_vector_type(4)));
typedef float f32x4 __attribute__((ext_vector_type(4)));
typedef short bf16x8 __attribute__((ext_vector_type(8)));
typedef GAS unsigned gu32;
typedef GAS unsigned long long gu64;
#define RLX_AGENT __ATOMIC_RELAXED, __HIP_MEMORY_SCOPE_AGENT
#define LDS_WAIT() asm volatile("s_waitcnt lgkmcnt(0)" ::: "memory")
#define VM_WAIT() asm volatile("s_waitcnt vmcnt(0)" ::: "memory")
__device__ __forceinline__ unsigned long long rt() { return __builtin_amdgcn_s_memrealtime(); }
__device__ __forceinline__ unsigned f2bf(float f) { unsigned u = __builtin_bit_cast(unsigned, f); return (u + 0x7fffu + ((u >> 16) & 1u)) >> 16; }
__device__ __forceinline__ unsigned pk2(float lo, float hi) { return f2bf(lo) | (f2bf(hi) << 16); }
#define XB_TMO      128
#define XB_XCNT(j)  (256  + 64 * (j))
#define XB_XSUB(j)  (1280 + 64 * (j))
#define XB_XGEN(j)  (2304 + 64 * (j))
#define XB_TOP      3328
#define XB_TOPGEN   3392
#define XCD_BAR_WORDS 3456
#define XB_SPIN_CAP (1u << 18)

__device__ __forceinline__ unsigned xb_ld(unsigned* p)              { return __hip_atomic_load(p, __ATOMIC_RELAXED, __HIP_MEMORY_SCOPE_AGENT); }
__device__ __forceinline__ unsigned xb_add(unsigned* p, unsigned v) { return __hip_atomic_fetch_add(p, v, __ATOMIC_RELAXED, __HIP_MEMORY_SCOPE_AGENT); }
__device__ __forceinline__ unsigned xb_xcc_id() { return (unsigned)__builtin_amdgcn_s_getreg((3 << 11) | 20) & 0xFu; }
#define XB_SPIN(cond, bar) do { unsigned _sp = 0; while (cond) { __builtin_amdgcn_s_sleep(1); \
    if ((++_sp & 255u) == 0u) { if (xb_ld(&(bar)[XB_TMO])) break; if (_sp > XB_SPIN_CAP) { atomicAdd(&(bar)[XB_TMO], 1u); break; } } } } while (0)

struct XcdBarrier {
    unsigned* bar; unsigned x;
    volatile LAS unsigned* st;
};

__device__ __forceinline__ XcdBarrier xcd_barrier_post(unsigned* bar, volatile LAS unsigned* st) {
    XcdBarrier b; b.bar = bar; b.x = xb_xcc_id(); b.st = st;
    if (threadIdx.x == 0) (void)xb_add(&bar[XB_XCNT(b.x)], 1u);
    return b;
}
__device__ __forceinline__ void xcd_barrier_complete(unsigned* bar, unsigned x, unsigned& nloc, unsigned& nx) {
    const unsigned G = gridDim.x * gridDim.y * gridDim.z;
    unsigned sum, cnt, mine, sp = 0u;
    for (;;) {
        sum = 0u; cnt = 0u; mine = 0u;
#pragma unroll
        for (unsigned j = 0; j < 16; ++j) { const unsigned c = xb_ld(&bar[XB_XCNT(j)]); sum += c; cnt += (c > 0u) ? 1u : 0u; mine = (j == x) ? c : mine; }
        if (sum == G) break;
        __builtin_amdgcn_s_sleep(1);
        if ((++sp & 255u) == 0u) { if (xb_ld(&bar[XB_TMO])) break; if (sp > XB_SPIN_CAP) { atomicAdd(&bar[XB_TMO], 1u); break; } }
    }
    nloc = mine > 0u ? mine : 1u; nx = cnt > 0u ? cnt : 1u;
}

__device__ __forceinline__ void xcd_barrier(const XcdBarrier& b) {
    asm volatile("s_waitcnt vmcnt(0)" ::: "memory");
    __syncthreads();
    if (threadIdx.x == 0) {
        unsigned* bar = b.bar;
        __builtin_amdgcn_s_waitcnt(0);
        unsigned nloc = b.st[0], nx = b.st[1];
        if (nloc == 0u) { xcd_barrier_complete(bar, b.x, nloc, nx); b.st[0] = nloc; b.st[1] = nx; }
        const unsigned old = xb_add(&bar[XB_XSUB(b.x)], 1u);
        const unsigned gen = old / nloc;
        if (old + 1u == (gen + 1u) * nloc) {
            __builtin_amdgcn_fence(__ATOMIC_RELEASE, "agent");
            asm volatile("s_waitcnt vmcnt(0)" ::: "memory");
            const unsigned og = xb_add(&bar[XB_TOP], 1u);
            const unsigned tg = og / nx;
            if (og + 1u == (tg + 1u) * nx) xb_add(&bar[XB_TOPGEN], 1u);
            else XB_SPIN(xb_ld(&bar[XB_TOPGEN]) == tg, bar);
            __builtin_amdgcn_fence(__ATOMIC_ACQUIRE, "agent");
            xb_add(&bar[XB_XGEN(b.x)], 1u);
            asm volatile("s_waitcnt vmcnt(0)" ::: "memory");
        } else {
            XB_SPIN(xb_ld(&bar[XB_XGEN(b.x)]) == gen, bar);
            __builtin_amdgcn_fence(__ATOMIC_ACQUIRE, "agent");
            asm volatile("s_waitcnt vmcnt(0)" ::: "memory");
        }
    }
    __syncthreads();
}

constexpr int NWAVES = 8, NTHREADS = 512;
constexpr int NT = 32768, DM = 1024, SEQ = 8192, NCHUNK = 128, PROJW = 3328;
constexpr float EPS = 1e-6f;
enum { I_X = 0, I_P, I_POS, I_NMW, I_NFW, I_NPW, I_FNW, I_EWIN, I_GWUP, I_GBUP, I_GNW, I_RNW, I_EWOUT, I_OWIN, I_POOLW, I_POOLS, I_ARE, I_AIM, I_LDT, I_BRE, I_BIM, I_CRE, I_CIM, I_DSK,
       I_WGLU, I_BGLU, I_OWOUT, I_PWQ, I_PKEYS, I_PU, I_PV, I_PLEP, I_PLEG, N_IN };
constexpr size_t MiB = 1u << 20;
constexpr size_t WS_CTL = 0, CTL_ZERO_BYTES = 64 * 1024;
constexpr size_t WS_WIN0 = 1 * MiB, WS_WOUT0 = 8 * MiB, WS_WEFF = 10 * MiB  , WS_WG = 18 * MiB  , WS_WP = 22 * MiB  , WS_WIN1 = 23 * MiB, WS_WGLU = 25 * MiB, WS_WOUT1 = 26 * MiB;
constexpr size_t WS_ROT = 28 * MiB, WS_S5C = 30 * MiB, WS_SSQ0 = 31 * MiB, WS_SSQ1 = 33 * MiB, WS_DEC = 35 * MiB;
constexpr size_t S5_ABAR = 0, S5_A64 = 16384, S5_BBAR = 32768  , S5_CM = 32768 + 262144  , S5_BB16 = S5_CM + 131072  ;
constexpr size_t WS_A0 = 36 * MiB, WS_A1 = 100 * MiB, WS_R1 = 164 * MiB;
constexpr size_t WS_PROJ = WS_R1, WS_KV = WS_R1 + 208 * MiB;
constexpr size_t WS_SC = WS_R1, WS_EID = WS_R1 + 256 * MiB, WS_GATE = WS_R1 + 272 * MiB;
constexpr size_t WS_COEF = WS_R1 + 160 * MiB;
constexpr size_t WS_XQ = WS_R1 + 224 * MiB;
constexpr size_t WS_UT4 = WS_R1 + 288 * MiB, WS_VT4 = WS_UT4 + 8 * MiB, WS_SCL = WS_UT4 + 16 * MiB, WS_PB = WS_UT4 + 18 * MiB, WS_PP = WS_R1 + 80 * MiB;
constexpr size_t WS_U = WS_R1, WS_Z = WS_R1 + 64 * MiB, WS_E = WS_R1 + 96 * MiB;
constexpr size_t WS_END = WS_R1 + 288 * MiB + 34 * MiB;
constexpr int RING_BYTES = 131072, MISC_OFF = RING_BYTES + 320, LDS_BYTES = 147456;

__device__ __forceinline__ float bf2f(unsigned short b) { return __uint_as_float((unsigned)b << 16); }
__device__ __forceinline__ float bf2f(unsigned b) { return __uint_as_float(b << 16); }
__device__ __forceinline__ float bflo(unsigned w) { return __uint_as_float(w << 16); }
__device__ __forceinline__ float bfhi(unsigned w) { return __uint_as_float(w & 0xffff0000u); }
__device__ __forceinline__ float wave_sum(float v) {
#pragma unroll
    for (int o = 1; o < 64; o <<= 1) v += __shfl_xor(v, o);
    return v;
}
__device__ __forceinline__ float gelu1(float v) {
    const float av = fabsf(v), t = __builtin_amdgcn_rcpf(av * 0.2316418882f + 1.0f);
    float q = t * 0.5307027145f + (-0.7265760135f); q = q * t + 0.7107068705f; q = q * t + (-0.142248368f); q = q * t + 0.127414796f; q = q * t;
    const float e = __builtin_amdgcn_exp2f((v * v) * (-0.72134752044f));
    const float m = v * (q * e);
    return v < 0.f ? m : v - m;
}
__device__ __forceinline__ float logsigf(float x) { return fminf(x, 0.f) - __logf(1.0f + __expf(-fabsf(x))); }
__device__ __forceinline__ float siluf(float x) { return x * __builtin_amdgcn_rcpf(1.0f + __expf(-x)); }

struct Ctx {
    LAS unsigned char* lds;
    int tid, lane, wave, G, bid;
    float* h;
    unsigned char* ws;
};
struct Args { const void* in[N_IN]; float* out; unsigned char* ws; };
constexpr int PTR_OFF = 131072 + 1024;
#define IN(i) inptr(C, (i))
#define WSP(T, off) ((T*)(C.ws + (off)))
#define PHASE_ENTER(C) do { int t_ = threadIdx.x; asm volatile("" : "+v"(t_)); C.tid = t_; C.lane = t_ & 63; C.wave = __builtin_amdgcn_readfirstlane(t_ >> 6); asm volatile("" : "+s"(C.ws), "+s"(C.h)); C.ws = (unsigned char*)(GAS unsigned char*)C.ws; C.h = (float*)(GAS float*)C.h; } while (0)
__device__ __forceinline__ const float* inptr(const Ctx& C, int i) { const LAS unsigned* t = (const LAS unsigned*)(C.lds + PTR_OFF) + 2 * i;
    const unsigned lo = __builtin_amdgcn_readfirstlane(t[0]), hi = __builtin_amdgcn_readfirstlane(t[1]); return (const float*)(const GAS float*)(((unsigned long long)hi << 32) | lo); }

__device__ __forceinline__ void tr_item(const float* W, int ldw, int c0, bf16* WT, int K, int r0, const float* ks, float cs, LAS float* scr, int item, int nblk, int lane) {
    const int kb = item / nblk, nb = item % nblk, k0 = 64 * kb, n0 = 32 * nb;
#pragma unroll 8
    for (int i = 0; i < 32; ++i) { const int kk = 2 * i + (lane >> 5); float v = W[(size_t)(k0 + kk) * ldw + c0 + n0 + (lane & 31)]; if (ks) v *= ks[k0 + kk]; scr[kk * 33 + (lane & 31)] = v * cs; }
    LDS_WAIT(); asm volatile("" ::: "memory");
    const int c = lane & 7;
#pragma unroll
    for (int j = 0; j < 4; ++j) { const int n = (lane >> 3) + 8 * j; const LAS float* s = scr + (8 * c) * 33 + n;
        v4u o; o.x = pk2(s[0 * 33], s[1 * 33]); o.y = pk2(s[2 * 33], s[3 * 33]); o.z = pk2(s[4 * 33], s[5 * 33]); o.w = pk2(s[6 * 33], s[7 * 33]);
        *(v4u*)(WT + (size_t)(r0 + n0 + n) * K + k0 + 8 * c) = o; }
    LDS_WAIT(); asm volatile("" ::: "memory");
}
__device__ __forceinline__ void fold_item(const float* KM, int sk, int sc, const float* W, int ldw, int wc0, int kb, bf16* OUT, const float* kscale, const float* nscale, LAS float* lds, int tid) {
    LAS float* KL = lds;
    LAS float* WL = lds + 128 * 132;
    if (sc == 1) { for (int idx = tid; idx < 16384; idx += NTHREADS) { const int key = idx >> 7, c = idx & 127; KL[key * 132 + c] = KM[(size_t)key * sk + c]; } }
    else         { for (int idx = tid; idx < 16384; idx += NTHREADS) { const int c = idx >> 7, key = idx & 127; KL[key * 132 + c] = KM[(size_t)key * sk + (size_t)c * sc]; } }
    for (int idx = tid; idx < 8192; idx += NTHREADS) { const int k = idx >> 7, c = idx & 127; WL[k * 132 + c] = W[(size_t)(kb * 64 + k) * ldw + wc0 + c]; }
    __syncthreads();
    const int ty = tid >> 4, tx = tid & 15;
    float acc[4][4];
#pragma unroll
    for (int i = 0; i < 4; ++i)
#pragma unroll
        for (int j = 0; j < 4; ++j) acc[i][j] = 0.f;
    for (int c4 = 0; c4 < 32; ++c4) {
        f32x4 a[4], b[4];
#pragma unroll
        for (int i = 0; i < 4; ++i) a[i] = *(const LAS f32x4*)(KL + (4 * ty + i) * 132 + 4 * c4);
#pragma unroll
        for (int j = 0; j < 4; ++j) b[j] = *(const LAS f32x4*)(WL + (tx + 16 * j) * 132 + 4 * c4);
#pragma unroll
        for (int i = 0; i < 4; ++i)
#pragma unroll
            for (int j = 0; j < 4; ++j) acc[i][j] += (a[i][0] * b[j][0] + a[i][1] * b[j][1]) + (a[i][2] * b[j][2] + a[i][3] * b[j][3]);
    }
#pragma unroll
    for (int i = 0; i < 4; ++i) { const int key = 4 * ty + i; const float ns = nscale ? nscale[key] : 1.0f;
#pragma unroll
        for (int j = 0; j < 4; ++j) { const int k = kb * 64 + tx + 16 * j; OUT[(size_t)key * 1024 + k] = (bf16)f2bf(acc[i][j] * kscale[k] * ns); } }
    __syncthreads();
}

__device__ __forceinline__ void phase_prologue(Ctx C, const Args& A) {
    PHASE_ENTER(C);
    const int tid = C.tid, lane = C.lane;
    const bool split = C.G >= 192; const int NF = split ? 96 : C.G;
    const bool do_fold = !split || C.bid < NF, do_rest = !split || C.bid >= NF;
    const int wb = split ? C.bid - NF : C.bid, nwb = split ? C.G - NF : C.G;
    const int gw = wb * NWAVES + C.wave, NGW = nwb * NWAVES;
    const int gt = wb * NTHREADS + tid, NGT = nwb * NTHREADS;
    if (do_fold) for (int it = C.bid; it < 576; it += NF) {
        if (it < 512) { const int l = it >> 8, hp = (it >> 4) & 15, kb = it & 15;
            fold_item(IN(I_PKEYS) + (size_t)(l * 16 + hp) * 16384, 128, 1, IN(I_PWQ) + (size_t)l * 1024 * 2048, 2048, hp * 128, kb,
                      WSP(bf16, WS_WEFF) + (size_t)l * 2048 * 1024 + (size_t)hp * 128 * 1024, IN(I_NFW) + l * 1024, nullptr, (LAS float*)C.lds, tid);
        } else { const int r = it - 512, g = r >> 4, kb = r & 15;
            fold_item(IN(I_POOLW) + (size_t)g * 16384, 1, 128, IN(I_OWIN), 1024, g * 128, kb,
                      WSP(bf16, WS_WIN1) + (size_t)g * 128 * 1024, IN(I_NMW) + 1024, IN(I_POOLS) + g * 128, (LAS float*)C.lds, tid);
        }
    }
    if (do_rest) {
    LAS float* scr = (LAS float*)(C.lds + C.wave * 8448);
    constexpr int TR_ITEMS = 128 + 640 + 128 + 128 + 512 + 512 + 512 + 512 + 128 + 128 + 256 + 128 + 512;
    for (int it = gw; it < TR_ITEMS; it += NGW) {
        int r = it;
#define TRJOB(W, ldw, c0, ncols, Krows, WT, r0, ks, cs) { constexpr int nb_ = (ncols) / 32, ni_ = ((Krows) / 64) * nb_; if (r < ni_) { tr_item(W, ldw, c0, WT, Krows, r0, ks, cs, scr, r, nb_, lane); continue; } r -= ni_; }
        TRJOB(IN(I_EWIN), 3088, 0,    256,  1024, WSP(bf16, WS_WIN0), 0,    IN(I_NMW), 0.125f)
        TRJOB(IN(I_EWIN), 3088, 256,  1280, 1024, WSP(bf16, WS_WIN0), 256,  IN(I_NMW), 1.0f)
        TRJOB(IN(I_EWIN), 3088, 1552, 256,  1024, WSP(bf16, WS_WIN0), 1792, IN(I_NMW), 1.0f)
        TRJOB(IN(I_EWIN), 3088, 1808, 256,  1024, WSP(bf16, WS_WIN0), 2048, IN(I_NMW), 0.125f)
        TRJOB(IN(I_EWIN), 3088, 2064, 1024, 1024, WSP(bf16, WS_WIN0), 2304, IN(I_NMW), 1.0f)
        TRJOB(IN(I_EWOUT), 1024, 0, 1024, 1024, WSP(bf16, WS_WOUT0), 0, (const float*)nullptr, 1.0f)
        TRJOB(IN(I_PLEG), 1024, 0, 1024, 1024, WSP(bf16, WS_WG), 0, IN(I_NPW), 1.0f)
        TRJOB(IN(I_PLEG) + 1024 * 1024, 1024, 0, 1024, 1024, WSP(bf16, WS_WG) + 1024 * 1024, 0, IN(I_NPW) + 1024, 1.0f)
        TRJOB(IN(I_PLEP), 1024, 0, 1024, 256, WSP(bf16, WS_WP), 0, (const float*)nullptr, 1.0f)
        TRJOB(IN(I_PLEP) + 256 * 1024, 1024, 0, 1024, 256, WSP(bf16, WS_WP) + 1024 * 256, 0, (const float*)nullptr, 1.0f)
        TRJOB(IN(I_OWIN), 1024, 512, 512, 1024, WSP(bf16, WS_WIN1), 512, IN(I_NMW) + 1024, 1.0f)
        TRJOB(IN(I_WGLU), 512, 0, 512, 512, WSP(bf16, WS_WGLU), 0, (const float*)nullptr, 1.0f)
        TRJOB(IN(I_OWOUT), 1024, 0, 1024, 1024, WSP(bf16, WS_WOUT1), 0, (const float*)nullptr, 1.0f)
#undef TRJOB
    }
    for (int idx = gt; idx < 256 * 1024; idx += NGT) { const int j = idx >> 10, k = idx & 1023; const float* wr = IN(I_EWIN) + (size_t)k * 3088 + 1536; const float* wu = IN(I_GWUP) + j; float s = 0.f;
#pragma unroll
        for (int r = 0; r < 16; ++r) s += wr[r] * wu[r * 256];
        WSP(bf16, WS_WIN0)[(size_t)(1536 + j) * 1024 + k] = (bf16)f2bf(s * IN(I_NMW)[k]); }
    for (int idx = gt; idx < SEQ * 32; idx += NGT) { const int s = idx >> 5, i = idx & 31; const double pos = (double)((const int*)IN(I_POS))[s];
        const double ang = pos * exp2(-(double)i * (13.287712379549449 / 32.0)); const double r = ang - 6.283185307179586 * rint(ang * 0.15915494309189535);
        float sn, cs; sincosf((float)r, &sn, &cs); WSP(float, WS_ROT)[2 * idx] = cs; WSP(float, WS_ROT)[2 * idx + 1] = sn; }
    for (int idx = gt; idx < 2048; idx += NGT) { const int g = idx >> 6;
        const double dt = exp((double)IN(I_LDT)[g]), are = (double)IN(I_ARE)[idx], aim = (double)IN(I_AIM)[idx];
        const double mag = exp(are * dt); double th = aim * dt; th -= 6.283185307179586 * rint(th * 0.15915494309189535);
        const double abr = mag * cos(th), abi = mag * sin(th);
        const double den = are * are + aim * aim, nr = abr - 1.0, ni = abi;
        const double cre = (nr * are + ni * aim) / den, cim = (ni * are - nr * aim) / den;
        const double m64 = exp(64.0 * are * dt); double t64 = 64.0 * aim * dt; t64 -= 6.283185307179586 * rint(t64 * 0.15915494309189535);
        float* s5 = WSP(float, WS_S5C);
        s5[S5_ABAR / 4 + 2 * idx] = (float)abr; s5[S5_ABAR / 4 + 2 * idx + 1] = (float)abi;
        s5[S5_A64 / 4 + 2 * idx] = (float)(m64 * cos(t64)); s5[S5_A64 / 4 + 2 * idx + 1] = (float)(m64 * sin(t64));
        for (int hh = 0; hh < 16; ++hh) { const double br = (double)IN(I_BRE)[idx * 16 + hh], bi = (double)IN(I_BIM)[idx * 16 + hh];
            s5[S5_BBAR / 4 + (idx * 16 + hh) * 2] = (float)(cre * br - cim * bi); s5[S5_BBAR / 4 + (idx * 16 + hh) * 2 + 1] = (float)(cre * bi + cim * br);
            bf16* bb = (bf16*)(C.ws + WS_S5C + S5_BB16) + (size_t)g * 128 * 16; const int pp_ = idx & 63;
            bb[(pp_) * 16 + hh] = (bf16)f2bf((float)(cre * br - cim * bi)); bb[(64 + pp_) * 16 + hh] = (bf16)f2bf((float)(cre * bi + cim * br)); } }
    for (int idx = gt; idx < 32 * 16 * 128; idx += NGT) { const int k = idx & 127, gh = idx >> 7;
        const float v = k < 64 ? IN(I_CRE)[gh * 64 + k] : -IN(I_CIM)[gh * 64 + k - 64]; ((bf16*)(C.ws + WS_S5C + S5_CM))[idx] = (bf16)f2bf(v); }
#pragma unroll 4
    for (int m = gw; m < NT; m += NGW) { const f32x4* xr = (const f32x4*)(IN(I_X) + (size_t)m * DM) + lane; f32x4 v[4]; float s = 0.f;
#pragma unroll
        for (int j = 0; j < 4; ++j) { v[j] = xr[64 * j]; s += (v[j][0] * v[j][0] + v[j][1] * v[j][1]) + (v[j][2] * v[j][2] + v[j][3] * v[j][3]); }
        const float rs = 1.0f / sqrtf(wave_sum(s) * (1.0f / DM) + EPS);
        unsigned long long* o8 = (unsigned long long*)(WSP(bf16, WS_A0) + (size_t)m * DM) + lane;
#pragma unroll
        for (int j = 0; j < 4; ++j) o8[64 * j] = (unsigned long long)pk2(v[j][0] * rs, v[j][1] * rs) | ((unsigned long long)pk2(v[j][2] * rs, v[j][3] * rs) << 32); }
    }
}

__device__ __forceinline__ float lg2gamma(int hh) { return __log2f(1.0f - exp2f(-5.0f - (float)hh)); }

__device__ __forceinline__ void gla_gate_local(const unsigned (&rla)[16], float bu, float (&g)[16]) {
    float run = 0.f;
#pragma unroll
    for (int c = 0; c < 16; ++c) { const float x = bf2f(rla[c]) + bu; run += logsigf(x) * (1.0f / 16.0f); g[c] = run; }
}
__device__ __forceinline__ void stage_vt(const unsigned (&v0)[16], const unsigned (&v1)[16], LAS bf16* Vt, int c0, int lane) {
    unsigned w[8];
#pragma unroll
    for (int c = 0; c < 16; c += 2) w[c >> 1] = (unsigned)v0[c] | ((unsigned)v0[c + 1] << 16);
    *(LAS v4u*)(Vt + lane * 72 + c0) = (v4u){w[0], w[1], w[2], w[3]}; *(LAS v4u*)(Vt + lane * 72 + c0 + 8) = (v4u){w[4], w[5], w[6], w[7]};
#pragma unroll
    for (int c = 0; c < 16; c += 2) w[c >> 1] = (unsigned)v1[c] | ((unsigned)v1[c + 1] << 16);
    *(LAS v4u*)(Vt + (lane + 64) * 72 + c0) = (v4u){w[0], w[1], w[2], w[3]}; *(LAS v4u*)(Vt + (lane + 64) * 72 + c0 + 8) = (v4u){w[4], w[5], w[6], w[7]};
}

__device__ __forceinline__ void phase_kv(Ctx C, const Args& A) {
    PHASE_ENTER(C);
    const int half = C.wave >> 2;
    LAS unsigned char* hb = C.lds + half * 28672;
    LAS bf16* Kt = (LAS bf16*)hb; LAS bf16* Vt = (LAS bf16*)(hb + 9216); LAS float* TOT = (LAS float*)(hb + 27648);
    const bf16* PROJ = WSP(bf16, WS_PROJ);
    unsigned r_la[16], r_k[16], r_kx[16], r_v0[16], r_v1[16]; float r_cs[16], r_sn[16]; float bu = 0.f;
#pragma unroll
    for (int c = 0; c < 16; ++c) { r_la[c] = 0u; r_kx[c] = 0u; r_cs[c] = 0.f; r_sn[c] = 0.f; r_k[c] = 0u; r_v0[c] = 0u; r_v1[c] = 0u; }
#define KV_LOAD(IT, LANE, C0) do { const int pair_ = (IT) & 3, n_ = ((IT) >> 2) & 127, b_ = (IT) >> 9; const bool ret_ = pair_ >= 2; const int hh_ = (pair_ & 1) * 2 + half; \
        const bf16* prow_ = PROJ + (size_t)(b_ * SEQ + n_ * 64 + (C0)) * PROJW; const int xoff_ = (LANE) < 32 ? 32 : -32; \
        const bf16* bK_ = prow_ + (ret_ ? 2048 + hh_ * 64 : 256 + hh_ * 64); const bf16* bV_ = prow_ + (ret_ ? 2304 + hh_ * 128 : 512 + hh_ * 128); const bf16* bL_ = prow_ + 1536 + hh_ * 64; \
        if (!ret_) { bu = IN(I_GBUP)[hh_ * 64 + (LANE)]; _Pragma("unroll") for (int c = 0; c < 16; ++c) r_la[c] = bL_[c * PROJW + (LANE)]; } \
        else { const float* rot_ = WSP(float, WS_ROT) + ((size_t)(n_ * 64 + (C0)) * 32 + ((LANE) & 31)) * 2; \
               _Pragma("unroll") for (int c = 0; c < 16; ++c) { r_kx[c] = bK_[c * PROJW + (LANE) + xoff_]; r_cs[c] = rot_[c * 64]; r_sn[c] = rot_[c * 64 + 1]; } } \
        _Pragma("unroll") for (int c = 0; c < 16; ++c) { r_k[c] = bK_[c * PROJW + (LANE)]; r_v0[c] = bV_[c * PROJW + (LANE)]; r_v1[c] = bV_[c * PROJW + (LANE) + 64]; } } while (0)
    if (C.bid < 2048) KV_LOAD(C.bid, C.lane, 16 * (C.wave & 3));
    for (int item = C.bid; item < 2048; item += C.G) {
        int lane_o = C.lane, w4_o = C.wave & 3; asm volatile("" : "+v"(lane_o), "+s"(w4_o));
        const int lane = lane_o, w4 = w4_o, fr = lane & 15, fq = lane >> 4, c0 = 16 * w4;
        const int pair = item & 3, n = (item >> 2) & 127, b = item >> 9; const bool isret = pair >= 2;
        const int hh = (pair & 1) * 2 + half, t0 = b * SEQ + n * 64;
        const bf16* prow = PROJ + (size_t)(t0 + c0) * PROJW;
        float g[16]; float glast = 0.f, off = 0.f;
        if (!isret) { gla_gate_local(r_la, bu, g); TOT[w4 * 64 + lane] = g[15]; }
        __syncthreads();
        if (!isret) {
#pragma unroll
            for (int w = 0; w < 4; ++w) { const float tv = TOT[w * 64 + lane]; glast += tv; if (w < w4) off += tv; } }
        unsigned kw[8];
        if (!isret) {
#pragma unroll
            for (int c = 0; c < 16; c += 2) { const float k0 = bf2f(r_k[c]) * __expf(glast - (off + g[c])), k1 = bf2f(r_k[c + 1]) * __expf(glast - (off + g[c + 1])); kw[c >> 1] = pk2(k0, k1); }
        } else { const float lg = lg2gamma(hh); float kv[2];
#pragma unroll
            for (int c = 0; c < 16; ++c) { const float own = bf2f(r_k[c]), oth = bf2f(r_kx[c]); const float cs = r_cs[c], sn = r_sn[c];
                const float r = lane < 32 ? own * cs - oth * sn : own * cs + oth * sn; kv[c & 1] = r * exp2f(lg * (float)(63 - (c0 + c))); if (c & 1) kw[c >> 1] = pk2(kv[0], kv[1]); } }
        *(LAS v4u*)(Kt + lane * 72 + c0) = (v4u){kw[0], kw[1], kw[2], kw[3]}; *(LAS v4u*)(Kt + lane * 72 + c0 + 8) = (v4u){kw[4], kw[5], kw[6], kw[7]};
        stage_vt(r_v0, r_v1, Vt, c0, lane);
        if (!isret && w4 == 0) WSP(float, WS_DEC)[(size_t)((b * 4 + hh) * 128 + n) * 64 + lane] = __expf(glast);
        asm volatile("" ::: "memory");
        if (item + C.G < 2048) KV_LOAD(item + C.G, lane, c0);
        __syncthreads();
        f32x4 acc[2][4];
#pragma unroll
        for (int et = 0; et < 2; ++et)
#pragma unroll
            for (int dt = 0; dt < 4; ++dt) acc[et][dt] = (f32x4){0.f, 0.f, 0.f, 0.f};
#pragma unroll
        for (int kk = 0; kk < 2; ++kk) { bf16x8 bfr[4];
#pragma unroll
            for (int dt = 0; dt < 4; ++dt) bfr[dt] = *(const LAS bf16x8*)(Kt + (dt * 16 + fr) * 72 + kk * 32 + 8 * fq);
#pragma unroll
            for (int et = 0; et < 2; ++et) { const bf16x8 afr = *(const LAS bf16x8*)(Vt + ((2 * w4 + et) * 16 + fr) * 72 + kk * 32 + 8 * fq);
#pragma unroll
                for (int dt = 0; dt < 4; ++dt) acc[et][dt] = __builtin_amdgcn_mfma_f32_16x16x32_bf16(afr, bfr[dt], acc[et][dt], 0, 0, 0); } }
        bf16* KV = WSP(bf16, WS_KV) + (size_t)((b * 8 + (isret ? 4 + hh : hh)) * 128 + n) * 8192;
#pragma unroll
        for (int et = 0; et < 2; ++et)
#pragma unroll
            for (int dt = 0; dt < 4; ++dt)
#pragma unroll
                for (int r = 0; r < 4; ++r) KV[((2 * w4 + et) * 16 + 4 * fq + r) * 64 + dt * 16 + fr] = (bf16)f2bf(acc[et][dt][r]);
        __syncthreads();
    }
#undef KV_LOAD
}

__device__ __forceinline__ void phase_scan(Ctx C, const Args& A) {
    PHASE_ENTER(C);
    for (int gid = C.bid * NTHREADS + C.tid; gid < 131072; gid += C.G * NTHREADS) {
        const int dp = gid & 31, e = (gid >> 5) & 127, bh = gid >> 12, h8 = bh & 7, b = bh >> 3;
        unsigned* p = (unsigned*)(WSP(bf16, WS_KV) + (size_t)bh * 128 * 8192 + e * 64) + dp;
        float s0 = 0.f, s1 = 0.f;
        if (h8 < 4) { const float* dec = WSP(float, WS_DEC) + (size_t)(b * 4 + h8) * 128 * 64 + 2 * dp;
#pragma unroll 8
            for (int n = 0; n < NCHUNK; ++n) { const unsigned kv = p[(size_t)n * 4096]; const float d0 = dec[n * 64], d1 = dec[n * 64 + 1]; p[(size_t)n * 4096] = pk2(s0, s1); s0 = d0 * s0 + bflo(kv); s1 = d1 * s1 + bfhi(kv); }
        } else { const float d = exp2f(64.0f * lg2gamma(h8 - 4));
#pragma unroll 8
            for (int n = 0; n < NCHUNK; ++n) { const unsigned kv = p[(size_t)n * 4096]; p[(size_t)n * 4096] = pk2(s0, s1); s0 = d * s0 + bflo(kv); s1 = d * s1 + bfhi(kv); } }
    }
}

__device__ __forceinline__ void phase_mix0_out(Ctx C, const Args& A) {
    PHASE_ENTER(C);
    const int half = C.wave >> 2;
    LAS unsigned char* hb = C.lds + half * 56320;
    LAS bf16* Qp = (LAS bf16*)hb; LAS bf16* Kp = (LAS bf16*)(hb + 9216); LAS bf16* Qpp = (LAS bf16*)(hb + 18432); LAS bf16* Vt = (LAS bf16*)(hb + 27648); LAS bf16* Pm = (LAS bf16*)(hb + 46080);
    LAS float* TOT = (LAS float*)(hb + 55296);
    const bf16* PROJ = WSP(bf16, WS_PROJ); bf16* Y = WSP(bf16, WS_A1);
    for (int item = C.bid; item < 2048; item += C.G) {
        int lane_o = C.lane, w4_o = C.wave & 3; asm volatile("" : "+v"(lane_o), "+s"(w4_o));
        const int lane = lane_o, w4 = w4_o, fr = lane & 15, fq = lane >> 4, c0 = 16 * w4;
        const int pair = item & 3, n = (item >> 2) & 127, b = item >> 9; const bool isret = pair >= 2;
        const int hh = (pair & 1) * 2 + half, t0 = b * SEQ + n * 64;
        const bf16* prow = PROJ + (size_t)(t0 + c0) * PROJW;
        const float lg = lg2gamma(hh);
        const int gcol0 = isret ? 2816 + hh * 128 : 1024 + hh * 128, ycol0 = isret ? 512 + hh * 128 : hh * 128;
        const bf16* bQ = prow + (isret ? 1792 + hh * 64 : hh * 64); const bf16* bK = prow + (isret ? 2048 + hh * 64 : 256 + hh * 64); const bf16* bV = prow + (isret ? 2304 + hh * 128 : 512 + hh * 128); const bf16* bL = prow + 1536 + hh * 64;
        const int xoff = lane < 32 ? 32 : -32;
        unsigned r_la[16], r_q[16], r_k[16], r_qx[16], r_kx[16], r_v0[16], r_v1[16]; float bu = 0.f;
#pragma unroll
        for (int c = 0; c < 16; ++c) { r_la[c] = 0u; r_qx[c] = 0u; r_kx[c] = 0u; }
        const float* rot = WSP(float, WS_ROT) + ((size_t)(n * 64 + c0) * 32 + (lane & 31)) * 2;
        if (!isret) { bu = IN(I_GBUP)[hh * 64 + lane];
#pragma unroll
            for (int c = 0; c < 16; ++c) r_la[c] = bL[c * PROJW + lane];
        } else {
#pragma unroll
            for (int c = 0; c < 16; ++c) { r_qx[c] = bQ[c * PROJW + lane + xoff]; r_kx[c] = bK[c * PROJW + lane + xoff]; } }
#pragma unroll
        for (int c = 0; c < 16; ++c) { r_q[c] = bQ[c * PROJW + lane]; r_k[c] = bK[c * PROJW + lane]; r_v0[c] = bV[c * PROJW + lane]; r_v1[c] = bV[c * PROJW + lane + 64]; }
        float g[16]; float glast = 0.f, off = 0.f;
        if (!isret) { gla_gate_local(r_la, bu, g); TOT[w4 * 64 + lane] = g[15]; }
        __syncthreads();
        if (!isret) {
#pragma unroll
            for (int w = 0; w < 4; ++w) { const float tv = TOT[w * 64 + lane]; glast += tv; if (w < w4) off += tv; }
            const float ref = 0.5f * glast;
#pragma unroll
            for (int c = 0; c < 16; ++c) { const float gq = off + g[c], q = bf2f(r_q[c]), k = bf2f(r_k[c]); const int o = (c0 + c) * 72 + lane;
                Qp[o] = (bf16)f2bf(q * __expf(gq - ref)); Kp[o] = (bf16)f2bf(k * __expf(ref - gq)); Qpp[o] = (bf16)f2bf(q * __expf(gq)); }
        } else {
#pragma unroll
            for (int c = 0; c < 16; ++c) { const float cs = rot[c * 64], sn = rot[c * 64 + 1];
                const float qo = bf2f(r_q[c]), qx = bf2f(r_qx[c]), ko = bf2f(r_k[c]), kx = bf2f(r_kx[c]);
                const float qr = lane < 32 ? qo * cs - qx * sn : qo * cs + qx * sn, kr = lane < 32 ? ko * cs - kx * sn : ko * cs + kx * sn; const int o = (c0 + c) * 72 + lane;
                Qp[o] = (bf16)f2bf(qr); Kp[o] = (bf16)f2bf(kr); Qpp[o] = (bf16)f2bf(qr * exp2f(lg * (float)(c0 + c + 1))); } }
        stage_vt(r_v0, r_v1, Vt, c0, lane);
        asm volatile("" ::: "memory");
        const bf16* St = WSP(bf16, WS_KV) + (size_t)((b * 8 + (isret ? 4 + hh : hh)) * 128 + n) * 8192;
        bf16x8 sfr[2][8]; unsigned r_g[8][4];
#pragma unroll
        for (int kk = 0; kk < 2; ++kk)
#pragma unroll
            for (int et = 0; et < 8; ++et) sfr[kk][et] = *(const bf16x8*)(St + (16 * et + fr) * 64 + kk * 32 + 8 * fq);
#pragma unroll
        for (int et = 0; et < 8; ++et)
#pragma unroll
            for (int r = 0; r < 4; ++r) r_g[et][r] = (PROJ + (size_t)(t0 + 16 * w4) * PROJW + gcol0)[(4 * fq + r) * PROJW + 16 * et + fr];
        __syncthreads();
        { f32x4 sc[4];
#pragma unroll
            for (int jt = 0; jt < 4; ++jt) sc[jt] = (f32x4){0.f, 0.f, 0.f, 0.f};
#pragma unroll
            for (int kk = 0; kk < 2; ++kk) { const bf16x8 afr = *(const LAS bf16x8*)(Qp + (16 * w4 + fr) * 72 + kk * 32 + 8 * fq);
#pragma unroll
                for (int jt = 0; jt < 4; ++jt) { const bf16x8 bfr = *(const LAS bf16x8*)(Kp + (16 * jt + fr) * 72 + kk * 32 + 8 * fq); sc[jt] = __builtin_amdgcn_mfma_f32_16x16x32_bf16(afr, bfr, sc[jt], 0, 0, 0); } }
#pragma unroll
            for (int jt = 0; jt < 4; ++jt)
#pragma unroll
                for (int r = 0; r < 4; ++r) { const int i = 16 * w4 + 4 * fq + r, j = 16 * jt + fr; float v = sc[jt][r]; if (isret) v *= exp2f(lg * (float)(i - j)); if (j > i) v = 0.f; Pm[i * 72 + j] = (bf16)f2bf(v); } }
        asm volatile("s_waitcnt lgkmcnt(0)" ::: "memory");
        f32x4 o[8];
#pragma unroll
        for (int et = 0; et < 8; ++et) o[et] = (f32x4){0.f, 0.f, 0.f, 0.f};
#pragma unroll
        for (int kk = 0; kk < 2; ++kk) { const bf16x8 afr = *(const LAS bf16x8*)(Pm + (16 * w4 + fr) * 72 + kk * 32 + 8 * fq), afr2 = *(const LAS bf16x8*)(Qpp + (16 * w4 + fr) * 72 + kk * 32 + 8 * fq);
#pragma unroll
            for (int et = 0; et < 8; ++et) { const bf16x8 bfr = *(const LAS bf16x8*)(Vt + (16 * et + fr) * 72 + kk * 32 + 8 * fq);
                o[et] = __builtin_amdgcn_mfma_f32_16x16x32_bf16(afr, bfr, o[et], 0, 0, 0); o[et] = __builtin_amdgcn_mfma_f32_16x16x32_bf16(afr2, sfr[kk][et], o[et], 0, 0, 0); } }
        float mu[4], rs[4];
#pragma unroll
        for (int r = 0; r < 4; ++r) { float s1 = 0.f;
            if (isret) {
#pragma unroll
                for (int et = 0; et < 8; ++et) s1 += o[et][r];
                s1 += __shfl_xor(s1, 1); s1 += __shfl_xor(s1, 2); s1 += __shfl_xor(s1, 4); s1 += __shfl_xor(s1, 8); }
            mu[r] = s1 * (1.0f / 128.0f); float s2 = 0.f;
#pragma unroll
            for (int et = 0; et < 8; ++et) { const float d = o[et][r] - mu[r]; s2 += d * d; }
            s2 += __shfl_xor(s2, 1); s2 += __shfl_xor(s2, 2); s2 += __shfl_xor(s2, 4); s2 += __shfl_xor(s2, 8);
            rs[r] = 1.0f / sqrtf(s2 * (1.0f / 128.0f) + EPS); }
#pragma unroll
        for (int et = 0; et < 8; ++et) { const int e = 16 * et + fr; const float nw = isret ? IN(I_RNW)[hh * 128 + e] : IN(I_GNW)[e];
#pragma unroll
            for (int r = 0; r < 4; ++r) { const int t = t0 + 16 * w4 + 4 * fq + r; const float gate = siluf(bf2f(r_g[et][r]));
                Y[(size_t)t * DM + ycol0 + e] = (bf16)f2bf((o[et][r] - mu[r]) * rs[r] * nw * gate); } }
        __syncthreads();
    }
}

__device__ __forceinline__ unsigned mono_key(float v) { const unsigned u = __float_as_uint(v); return u ^ ((unsigned)((int)u >> 31) | 0x80000000u); }
__device__ __forceinline__ float mono_val(unsigned k) { return __uint_as_float((k & 0x80000000u) ? (k ^ 0x80000000u) : ~k); }
#define CE_DESC(a, b) { const unsigned hi_ = max((a), (b)), lo_ = min((a), (b)); (a) = hi_; (b) = lo_; }
__device__ __forceinline__ void sort16_desc(unsigned (&v)[16]) {
#pragma unroll
    for (int k = 2; k <= 16; k <<= 1)
#pragma unroll
        for (int j = k >> 1; j > 0; j >>= 1)
#pragma unroll
            for (int i = 0; i < 16; ++i) { const int l = i ^ j; if (l > i) { if ((i & k) == 0) { CE_DESC(v[i], v[l]); } else { CE_DESC(v[l], v[i]); } } }
}
__device__ __forceinline__ void merge_top16(unsigned (&T)[16], const unsigned (&G)[16]) {
#pragma unroll
    for (int i = 0; i < 16; ++i) T[i] = max(T[i], G[15 - i]);
#pragma unroll
    for (int j = 8; j > 0; j >>= 1)
#pragma unroll
        for (int i = 0; i < 16; ++i) { const int l = i ^ j; if (l > i) CE_DESC(T[i], T[l]); }
}
__device__ __forceinline__ void topk_load_chunk(const bf16* SC, int tok0, int X, int q, int lane, uint2 (&nxt)[8]) {
#pragma unroll
    for (int m = 0; m < 8; ++m) { const int li = m * 8 + (lane >> 3); nxt[m] = *(const uint2*)(SC + (size_t)(tok0 + (li >> 3)) * 2048 + (li & 7) * 256 + X * 128 + q * 32 + (lane & 7) * 4); }
}
__device__ __forceinline__ void top16_list(const bf16* SC, int tok0, int X, int tok0n, int Xn, LAS float* row, int lane, unsigned (&L)[16], uint2 (&nxt)[8]) {
#pragma unroll
    for (int q = 0; q < 4; ++q) {
#pragma unroll
        for (int m = 0; m < 8; ++m) { const int li = m * 8 + (lane >> 3); const uint2 v = nxt[m];
            LAS float* dst = row + li * 33 + (lane & 7) * 4; dst[0] = bflo(v.x); dst[1] = bfhi(v.x); dst[2] = bflo(v.y); dst[3] = bfhi(v.y); }
        if (q < 3) topk_load_chunk(SC, tok0, X, q + 1, lane, nxt); else topk_load_chunk(SC, tok0n, Xn, 0, lane, nxt);
        asm volatile("s_waitcnt lgkmcnt(0)" ::: "memory");
#pragma unroll
        for (int hgrp = 0; hgrp < 2; ++hgrp) { unsigned G[16];
#pragma unroll
            for (int i = 0; i < 16; ++i) { const float v = row[lane * 33 + hgrp * 16 + i]; G[i] = (mono_key(v) & ~127u) | (unsigned)(127 - (q * 32 + hgrp * 16 + i)); }
            sort16_desc(G);
            if (q == 0 && hgrp == 0) {
#pragma unroll
                for (int i = 0; i < 16; ++i) L[i] = G[i];
            } else merge_top16(L, G); }
        asm volatile("s_waitcnt lgkmcnt(0)" ::: "memory");
    }
}
__device__ __forceinline__ void phase_topk(Ctx C, const Args& A) {
    PHASE_ENTER(C);
    const int lane = C.lane; const int gw = C.bid * NWAVES + C.wave, NGW = C.G * NWAVES;
    LAS float* row = (LAS float*)(C.lds + C.wave * 8448);
    const bf16* SC = WSP(bf16, WS_SC);
    uint2 nxt[8]; if (gw < NT / 8) topk_load_chunk(SC, gw * 8, 0, 0, lane, nxt);
    for (int it = gw; it < NT / 8; it += NGW) {
        const int tok0 = it * 8, mytok = tok0 + (lane >> 3), myh = lane & 7;
        unsigned TA[16], TB[16];
        const int tok0n = (it + NGW < NT / 8) ? (it + NGW) * 8 : tok0;
        top16_list(SC, tok0, 0, tok0, 1, row, lane, TA, nxt);
        top16_list(SC, tok0, 1, tok0n, 0, row, lane, TB, nxt);
        float sa[16], sb[16]; LAS int* irow = (LAS int*)(row + lane * 33);
#pragma unroll
        for (int i = 0; i < 16; ++i) { sa[i] = mono_val(TA[i] & ~127u); sb[i] = mono_val(TB[i] & ~127u); irow[i] = 127 - (int)(TA[i] & 127u); irow[16 + i] = 127 - (int)(TB[i] & 127u); }
        unsigned B[16];
        {
            constexpr int NC = 50;
            unsigned Gp[16];
#pragma unroll
            for (int grp = 0; grp < 4; ++grp) {
                int cnt = 0, slot = 0;
#pragma unroll
                for (int i = 0; i < 16; ++i)
#pragma unroll
                    for (int j = 0; j < 16; ++j) if ((i + 1) * (j + 1) <= 16) { if (cnt >= grp * 16 && cnt < grp * 16 + 16) { Gp[slot] = (mono_key(sa[i] + sb[j]) & ~255u) | (unsigned)(255 - (i * 16 + j)); ++slot; } ++cnt; }
#pragma unroll
                for (int z = 0; z < 16; ++z) if (z >= NC - grp * 16) Gp[z] = 0u;
                sort16_desc(Gp);
                if (grp == 0) {
#pragma unroll
                    for (int i = 0; i < 16; ++i) B[i] = Gp[i];
                } else merge_top16(B, Gp);
            }
        }
        asm volatile("s_waitcnt lgkmcnt(0)" ::: "memory");
        const float mx = mono_val(B[0] & ~255u); float ex[16]; float zs = 0.f;
#pragma unroll
        for (int r = 0; r < 16; ++r) { ex[r] = __expf(mono_val(B[r] & ~255u) - mx); zs += ex[r]; }
        const float iz = 1.0f / zs;
        int* eo = WSP(int, WS_EID) + (size_t)mytok * 128 + myh * 16; float* go = WSP(float, WS_GATE) + (size_t)mytok * 128 + myh * 16;
#pragma unroll
        for (int r4 = 0; r4 < 4; ++r4) { int ev[4]; float gv[4];
#pragma unroll
            for (int r = 0; r < 4; ++r) { const int flat = 255 - (int)(B[r4 * 4 + r] & 255u); ev[r] = irow[flat >> 4] * 128 + irow[16 + (flat & 15)]; gv[r] = ex[r4 * 4 + r] * iz; }
            *(int4*)(eo + r4 * 4) = make_int4(ev[0], ev[1], ev[2], ev[3]); *(f32x4*)(go + r4 * 4) = (f32x4){gv[0], gv[1], gv[2], gv[3]}; }
        asm volatile("s_waitcnt lgkmcnt(0)" ::: "memory");
    }
}

__device__ __forceinline__ unsigned fp4_code(float y) {
    const float a = fabsf(y);
    const unsigned c = (a > 0.25f) + (a > 0.75f) + (a > 1.25f) + (a > 1.75f) + (a > 2.5f) + (a > 3.5f) + (a > 5.0f);
    return c | (y < 0.f ? 8u : 0u);
}
__device__ __forceinline__ float wave_max64(float v) {
#pragma unroll
    for (int o = 1; o < 64; o <<= 1) v = fmaxf(v, __shfl_xor(v, o));
    return v;
}
__device__ __forceinline__ void quant_row16(const f32x4 (&v)[4], float inv, unsigned& d0, unsigned& d1) {
    unsigned w[2] = {0u, 0u};
#pragma unroll
    for (int c = 0; c < 4; ++c)
#pragma unroll
        for (int j = 0; j < 4; ++j) w[c >> 1] |= fp4_code(v[c][j] * inv) << (4 * ((c & 1) * 4 + j));
    d0 = w[0]; d1 = w[1];
}
__device__ __forceinline__ void phase_convert_peer(Ctx C, const Args& A, int l, int wg0, int nwg) {
    PHASE_ENTER(C);
    if (C.bid < wg0) return;
    const int gt = (C.bid - wg0) * NTHREADS + C.tid, NGT = nwg * NTHREADS;
    const float* U = IN(I_PU) + (size_t)l * 16384 * 1024; const float* V = IN(I_PV) + (size_t)l * 16384 * 1024; const float* nw = IN(I_NFW) + l * 1024;
#pragma unroll 2
    for (int i = gt; i < 16384 * 64; i += NGT) {
        const f32x4* up = (const f32x4*)(U + (size_t)i * 16); const f32x4* wp = (const f32x4*)(nw + (i & 63) * 16); const f32x4* vp = (const f32x4*)(V + (size_t)i * 16);
        f32x4 a[4], b[4];
#pragma unroll
        for (int c = 0; c < 4; ++c) { a[c] = up[c] * wp[c]; b[c] = vp[c]; }
        float au = 0.f, av = 0.f;
#pragma unroll
        for (int c = 0; c < 4; ++c) { au = fmaxf(au, fmaxf(fmaxf(fabsf(a[c][0]), fabsf(a[c][1])), fmaxf(fabsf(a[c][2]), fabsf(a[c][3])))); av = fmaxf(av, fmaxf(fmaxf(fabsf(b[c][0]), fabsf(b[c][1])), fmaxf(fabsf(b[c][2]), fabsf(b[c][3])))); }
        au = wave_max64(au); av = wave_max64(av);
        const float su = au > 0.f ? au * (1.0f / 6.0f) : 1.0f, sv = av > 0.f ? av * (1.0f / 6.0f) : 1.0f;
        unsigned u0, u1, v0, v1;
        quant_row16(a, 1.0f / su, u0, u1); quant_row16(b, 1.0f / sv, v0, v1);
        const int e = i >> 6, bl = i & 63;
        *(uint2*)(C.ws + WS_UT4 + (size_t)e * 512 + bl * 8) = make_uint2(u0, u1);
        *(uint2*)(C.ws + WS_VT4 + ((size_t)(bl >> 3) * 16384 + e) * 64 + (bl & 7) * 8) = make_uint2(v0, v1);
        if (bl == 0) *(float2*)(C.ws + WS_SCL + (size_t)e * 8) = make_float2(su, sv); }
    const float* P = IN(I_P) + (size_t)l * NT * 256;
#pragma unroll 4
    for (int i = gt; i < NT * 32; i += NGT) { const f32x4 a = *(const f32x4*)(P + (size_t)i * 8), b = *(const f32x4*)(P + (size_t)i * 8 + 4);
        *(v4u*)(WSP(bf16, WS_PB) + (size_t)i * 8) = (v4u){pk2(a[0], a[1]), pk2(a[2], a[3]), pk2(b[0], b[1]), pk2(b[2], b[3])}; }
}

typedef float f32x2 __attribute__((ext_vector_type(2)));
#define DPP_ADD(v, ctrl) ((v) + __builtin_bit_cast(float, __builtin_amdgcn_update_dpp(0, __builtin_bit_cast(int, (v)), (ctrl), 0xF, 0xF, true)))
__device__ __forceinline__ float row16_sum(float v) {
    v = DPP_ADD(v, 0xB1); v = DPP_ADD(v, 0x4E); v = DPP_ADD(v, 0x141); v = DPP_ADD(v, 0x140); return v;
}
__device__ __forceinline__ float wave_sum_fast(float v) { v = row16_sum(v); v += __shfl_xor(v, 16); v += __shfl_xor(v, 32); return v; }
typedef int v8i_t __attribute__((ext_vector_type(8)));
#define FP4X2(w, b) __builtin_amdgcn_cvt_scalef32_pk_f32_fp4((w), 1.0f, (b))

typedef unsigned u32x2_t __attribute__((ext_vector_type(2)));
constexpr int EU_TOK = 4, EU_CAP = 128 * EU_TOK, EU_WAVE_LDS = 8192 + 1024 * EU_TOK + 2 * 4 * EU_CAP;
__device__ __forceinline__ int eu_build(const v4u (&E)[2], LAS unsigned* wl, int lane) {
#pragma unroll
    for (int q = 0; q < 2; ++q) { v4u w;
#pragma unroll
        for (int j = 0; j < 4; ++j) w[j] = E[q][j] | ((unsigned)(q * 256 + 4 * lane + j) << 14);
        *(LAS v4u*)(wl + q * 256 + 4 * lane) = w; }
    return EU_CAP;
}
#define EU_STEP(st) { const v4u a_ = *(const LAS v4u*)((((st) & 3) == 0 ? pa0 : (((st) & 3) == 1 ? pa1 : (((st) & 3) == 2 ? pa2 : pa3))) + 256 * ((st) >> 2)); \
        const v4u b0 = *(const LAS v4u*)(((st) & 1 ? p10 : p00) + 256 * ((st) >> 1)), b1 = *(const LAS v4u*)(((st) & 1 ? p11 : p01) + 256 * ((st) >> 1)); \
        const v8i_t bb = {(int)b0[0], (int)b0[1], (int)b0[2], (int)b0[3], (int)b1[0], (int)b1[1], (int)b1[2], (int)b1[3]}; \
        const v8i_t aa = {(int)a_[0], (int)a_[1], (int)a_[2], (int)a_[3], 0, 0, 0, 0}; \
        d = __builtin_amdgcn_mfma_scale_f32_16x16x128_f8f6f4(aa, bb, d, 4, 0, 0, 0x7f7f7f7f, 0, 0x7f7f7f7f); }
__device__ __forceinline__ void eu_block_loads(v4u (&EN)[2], v4u (&XN)[EU_TOK], f32x4 (&sq)[4], const int* EID, const unsigned char* XQ, const float* SSQ, int blk, int lane) {
    const GAS v4u* ep = (const GAS v4u*)(EID + (size_t)blk * EU_CAP) + lane;
#pragma unroll
    for (int q = 0; q < 2; ++q) EN[q] = ep[64 * q];
    const GAS v4u* xp = (const GAS v4u*)(XQ + (size_t)blk * (1024 * EU_TOK)) + lane;
#pragma unroll
    for (int s = 0; s < EU_TOK; ++s) XN[s] = xp[64 * s];
    { const GAS f32x4* sp = (const GAS f32x4*)(SSQ + (size_t)(blk * EU_TOK + (lane & 3)) * 16); sq[0] = sp[0]; sq[1] = sp[1]; sq[2] = sp[2]; sq[3] = sp[3]; }
}
__device__ __forceinline__ float eu_rstd(const f32x4 (&sq)[4]) {
    const f32x4 a = sq[0], b = sq[1], c = sq[2], d = sq[3];
    const float s = (((a[0] + a[1]) + (a[2] + a[3])) + ((b[0] + b[1]) + (b[2] + b[3]))) + (((c[0] + c[1]) + (c[2] + c[3])) + ((d[0] + d[1]) + (d[2] + d[3])));
    return 1.0f / sqrtf(s * (1.0f / 1024.0f) + 1e-6f);
}
__device__ __forceinline__ void phase_experts_u(Ctx C, const Args& A) {
    PHASE_ENTER(C);
    const int lane = C.lane; const int ncls = C.G >> 3;
    if (C.bid >= ncls * 8) return;
    const int wi = C.bid * NWAVES + C.wave, NWC = ncls * 8 * NWAVES;
    const GAS unsigned char* UT = (const GAS unsigned char*)(C.ws + WS_UT4); const GAS u32x2_t* SC2 = (const GAS u32x2_t*)(C.ws + WS_SCL);
    const int* EID = WSP(int, WS_EID); const GAS float* GATE = (const GAS float*)WSP(float, WS_GATE); GAS unsigned char* COEF = (GAS unsigned char*)(C.ws + WS_COEF);
    const unsigned char* XQ = C.ws + WS_XQ; const float* SSQ = WSP(float, WS_SSQ0);
    LAS unsigned char* at = C.lds + C.wave * EU_WAVE_LDS; LAS unsigned char* xq = at + 8192; LAS unsigned* wl = (LAS unsigned*)(xq + 1024 * EU_TOK);
    constexpr int NBLK = NT / EU_TOK;
    int blk = wi; if (blk >= NBLK) return;
    v4u EN[2], XN[EU_TOK]; f32x4 rsn[4];
    eu_block_loads(EN, XN, rsn, EID, XQ, SSQ, blk, lane);
    const int kg = lane >> 4, i16 = lane & 15, s4 = lane & 3;
    const int mB = kg | (s4 << 2);
    const LAS unsigned char* xr = xq + s4 * 1024;
    const LAS unsigned char* p00 = xr + 16 * (0 ^ mB); const LAS unsigned char* p01 = xr + 16 * (4 ^ mB); const LAS unsigned char* p10 = xr + 16 * (8 ^ mB); const LAS unsigned char* p11 = xr + 16 * (12 ^ mB);
    const int mA = kg ^ i16;
    const LAS unsigned char* ar = at + 512 * i16;
    const LAS unsigned char* pa0 = ar + 16 * (0 ^ mA); const LAS unsigned char* pa1 = ar + 16 * (4 ^ mA); const LAS unsigned char* pa2 = ar + 16 * (8 ^ mA); const LAS unsigned char* pa3 = ar + 16 * (12 ^ mA);
    const GAS unsigned char* usrc[8];
    const int hrow = lane >> 5, hpos = lane & 31;
    struct UMeta { u32x2_t sc; float gate; unsigned ent; };
#define EU_PREP(WL, G, TOK0, M) { const LAS unsigned* wg_ = (WL) + 16 * (G); unsigned erw[8]; \
        _Pragma("unroll") for (int j = 0; j < 8; ++j) erw[j] = wg_[2 * j + hrow]; \
        M.ent = wg_[i16]; \
        asm volatile("s_waitcnt lgkmcnt(0)" : "+v"(erw[0]), "+v"(erw[1]), "+v"(erw[2]), "+v"(erw[3]), "+v"(erw[4]), "+v"(erw[5]), "+v"(erw[6]), "+v"(erw[7]), "+v"(M.ent) :: "memory"); \
        _Pragma("unroll") for (int j = 0; j < 8; ++j) { const int r = 2 * j + hrow; usrc[j] = UT + (size_t)(erw[j] & 0x3fffu) * 512 + 16 * (hpos ^ (r & 15)); } \
        { const GAS u32x2_t* sp_ = SC2 + (M.ent & 0x3fffu); const GAS float* gp_ = GATE + (size_t)(TOK0) * 128 + ((M.ent >> 14) & 1023u); \
          asm volatile("global_load_dwordx2 %0, %1, off" : "=v"(M.sc) : "v"(sp_) : "memory"); asm volatile("global_load_dword %0, %1, off" : "=v"(M.gate) : "v"(gp_) : "memory"); } }
#define EU_PIECE(j) { __builtin_amdgcn_sched_barrier(0); __builtin_amdgcn_global_load_lds((const GAS unsigned*)usrc[j], (LAS unsigned*)(at + 1024 * (j)), 16, 0, 0); __builtin_amdgcn_sched_barrier(0); }
#define EU_DMA(WL, G, TOK0, M) { EU_PREP(WL, G, TOK0, M) EU_PIECE(0) EU_PIECE(1) EU_PIECE(2) EU_PIECE(3) EU_PIECE(4) EU_PIECE(5) EU_PIECE(6) EU_PIECE(7) }
#define EU_MM(st) { const v8i_t bb = {(int)bR[2 * (st)][0], (int)bR[2 * (st)][1], (int)bR[2 * (st)][2], (int)bR[2 * (st)][3], (int)bR[2 * (st) + 1][0], (int)bR[2 * (st) + 1][1], (int)bR[2 * (st) + 1][2], (int)bR[2 * (st) + 1][3]}; \
        const v8i_t aa = {(int)aR[st][0], (int)aR[st][1], (int)aR[st][2], (int)aR[st][3], 0, 0, 0, 0}; \
        d = __builtin_amdgcn_mfma_scale_f32_16x16x128_f8f6f4(aa, bb, d, 4, 0, 0, 0x7f7f7f7f, 0, 0x7f7f7f7f); }
#define EU_LOADB() { _Pragma("unroll") for (int st = 0; st < 8; ++st) { bR[2 * st] = *(const LAS v4u*)(((st) & 1 ? p10 : p00) + 256 * ((st) >> 1)); bR[2 * st + 1] = *(const LAS v4u*)(((st) & 1 ? p11 : p01) + 256 * ((st) >> 1)); } \
        asm volatile("s_waitcnt lgkmcnt(0)" ::: "memory"); }
#define EU_UNIT(CUR, NXT) { \
        asm volatile("s_waitcnt vmcnt(0)" : "+v"(CUR.sc), "+v"(CUR.gate) :: "memory");     \
        v4u aR[8]; \
        _Pragma("unroll") for (int st = 0; st < 8; ++st) aR[st] = *(const LAS v4u*)((((st) & 3) == 0 ? pa0 : (((st) & 3) == 1 ? pa1 : (((st) & 3) == 2 ? pa2 : pa3))) + 256 * ((st) >> 2)); \
        asm volatile("s_waitcnt lgkmcnt(0)" ::: "memory"); \
        const bool last = g + 1 >= ng; const bool nextblk = last && hasn; \
        if (nextblk) nn = eu_build(EN, wl + (par ^ 1) * EU_CAP, lane); \
        { const LAS unsigned* wln = wl + (nextblk ? par ^ 1 : par) * EU_CAP; const int gn = last ? 0 : g + 1; const int tokn = nextblk ? blkn * EU_TOK : tok0; \
          EU_PREP(wln, gn, tokn, NXT) }     \
        f32x4 d = (f32x4){0.f, 0.f, 0.f, 0.f}; \
        EU_MM(0) asm volatile("" : "+v"(d)); EU_PIECE(0) EU_PIECE(1) EU_MM(1) asm volatile("" : "+v"(d)); EU_PIECE(2) EU_PIECE(3) EU_MM(2) asm volatile("" : "+v"(d)); EU_PIECE(4) EU_PIECE(5) EU_MM(3) asm volatile("" : "+v"(d)); EU_PIECE(6) EU_PIECE(7) \
        EU_MM(4) asm volatile("" : "+v"(d)); EU_MM(5) asm volatile("" : "+v"(d)); EU_MM(6) asm volatile("" : "+v"(d)); EU_MM(7) asm volatile("" : "+v"(d));     \
        const unsigned ent = CUR.ent; const unsigned idx = (ent >> 14) & 1023u; \
        const int slot = (int)(ent >> 21) & 3; \
        const int src = (slot + 16 * (i16 >> 2)) << 2; \
        const float v0 = __int_as_float(__builtin_amdgcn_ds_bpermute(src, __float_as_int(d[0]))), v1 = __int_as_float(__builtin_amdgcn_ds_bpermute(src, __float_as_int(d[1]))); \
        const float v2 = __int_as_float(__builtin_amdgcn_ds_bpermute(src, __float_as_int(d[2]))), v3 = __int_as_float(__builtin_amdgcn_ds_bpermute(src, __float_as_int(d[3]))); \
        const int r4 = i16 & 3; const float val = r4 == 0 ? v0 : (r4 == 1 ? v1 : (r4 == 2 ? v2 : v3)); \
        const float rs = __int_as_float(__builtin_amdgcn_ds_bpermute(slot << 2, __float_as_int(rsl))); \
        const float coef = CUR.gate * __uint_as_float(CUR.sc.y) * gelu1(val * rs * __uint_as_float(CUR.sc.x)); \
        { const float c64 = __builtin_amdgcn_fmed3f(coef * 64.0f, -448.0f, 448.0f); const int c8 = __builtin_amdgcn_cvt_pk_fp8_f32(c64, c64, 0, false); \
          const unsigned pos = idx & 127u; \
          if (lane < 16 && (int)ent >= 0) COEF[(size_t)(tok0 + (idx >> 7)) * 128 + 16 * (pos & 7u) + (pos >> 3)] = (unsigned char)c8; } \
        asm volatile("s_waitcnt lgkmcnt(0)" ::: "memory"); \
        if (!last) ++g; \
        else { if (!hasn) break; \
              \
            _Pragma("unroll") for (int s = 0; s < EU_TOK; ++s) *(LAS v4u*)(xq + s * 1024 + 16 * (lane ^ ((s & 3) << 2))) = XN[s]; \
            EU_LOADB() rsl = eu_rstd(rsn); blk = blkn; tok0 = blk * EU_TOK; ng = nn > 16 ? (nn + 15) >> 4 : 1; g = 0; par ^= 1; \
            blkn = blk + NWC; hasn = blkn < NBLK; \
            if (hasn) eu_block_loads(EN, XN, rsn, EID, XQ, SSQ, blkn, lane); } }
    int par = 0, nn = 0, g = 0;
    int ng; { const int n0 = eu_build(EN, wl, lane); ng = n0 > 16 ? (n0 + 15) >> 4 : 1; }
#pragma unroll
    for (int s = 0; s < EU_TOK; ++s) *(LAS v4u*)(xq + s * 1024 + 16 * (lane ^ ((s & 3) << 2))) = XN[s];
    v4u bR[16]; EU_LOADB()
    float rsl = eu_rstd(rsn); int tok0 = blk * EU_TOK;
    int blkn = blk + NWC; bool hasn = blkn < NBLK;
    if (hasn) eu_block_loads(EN, XN, rsn, EID, XQ, SSQ, blkn, lane);
    UMeta MA, MB;
    EU_DMA(wl, 0, tok0, MA)
    while (true) {
        EU_UNIT(MA, MB)
        EU_UNIT(MB, MA)
    }
#undef EU_UNIT
#undef EU_MM
#undef EU_LOADB
#undef EU_DMA
#undef EU_PIECE
#undef EU_PREP
}

typedef int v2i_t __attribute__((ext_vector_type(2)));
__device__ __forceinline__ void ev_dma(LAS unsigned char* tile, const GAS unsigned char* VTl, const v4u e0, const v4u e1) {
#pragma unroll
    for (int it = 0; it < 4; ++it) __builtin_amdgcn_global_load_lds((const GAS unsigned*)(VTl + (size_t)(e0[it] << 6)), (LAS unsigned*)(tile + 1024 * it), 16, 0, 0);
#pragma unroll
    for (int it = 0; it < 4; ++it) __builtin_amdgcn_global_load_lds((const GAS unsigned*)(VTl + (size_t)(e1[it] << 6)), (LAS unsigned*)(tile + 1024 * (4 + it)), 16, 0, 0);
}
#define EV_TR(dst, base, off) asm volatile("ds_read_b64_tr_b4 %0, %1 offset:" #off : "=v"(dst) : "v"(base) : "memory")
#define EV_MMA(ct, T0, T1) { const v8i_t aa = {T0.x, T0.y, T1.x, T1.y, 0, 0, 0, 0}; \
        sel = __builtin_amdgcn_mfma_scale_f32_16x16x128_f8f6f4(aa, bb, sel, 4, 0, 0, 0x7f7f7f7f, 0, jc == (ct) ? 0x79797979 : 0); }
__device__ __forceinline__ void phase_experts_v(Ctx C, const Args& A, const bf16* hin, bf16* hbout, float* ssq_out) {
    PHASE_ENTER(C);
    const int lane = C.lane; const int ncls = C.G >> 3;
    if (C.bid >= ncls * 8) return;
    const int x = C.bid & 7; const int wi = (C.bid >> 3) * NWAVES + C.wave, NWC = ncls * NWAVES;
    const int ps = lane >> 2, q4 = lane & 3, r16 = lane & 15, kg = lane >> 4, jc = lane & 7;
    const GAS unsigned char* VTl = (const GAS unsigned char*)(C.ws + WS_VT4) + (size_t)x * 16384 * 64 + 16 * (q4 ^ ((ps >> 2) & 3));
    const GAS int* EID = (const GAS int*)WSP(int, WS_EID) + 8 * ps; const GAS unsigned char* COEF = (const GAS unsigned char*)(C.ws + WS_COEF) + 16 * kg;
    const int hoff = 128 * x + 16 * jc + 4 * kg;
    LAS unsigned char* tile0 = C.lds + C.wave * 16384;
    const int fsw = (r16 >> 2) & 3; const int rowoff = 64 * (32 * kg + r16);
    int t = wi; if (t >= NT) return;
    v4u ea0, ea1, eb0, eb1, cb0, cb1; u32x2_t hres, ypk = {0u, 0u}; float yss = 0.f; int tp = -1;
    { const GAS v4u* p = (const GAS v4u*)(EID + (size_t)t * 128); ea0 = p[0]; ea1 = p[1]; }
    ev_dma(tile0, VTl, ea0, ea1);
    { const GAS unsigned char* cp = COEF + (size_t)t * 128; cb0 = *(const GAS v4u*)cp; cb1 = *(const GAS v4u*)(cp + 64); hres = *(const GAS u32x2_t*)(hin + (size_t)t * DM + hoff); }
    int t1 = t + NWC < NT ? t + NWC : t;
    { const GAS v4u* p = (const GAS v4u*)(EID + (size_t)t1 * 128); eb0 = p[0]; eb1 = p[1]; }
    int par = 0;
    while (true) {
        asm volatile("s_waitcnt vmcnt(0)" ::: "memory");
        const v8i_t bb = {(int)cb0[0], (int)cb0[1], (int)cb0[2], (int)cb0[3], (int)cb1[0], (int)cb1[1], (int)cb1[2], (int)cb1[3]};
        const u32x2_t hcur = hres;
        LAS unsigned char* tile = tile0 + 8192 * par;
        const bool more = t + NWC < NT;
        const GAS unsigned char* dsrc[8];
#pragma unroll
        for (int it = 0; it < 4; ++it) { dsrc[it] = VTl + (size_t)(eb0[it] << 6); dsrc[4 + it] = VTl + (size_t)(eb1[it] << 6); }
#pragma unroll
        for (int it = 0; it < 8; ++it) asm volatile("" : "+v"(dsrc[it]));
        if (tp >= 0) { if ((lane & 8) == 0) *(GAS u32x2_t*)(hbout + (size_t)tp * DM + hoff) = ypk;
                       if (lane < 2) ((GAS float*)ssq_out)[(size_t)tp * 16 + 2 * x + lane] = lane == 0 ? yss : 0.f; }
        { const GAS unsigned char* cp = COEF + (size_t)t1 * 128; cb0 = *(const GAS v4u*)cp; cb1 = *(const GAS v4u*)(cp + 64); hres = *(const GAS u32x2_t*)(hin + (size_t)t1 * DM + hoff); }
        const int t2 = t1 + NWC < NT ? t1 + NWC : t1;
        { const GAS v4u* p = (const GAS v4u*)(EID + (size_t)t2 * 128); eb0 = p[0]; eb1 = p[1]; }
        LAS unsigned char* tilen = tile0 + 8192 * (par ^ 1);
        const unsigned o0 = (unsigned)(size_t)(tile + rowoff + 16 * (0 ^ fsw)), o1 = (unsigned)(size_t)(tile + rowoff + 16 * (1 ^ fsw));
        const unsigned o2 = (unsigned)(size_t)(tile + rowoff + 16 * (2 ^ fsw)), o3 = (unsigned)(size_t)(tile + rowoff + 16 * (3 ^ fsw));
        v2i_t a00, a01, a10, a11, a20, a21, a30, a31, a40, a41, a50, a51, a60, a61, a70, a71;
        EV_TR(a00, o0, 0); EV_TR(a01, o0, 1024); EV_TR(a10, o0, 8); EV_TR(a11, o0, 1032);
        EV_TR(a20, o1, 0); EV_TR(a21, o1, 1024); EV_TR(a30, o1, 8); EV_TR(a31, o1, 1032);
        EV_TR(a40, o2, 0); EV_TR(a41, o2, 1024); EV_TR(a50, o2, 8); EV_TR(a51, o2, 1032);
        EV_TR(a60, o3, 0); EV_TR(a61, o3, 1024); EV_TR(a70, o3, 8); EV_TR(a71, o3, 1032);
        asm volatile("s_waitcnt lgkmcnt(0)" : "+v"(a00), "+v"(a01), "+v"(a10), "+v"(a11), "+v"(a20), "+v"(a21), "+v"(a30), "+v"(a31), "+v"(a40), "+v"(a41), "+v"(a50), "+v"(a51), "+v"(a60), "+v"(a61), "+v"(a70), "+v"(a71) :: "memory");
        f32x4 sel = (f32x4){0.f, 0.f, 0.f, 0.f};
#define EV_PIECE(it, E) { asm volatile("" : "+v"(sel)); __builtin_amdgcn_sched_barrier(0); __builtin_amdgcn_global_load_lds((const GAS unsigned*)dsrc[it], (LAS unsigned*)(tilen + 1024 * (it)), 16, 0, 0); __builtin_amdgcn_sched_barrier(0); }
        EV_MMA(0, a00, a01) EV_PIECE(0, ec0[0]) EV_MMA(1, a10, a11) EV_PIECE(1, ec0[1]) EV_MMA(2, a20, a21) EV_PIECE(2, ec0[2]) EV_MMA(3, a30, a31) EV_PIECE(3, ec0[3])
        EV_MMA(4, a40, a41) EV_PIECE(4, ec1[0]) EV_MMA(5, a50, a51) EV_PIECE(5, ec1[1]) EV_MMA(6, a60, a61) EV_PIECE(6, ec1[2]) EV_MMA(7, a70, a71) EV_PIECE(7, ec1[3])
#undef EV_PIECE
        const float y0 = bflo(hcur.x) + sel[0], y1 = bfhi(hcur.x) + sel[1], y2 = bflo(hcur.y) + sel[2], y3 = bfhi(hcur.y) + sel[3];
        ypk.x = pg8::cvt_pk_bf16(y0, y1); ypk.y = pg8::cvt_pk_bf16(y2, y3);
        const float s2 = (lane & 8) == 0 ? (y0 * y0 + y1 * y1) + (y2 * y2 + y3 * y3) : 0.f;
        yss = wave_sum_fast(s2); tp = t;
        asm volatile("s_waitcnt lgkmcnt(0)" ::: "memory");
        if (!more) break;
        t = t1; t1 = t2; par ^= 1;
    }
    if ((lane & 8) == 0) *(GAS u32x2_t*)(hbout + (size_t)tp * DM + hoff) = ypk;
    if (lane < 2) ((GAS float*)ssq_out)[(size_t)tp * 16 + 2 * x + lane] = lane == 0 ? yss : 0.f;
}

template <int WIN> __device__ __forceinline__ void pool_run(const bf16* U, bf16* Y, int b, int p0, int cp) {
    const unsigned* ub = (const unsigned*)(U + (size_t)b * SEQ * DM + 2 * cp);
    unsigned w[16 + WIN - 1];
#pragma unroll
    for (int i = 0; i < 16 + WIN - 1; ++i) { const int pos = p0 - (WIN - 1) + i; w[i] = pos >= 0 ? ub[(size_t)pos * (DM / 2)] : 0u; }
    float s0 = 0.f, s1 = 0.f;
#pragma unroll
    for (int i = 0; i < WIN - 1; ++i) { s0 += bflo(w[i]); s1 += bfhi(w[i]); }
    unsigned* yb = (unsigned*)(Y + (size_t)b * SEQ * DM + 2 * cp);
#pragma unroll
    for (int t = 0; t < 16; ++t) { const int pos = p0 + t; const float c0 = bflo(w[WIN - 1 + t]), c1 = bfhi(w[WIN - 1 + t]); s0 += c0; s1 += c1;
        const float inv = 1.0f / (float)(pos + 1 < WIN ? pos + 1 : WIN);
        yb[(size_t)pos * (DM / 2)] = pk2(s0 * inv - c0, s1 * inv - c1);
        s0 -= bflo(w[t]); s1 -= bfhi(w[t]); }
}
__device__ __forceinline__ void phase_pool(Ctx C, const Args& A) {
    PHASE_ENTER(C);
    const bf16* U = WSP(bf16, WS_U); bf16* Y = WSP(bf16, WS_A1);
    const int cp = C.tid & 255, th = C.tid >> 8, grp = (C.wave & 3);
    for (int it = C.bid; it < 1024; it += C.G) { const int b = it >> 8, p0 = (it & 255) * 32 + th * 16;
        if (grp == 0) pool_run<2>(U, Y, b, p0, cp); else if (grp == 1) pool_run<4>(U, Y, b, p0, cp); else if (grp == 2) pool_run<8>(U, Y, b, p0, cp); else pool_run<16>(U, Y, b, p0, cp); }
}
__device__ __forceinline__ void s5_wave_consts(const Ctx& C, int g, int lane, float& abr, float& abi, bf16x8 (&bfr)[8]) {
    const float* s5 = WSP(float, WS_S5C); const int idx = g * 64 + lane, fr = lane & 15, fq = lane >> 4;
    abr = s5[S5_ABAR / 4 + 2 * idx]; abi = s5[S5_ABAR / 4 + 2 * idx + 1];
    const bf16* BB = (const bf16*)(C.ws + WS_S5C + S5_BB16) + (size_t)g * 128 * 16;
#pragma unroll
    for (int ct = 0; ct < 8; ++ct) { bf16x8 z = {0, 0, 0, 0, 0, 0, 0, 0}; if (fq < 2) z = *(const bf16x8*)(BB + (16 * ct + fr) * 16 + 8 * fq); bfr[ct] = z; }
}
__device__ __forceinline__ void s5_bu_tile(const bf16x8 afr, const bf16x8 (&bfr)[8], LAS float* BUL, int fr, int fq) {
#pragma unroll
    for (int ct = 0; ct < 8; ++ct) { const f32x4 d = __builtin_amdgcn_mfma_f32_16x16x32_bf16(afr, bfr[ct], (f32x4){0.f, 0.f, 0.f, 0.f}, 0, 0, 0);
#pragma unroll
        for (int r = 0; r < 4; ++r) BUL[(4 * fq + r) * 132 + (ct >> 2) * 64 + (ct & 3) * 16 + fr] = d[r]; }
}
__device__ __forceinline__ void phase_s5_local(Ctx C, const Args& A) {
    PHASE_ENTER(C);
    const int lane = C.lane, fr = lane & 15, fq = lane >> 4; const int gw = C.bid * NWAVES + C.wave, NGW = C.G * NWAVES;
    LAS float* BUL = (LAS float*)(C.lds + C.wave * 8448);
    int gprev = -1; float abr = 0.f, abi = 0.f; bf16x8 bfr[8];
    for (int it = gw; it < 16384; it += NGW) { const int g = it & 31, bn = it >> 5;
        if (g != gprev) { s5_wave_consts(C, g, lane, abr, abi, bfr); gprev = g; }
        const bf16* ubase = WSP(bf16, WS_U) + (size_t)bn * 64 * DM + 512 + g * 16;
        bf16x8 afr[4];
#pragma unroll
        for (int sub = 0; sub < 4; ++sub) { bf16x8 z = {0, 0, 0, 0, 0, 0, 0, 0}; if (fq < 2) z = *(const bf16x8*)(ubase + (size_t)(sub * 16 + fr) * DM + 8 * fq); afr[sub] = z; }
        float xr = 0.f, xi = 0.f;
#pragma unroll
        for (int sub = 0; sub < 4; ++sub) {
            s5_bu_tile(afr[sub], bfr, BUL, fr, fq);
            asm volatile("s_waitcnt lgkmcnt(0)" ::: "memory");
#pragma unroll
            for (int tt = 0; tt < 16; ++tt) { const float br = BUL[tt * 132 + lane], bi = BUL[tt * 132 + 64 + lane]; const float nr = abr * xr - abi * xi + br, ni = abr * xi + abi * xr + bi; xr = nr; xi = ni; }
            asm volatile("s_waitcnt lgkmcnt(0)" ::: "memory");
        }
        float* e = WSP(float, WS_E) + ((size_t)(bn * 32 + g) * 64 + lane) * 2; e[0] = xr; e[1] = xi; }
}
__device__ __forceinline__ void phase_s5_carry(Ctx C, const Args& A) {
    PHASE_ENTER(C);
    for (int gid = C.bid * NTHREADS + C.tid; gid < 8192; gid += C.G * NTHREADS) { const int p = gid & 63, g = (gid >> 6) & 31, b = gid >> 11;
        const float* s5 = WSP(float, WS_S5C); const float ar = s5[S5_A64 / 4 + 2 * (g * 64 + p)], ai = s5[S5_A64 / 4 + 2 * (g * 64 + p) + 1];
        float2* e = (float2*)WSP(float, WS_E) + ((size_t)(b * 128) * 32 + g) * 64 + p; float cr = 0.f, ci = 0.f;
#pragma unroll 8
        for (int n = 0; n < NCHUNK; ++n) { const float2 tv = e[(size_t)n * 2048]; e[(size_t)n * 2048] = make_float2(cr, ci); const float nr = ar * cr - ai * ci + tv.x, ni = ar * ci + ai * cr + tv.y; cr = nr; ci = ni; } }
}
__device__ __forceinline__ void phase_s5_out(Ctx C, const Args& A) {
    PHASE_ENTER(C);
    const int lane = C.lane, fr = lane & 15, fq = lane >> 4; const int gw = C.bid * NWAVES + C.wave, NGW = C.G * NWAVES;
    LAS float* BUL = (LAS float*)(C.lds + C.wave * 12800);
    LAS bf16* XL = (LAS bf16*)(C.lds + C.wave * 12800 + 8448);
    int gprev = -1; float abr = 0.f, abi = 0.f; bf16x8 bfr[8]; bf16x8 cm[4]; float dsk = 0.f;
    for (int it = gw; it < 16384; it += NGW) { const int g = it & 31, bn = it >> 5;
        if (g != gprev) { s5_wave_consts(C, g, lane, abr, abi, bfr); gprev = g;
            const bf16* CM = (const bf16*)(C.ws + WS_S5C + S5_CM) + (size_t)(g * 16 + fr) * 128;
#pragma unroll
            for (int kk = 0; kk < 4; ++kk) cm[kk] = *(const bf16x8*)(CM + kk * 32 + 8 * fq);
            dsk = IN(I_DSK)[g * 16 + fr]; }
        const bf16* ubase = WSP(bf16, WS_U) + (size_t)bn * 64 * DM + 512 + g * 16;
        bf16x8 afr[4];
#pragma unroll
        for (int sub = 0; sub < 4; ++sub) { bf16x8 z = {0, 0, 0, 0, 0, 0, 0, 0}; if (fq < 2) z = *(const bf16x8*)(ubase + (size_t)(sub * 16 + fr) * DM + 8 * fq); afr[sub] = z; }
        const float* e = WSP(float, WS_E) + ((size_t)(bn * 32 + g) * 64 + lane) * 2; float xr = e[0], xi = e[1];
        unsigned short uskip[4][4];
#pragma unroll
        for (int sub = 0; sub < 4; ++sub)
#pragma unroll
            for (int r = 0; r < 4; ++r) uskip[sub][r] = ubase[(size_t)(sub * 16 + 4 * fq + r) * DM + fr];
#pragma unroll
        for (int sub = 0; sub < 4; ++sub) {
            s5_bu_tile(afr[sub], bfr, BUL, fr, fq);
            asm volatile("s_waitcnt lgkmcnt(0)" ::: "memory");
#pragma unroll
            for (int tt = 0; tt < 16; ++tt) { const float br = BUL[tt * 132 + lane], bi = BUL[tt * 132 + 64 + lane]; const float nr = abr * xr - abi * xi + br, ni = abr * xi + abi * xr + bi; xr = nr; xi = ni;
                XL[tt * 136 + lane] = (bf16)f2bf(xr); XL[tt * 136 + 64 + lane] = (bf16)f2bf(xi); }
            asm volatile("s_waitcnt lgkmcnt(0)" ::: "memory");
            f32x4 acc = (f32x4){0.f, 0.f, 0.f, 0.f};
#pragma unroll
            for (int kk = 0; kk < 4; ++kk) { const bf16x8 a = *(const LAS bf16x8*)(XL + fr * 136 + kk * 32 + 8 * fq); acc = __builtin_amdgcn_mfma_f32_16x16x32_bf16(a, cm[kk], acc, 0, 0, 0); }
#pragma unroll
            for (int r = 0; r < 4; ++r) { const size_t tok = (size_t)bn * 64 + sub * 16 + 4 * fq + r; const float uv = bf2f(uskip[sub][r]);
                WSP(bf16, WS_Z)[tok * 512 + g * 16 + fr] = (bf16)f2bf(gelu1(acc[r] + dsk * uv)); }
            asm volatile("s_waitcnt lgkmcnt(0)" ::: "memory");
        } }
}
__device__ __forceinline__ void phase_final_norm(Ctx C, const Args& A, const bf16* hin) {
    PHASE_ENTER(C);
    const int lane = C.lane; const int gw = C.bid * NWAVES + C.wave, NGW = C.G * NWAVES; const f32x4* wv = (const f32x4*)IN(I_FNW) + 4 * lane;
#pragma unroll 4
    for (int m = gw; m < NT; m += NGW) { const v4u* hr = (const v4u*)(hin + (size_t)m * DM + 16 * lane); f32x4 v[4]; float s = 0.f;
#pragma unroll
        for (int c = 0; c < 2; ++c) { const v4u hw = hr[c]; v[2 * c] = (f32x4){bflo(hw[0]), bfhi(hw[0]), bflo(hw[1]), bfhi(hw[1])}; v[2 * c + 1] = (f32x4){bflo(hw[2]), bfhi(hw[2]), bflo(hw[3]), bfhi(hw[3])}; }
#pragma unroll
        for (int j = 0; j < 4; ++j) s += (v[j][0] * v[j][0] + v[j][1] * v[j][1]) + (v[j][2] * v[j][2] + v[j][3] * v[j][3]);
        const float rs = 1.0f / sqrtf(wave_sum(s) * (1.0f / DM) + EPS);
        f32x4* o = (f32x4*)(C.h + (size_t)m * DM + 16 * lane);
#pragma unroll
        for (int j = 0; j < 4; ++j) o[j] = v[j] * rs * wv[j]; }
}

constexpr int CW_BAR = 1024;

__global__ void __launch_bounds__(NTHREADS, 2) mk_fwd(Args A) {
    extern __shared__ __attribute__((aligned(16))) unsigned char lds_raw[];
    Ctx C;
    C.lds = (LAS unsigned char*)lds_raw; C.tid = threadIdx.x; C.lane = C.tid & 63; C.wave = __builtin_amdgcn_readfirstlane(C.tid >> 6); C.G = gridDim.x; C.bid = blockIdx.x;
    C.h = A.out; C.ws = A.ws;
    volatile LAS unsigned* MISC = (volatile LAS unsigned*)(C.lds + MISC_OFF);
    for (int u = C.tid; u < (LDS_BYTES - RING_BYTES) / 4; u += NTHREADS) ((LAS unsigned*)(C.lds + RING_BYTES))[u] = 0u;
    __syncthreads();
    if (C.tid == 0) {
#pragma unroll
        for (int i = 0; i < N_IN; ++i) ((LAS unsigned long long*)(C.lds + PTR_OFF))[i] = (unsigned long long)A.in[i];
    }
    __syncthreads();
    XcdBarrier bar = xcd_barrier_post((unsigned*)(C.ws + WS_CTL) + CW_BAR, MISC + 8);
#define GBAR() xcd_barrier(bar)
#define FRESH() do { asm volatile("" : "+s"(C.ws), "+s"(C.h)); C.ws = (unsigned char*)(GAS unsigned char*)C.ws; C.h = (float*)(GAS float*)C.h; } while (0)
#define GEMM(EpiT, E, Ap, Bp, Mv, Nv, Kv) do { pg8::Gemm g_{(const pg8::bf16_t*)(Ap), (const pg8::bf16_t*)(Bp), Mv, Nv, Kv}; pg8::StaticOrder S_; S_.init(Mv, Nv, C.G, C.bid); \
        pg8::gemm_phase<EpiT, pg8::StaticOrder, true, true>(C.lds, g_, S_, E); } while (0)
    float* SSQ0 = WSP(float, WS_SSQ0); float* SSQ1 = WSP(float, WS_SSQ1);
    bf16* A0 = WSP(bf16, WS_A0); bf16* A1 = WSP(bf16, WS_A1);

#ifndef PROBE_MASK
#define PROBE_MASK 0
#endif
#define REP(k) for (int rep_ = 0; rep_ < (((PROBE_MASK) >> (k)) & 1 ? 2 : 1); ++rep_)
    REP(4) phase_prologue(C, A);
    GBAR();
    REP(0) { FRESH(); { pg8::EpiBf16<0> E{(pg8::bf16_t*)WSP(bf16, WS_PROJ), PROJW, nullptr, 0, 0, 1.f}; GEMM(pg8::EpiBf16<0>, E, A0, WSP(bf16, WS_WIN0), NT, PROJW, DM); } }
    GBAR();
    REP(1) phase_kv(C, A);
    GBAR();
    phase_scan(C, A); GBAR();
    REP(1) phase_mix0_out(C, A);
    GBAR();
    REP(0) { FRESH(); { pg8::EpiRes E{IN(I_X), nullptr, (pg8::bf16_t*)A0, SSQ0, C.ws + WS_XQ}; GEMM(pg8::EpiRes, E, A1, WSP(bf16, WS_WOUT0), NT, DM, DM); } }
    GBAR();
    REP(0) { FRESH(); { pg8::EpiScaleBf16 E{(pg8::bf16_t*)WSP(bf16, WS_SC), 2048, SSQ0}; GEMM(pg8::EpiScaleBf16, E, A0, WSP(bf16, WS_WEFF) + (size_t)0 * 2048 * 1024, NT, 2048, DM); } }
    GBAR();
    REP(2) phase_topk(C, A);
    REP(5) phase_convert_peer(C, A, 0, 0, C.G);
    GBAR();
    REP(8) phase_experts_u(C, A);
    GBAR();
    REP(9) phase_experts_v(C, A, A0, A1, SSQ1);
    __syncthreads();
    REP(0) { FRESH(); { pg8::EpiBf16<0> E{(pg8::bf16_t*)WSP(bf16, WS_PP), DM, nullptr, 0, 0, 1.f}; GEMM(pg8::EpiBf16<0>, E, WSP(bf16, WS_PB), WSP(bf16, WS_WP) + (size_t)0 * 1024 * 256, NT, DM, 256); } }
    GBAR();
    FRESH(); { pg8::EpiPle E{(const pg8::bf16_t*)A1, (const pg8::bf16_t*)WSP(bf16, WS_PP), (pg8::bf16_t*)A0, SSQ1, SSQ0}; GEMM(pg8::EpiPle, E, A1, WSP(bf16, WS_WG) + (size_t)0 * 1024 * 1024, NT, DM, DM); }
    GBAR();

    REP(0) { FRESH(); { pg8::EpiScaleBf16 E{(pg8::bf16_t*)WSP(bf16, WS_U), DM, SSQ0}; GEMM(pg8::EpiScaleBf16, E, A0, WSP(bf16, WS_WIN1), NT, DM, DM); } }
    GBAR();
    REP(6) { phase_s5_local(C, A); phase_pool(C, A); }
    GBAR();
    phase_s5_carry(C, A);
    phase_convert_peer(C, A, 1, 16, C.G - 16); GBAR();
    REP(7) phase_s5_out(C, A);
    GBAR();
    REP(0) { FRESH(); { pg8::EpiGlu E{(const pg8::bf16_t*)WSP(bf16, WS_Z), 512, IN(I_BGLU), (pg8::bf16_t*)A1, DM, 512}; GEMM(pg8::EpiGlu, E, WSP(bf16, WS_Z), WSP(bf16, WS_WGLU), NT, 512, 512); } }
    GBAR();
    FRESH(); { pg8::EpiRes E{nullptr, (const pg8::bf16_t*)A0, (pg8::bf16_t*)A0, SSQ0, C.ws + WS_XQ}; GEMM(pg8::EpiRes, E, A1, WSP(bf16, WS_WOUT1), NT, DM, DM); }
    GBAR();

    REP(0) { FRESH(); { pg8::EpiScaleBf16 E{(pg8::bf16_t*)WSP(bf16, WS_SC), 2048, SSQ0}; GEMM(pg8::EpiScaleBf16, E, A0, WSP(bf16, WS_WEFF) + (size_t)1 * 2048 * 1024, NT, 2048, DM); } }
    GBAR();
    REP(2) phase_topk(C, A);
    GBAR();
    REP(8) phase_experts_u(C, A);
    GBAR();
    REP(9) phase_experts_v(C, A, A0, A1, SSQ1);
    __syncthreads();
    REP(0) { FRESH(); { pg8::EpiBf16<0> E{(pg8::bf16_t*)WSP(bf16, WS_PP), DM, nullptr, 0, 0, 1.f}; GEMM(pg8::EpiBf16<0>, E, WSP(bf16, WS_PB), WSP(bf16, WS_WP) + (size_t)1 * 1024 * 256, NT, DM, 256); } }
    GBAR();
    FRESH(); { pg8::EpiPle E{(const pg8::bf16_t*)A1, (const pg8::bf16_t*)WSP(bf16, WS_PP), (pg8::bf16_t*)A0, SSQ1, SSQ0}; GEMM(pg8::EpiPle, E, A1, WSP(bf16, WS_WG) + (size_t)1 * 1024 * 1024, NT, DM, DM); }
    GBAR();

    phase_final_norm(C, A, A0);
}

extern "C" void kernel_launch(void* const* d_in, const int* in_sizes, int n_in, void* d_out, int out_size, void* d_ws, size_t ws_size, hipStream_t stream) {
    static int grid = 0;
    if (grid == 0) {
        if (n_in != N_IN || out_size != NT * DM || ws_size < WS_END) { fprintf(stderr, "kernel_launch: unexpected shapes (n_in %d, out %d, ws %zu, need %zu)\n", n_in, out_size, ws_size, (size_t)WS_END); grid = -1; return; }
        int dev = 0, cus = 0, per_cu = 0;
        if (hipGetDevice(&dev) != hipSuccess || hipDeviceGetAttribute(&cus, hipDeviceAttributeMultiprocessorCount, dev) != hipSuccess) { grid = -1; return; }
        if (hipFuncSetAttribute((const void*)mk_fwd, hipFuncAttributeMaxDynamicSharedMemorySize, LDS_BYTES) != hipSuccess) { fprintf(stderr, "kernel_launch: hipFuncSetAttribute failed\n"); grid = -1; return; }
        if (hipOccupancyMaxActiveBlocksPerMultiprocessor(&per_cu, (const void*)mk_fwd, NTHREADS, LDS_BYTES) != hipSuccess || per_cu < 1) { fprintf(stderr, "kernel_launch: occupancy query says %d blocks per CU\n", per_cu); grid = -1; return; }
        grid = cus;
    }
    if (grid < 0) return;
    if (hipMemsetAsync((char*)d_ws + WS_CTL, 0, CTL_ZERO_BYTES, stream) != hipSuccess) return;
    Args a{};
    for (int i = 0; i < N_IN; ++i) a.in[i] = d_in[i];
    a.out = (float*)d_out; a.ws = (unsigned char*)d_ws;
    void* kargs[] = {&a};
    const hipError_t le = hipLaunchCooperativeKernel((const void*)mk_fwd, dim3(grid), dim3(NTHREADS), kargs, LDS_BYTES, stream);
    if (le != hipSuccess) fprintf(stderr, "kernel_launch: cooperative launch failed: %s (grid %d)\n", hipGetErrorString(le), grid);
}
```

```cpp
#include <hip/hip_runtime.h>
#include <hip/hip_cooperative_groups.h>
#include <cstdio>
#include <cstdint>
namespace cg = cooperative_groups;
namespace pg8 {
#define PG8_LAS __attribute__((address_space(3)))
typedef unsigned short bf16_t;
typedef short bf16x8 __attribute__((ext_vector_type(8)));
typedef float f32x4 __attribute__((ext_vector_type(4)));
typedef unsigned u32x4 __attribute__((ext_vector_type(4)));
constexpr int BM = 256, BK = 64, HALF = 128, HTB = HALF * BK * 2  , STAGE_BYTES = 8 * HTB, NXCD = 8, WGM = 8;

__host__ __device__ __forceinline__ int lds_byte(int r, int c) { const int st = (r >> 4) * 2 + (c >> 5), rr = r & 15, cc = c & 31, ob = rr * 64 + cc * 2; return st * 1024 + (ob ^ (((ob >> 9) & 1) << 5)); }
__host__ __device__ __forceinline__ void stage_rc(int b, int& R, int& C) { const int st = b / 1024, sb = b % 1024, swz = sb ^ (((sb >> 9) & 1) << 5); R = (st >> 1) * 16 + swz / 64; C = (st & 1) * 32 + (swz % 64) / 2; }
__host__ __device__ __forceinline__ int perm32(int rho) { const int n = rho >> 4, i = rho & 15; return 8 * (i >> 2) + 4 * n + (i & 3); }

struct Unit { int pm, pn; };
struct Gemm { const bf16_t* A; const bf16_t* Bt; int M, N, K; };

struct StaticOrder {
    int nM, nN, nwg, G, c;
    __host__ __device__ void init(int M, int N, int G_, int c_) { nM = M / BM; nN = N / BM; nwg = nM * nN; G = G_; c = c_; }
    __host__ __device__ bool next(int i, Unit& u) const {
        const long L = (long)i * G + c; if (L >= nwg) return false;
        int wgid = (int)L; { const int q = nwg / NXCD, r = nwg % NXCD, xcd = wgid % NXCD, off = wgid / NXCD; wgid = (xcd < r ? xcd * (q + 1) : r * (q + 1) + (xcd - r) * q) + off; }
        const int nig = WGM * nN, gid = wgid / nig, fm = gid * WGM, gsz = (nM - fm) < WGM ? (nM - fm) : WGM;
        u.pm = fm + ((wgid % nig) % gsz); u.pn = (wgid % nig) / gsz; return true;
    }
    __device__ __forceinline__ void a_ready(const Unit&) const {}
    __device__ __forceinline__ void done(const Unit&) const {}
};

__device__ __forceinline__ unsigned cvt_pk_bf16(float lo, float hi) { unsigned r; asm volatile("v_cvt_pk_bf16_f32 %0, %1, %2" : "=v"(r) : "v"(lo), "v"(hi)); return r; }
typedef float f32x2 __attribute__((ext_vector_type(2)));
__device__ __forceinline__ f32x2 gelu_pk(f32x2 v) {
    const f32x2 av = __builtin_elementwise_abs(v), d = av * 0.2316418882f + 1.0f;
    f32x2 t; t.x = __builtin_amdgcn_rcpf(d.x); t.y = __builtin_amdgcn_rcpf(d.y);
    f32x2 q = t * 0.5307027145f + (-0.7265760135f); q = q * t + 0.7107068705f; q = q * t + (-0.142248368f); q = q * t + 0.127414796f; q = q * t;
    const f32x2 s = (v * v) * (-0.72134752044f);
    f32x2 e; e.x = __builtin_amdgcn_exp2f(s.x); e.y = __builtin_amdgcn_exp2f(s.y);
    const f32x2 m = v * (q * e), r = v - m;
    f32x2 o; o.x = v.x < 0.f ? m.x : r.x; o.y = v.y < 0.f ? m.y : r.y; return o;
}

template <int ACT  > struct EpiBf16 {
    static constexpr bool PERM = true, AFTER_DRAIN = false; static_assert(ACT == 0 || ACT == 1, "EpiBf16: ACT is 0 (none) or 1 (gelu_pk)");
    bf16_t* O; int ldc; const float* bias; int split_cols; size_t split_stride; float scale0;
    __device__ __forceinline__ void operator()(const f32x4 (&acc)[2][2][4][2], const Unit& u, int wr, int wc, int fr, int fq) const {
        const int row0 = u.pm * BM + wr * 64 + fr; int colt = u.pn * BM; bf16_t* base = O;
        float sc = 1.f; if (split_cols) { const int t = colt / split_cols; base += (size_t)t * split_stride; colt -= t * split_cols; if (t == 0) sc = scale0; }
        const int col0 = colt + wc * 32 + 8 * fq, bcol0 = u.pn * BM + wc * 32 + 8 * fq;
        f32x4 bv[2][2];
#pragma unroll
        for (int bj = 0; bj < 2; ++bj)
#pragma unroll
            for (int n = 0; n < 2; ++n) bv[bj][n] = bias ? *(const f32x4*)(bias + bcol0 + bj * HALF + 4 * n) : (f32x4){0.f, 0.f, 0.f, 0.f};
#pragma unroll
        for (int ai = 0; ai < 2; ++ai)
#pragma unroll
            for (int m = 0; m < 4; ++m) { bf16_t* rowp = base + (size_t)(row0 + ai * HALF + m * 16) * ldc + col0;
#pragma unroll
                for (int bj = 0; bj < 2; ++bj) { f32x4 v0 = acc[ai][bj][m][0] + bv[bj][0], v1 = acc[ai][bj][m][1] + bv[bj][1];
                    if (ACT == 1) { f32x2 a = gelu_pk((f32x2){v0[0], v0[1]}), b = gelu_pk((f32x2){v0[2], v0[3]}), c = gelu_pk((f32x2){v1[0], v1[1]}), d = gelu_pk((f32x2){v1[2], v1[3]});
                        v0 = (f32x4){a.x, a.y, b.x, b.y}; v1 = (f32x4){c.x, c.y, d.x, d.y}; }
                    v0 = v0 * sc; v1 = v1 * sc; u32x4 w; w.x = cvt_pk_bf16(v0[0], v0[1]); w.y = cvt_pk_bf16(v0[2], v0[3]); w.z = cvt_pk_bf16(v1[0], v1[1]); w.w = cvt_pk_bf16(v1[2], v1[3]);
                    *(u32x4*)(rowp + bj * HALF) = w; } }
    }
};

__device__ __forceinline__ float row_rstd(const float* ssq, int row) {
    const f32x4* p = (const f32x4*)(ssq + (size_t)row * 16);
    const f32x4 a = p[0], b = p[1], c = p[2], d = p[3];
    const float s = (((a[0] + a[1]) + (a[2] + a[3])) + ((b[0] + b[1]) + (b[2] + b[3]))) + (((c[0] + c[1]) + (c[2] + c[3])) + ((d[0] + d[1]) + (d[2] + d[3])));
    return 1.0f / sqrtf(s * (1.0f / 1024.0f) + 1e-6f);
}
__device__ __forceinline__ float sigmoidf_(float x) { return __builtin_amdgcn_rcpf(1.0f + __expf(-x)); }
typedef unsigned u32x2 __attribute__((ext_vector_type(2)));

struct EpiRes {
    static constexpr bool PERM = false, AFTER_DRAIN = false;
    const float* base32; const bf16_t* base16; bf16_t* hb; float* ssq; unsigned char* xq8;
    __device__ __forceinline__ void operator()(const f32x4 (&acc)[2][2][4][2], const Unit& u, int wr, int wc, int fr, int fq) const {
        const int row0 = u.pm * BM + wr * 64 + fr, col0 = u.pn * BM + wc * 32 + 4 * fq;
#pragma unroll
        for (int ai = 0; ai < 2; ++ai)
#pragma unroll
            for (int m = 0; m < 4; ++m) { const int row = row0 + ai * HALF + m * 16; const size_t off = (size_t)row * 1024 + col0; float ss = 0.f;
#pragma unroll
                for (int bj = 0; bj < 2; ++bj)
#pragma unroll
                    for (int n = 0; n < 2; ++n) { const size_t o2 = off + bj * HALF + n * 16; f32x4 b;
                        if (base32) b = *(const f32x4*)(base32 + o2);
                        else { const u32x2 bw = *(const u32x2*)(base16 + o2); b = (f32x4){__uint_as_float(bw.x << 16), __uint_as_float(bw.x & 0xffff0000u), __uint_as_float(bw.y << 16), __uint_as_float(bw.y & 0xffff0000u)}; }
                        const f32x4 o = b + acc[ai][bj][m][n];
                        ss += (o[0] * o[0] + o[1] * o[1]) + (o[2] * o[2] + o[3] * o[3]);
                        u32x2 w; w.x = cvt_pk_bf16(o[0], o[1]); w.y = cvt_pk_bf16(o[2], o[3]); *(u32x2*)(hb + o2) = w;
                        int w8 = __builtin_amdgcn_cvt_pk_fp8_f32(o[0], o[1], 0, false); w8 = __builtin_amdgcn_cvt_pk_fp8_f32(o[2], o[3], w8, true); *(unsigned*)(xq8 + o2) = (unsigned)w8; }
                ss += __shfl_xor(ss, 16); ss += __shfl_xor(ss, 32);
                if (fq == 0) ssq[(size_t)row * 16 + u.pn * 4 + wc] = ss; }
    }
};
struct EpiScaleF32 {
    static constexpr bool PERM = false, AFTER_DRAIN = false;
    float* C; int ldc; const float* ssq;
    __device__ __forceinline__ void operator()(const f32x4 (&acc)[2][2][4][2], const Unit& u, int wr, int wc, int fr, int fq) const {
        const int row0 = u.pm * BM + wr * 64 + fr, col0 = u.pn * BM + wc * 32 + 4 * fq;
#pragma unroll
        for (int ai = 0; ai < 2; ++ai)
#pragma unroll
            for (int m = 0; m < 4; ++m) { const int row = row0 + ai * HALF + m * 16; const float rs = row_rstd(ssq, row); float* rowp = C + (size_t)row * ldc + col0;
#pragma unroll
                for (int bj = 0; bj < 2; ++bj)
#pragma unroll
                    for (int n = 0; n < 2; ++n) *(f32x4*)(rowp + bj * HALF + n * 16) = acc[ai][bj][m][n] * rs; }
    }
};
struct EpiScaleBf16 {
    static constexpr bool PERM = false, AFTER_DRAIN = false;
    bf16_t* O; int ldc; const float* ssq;
    __device__ __forceinline__ void operator()(const f32x4 (&acc)[2][2][4][2], const Unit& u, int wr, int wc, int fr, int fq) const {
        const int row0 = u.pm * BM + wr * 64 + fr, col0 = u.pn * BM + wc * 32 + 4 * fq;
#pragma unroll
        for (int ai = 0; ai < 2; ++ai)
#pragma unroll
            for (int m = 0; m < 4; ++m) { const int row = row0 + ai * HALF + m * 16; const float rs = row_rstd(ssq, row); bf16_t* rowp = O + (size_t)row * ldc + col0;
#pragma unroll
                for (int bj = 0; bj < 2; ++bj)
#pragma unroll
                    for (int n = 0; n < 2; ++n) { const f32x4 o = acc[ai][bj][m][n] * rs; u32x2 w; w.x = cvt_pk_bf16(o[0], o[1]); w.y = cvt_pk_bf16(o[2], o[3]); *(u32x2*)(rowp + bj * HALF + n * 16) = w; } }
    }
};
__device__ __forceinline__ unsigned bf16x2_keys(unsigned w) { const unsigned m = (w >> 15) & 0x00010001u; return w ^ ((m * 0xFFFFu) | 0x80008000u); }
struct EpiScoreKey {
    static constexpr bool PERM = false, AFTER_DRAIN = false;
    bf16_t* O; int ldc; const float* ssq;
    __device__ __forceinline__ void operator()(const f32x4 (&acc)[2][2][4][2], const Unit& u, int wr, int wc, int fr, int fq) const {
        const int row0 = u.pm * BM + wr * 64 + fr, col0 = u.pn * BM + wc * 32 + 4 * fq;
#pragma unroll
        for (int ai = 0; ai < 2; ++ai)
#pragma unroll
            for (int m = 0; m < 4; ++m) { const int row = row0 + ai * HALF + m * 16; const float rs = row_rstd(ssq, row); bf16_t* rowp = O + (size_t)row * ldc + col0;
#pragma unroll
                for (int bj = 0; bj < 2; ++bj)
#pragma unroll
                    for (int n = 0; n < 2; ++n) { const f32x4 o = acc[ai][bj][m][n] * rs; u32x2 w; w.x = bf16x2_keys(cvt_pk_bf16(o[0], o[1])); w.y = bf16x2_keys(cvt_pk_bf16(o[2], o[3])); *(u32x2*)(rowp + bj * HALF + n * 16) = w; } }
    }
};
struct EpiPle {
    static constexpr bool PERM = false, AFTER_DRAIN = false;
    const bf16_t* hin; const bf16_t* pp; bf16_t* hb; const float* ssq_in; float* ssq_out;
    __device__ __forceinline__ void operator()(const f32x4 (&acc)[2][2][4][2], const Unit& u, int wr, int wc, int fr, int fq) const {
        const int row0 = u.pm * BM + wr * 64 + fr, col0 = u.pn * BM + wc * 32 + 4 * fq;
#pragma unroll
        for (int ai = 0; ai < 2; ++ai)
#pragma unroll
            for (int m = 0; m < 4; ++m) { const int row = row0 + ai * HALF + m * 16; const float rs = row_rstd(ssq_in, row); const size_t off = (size_t)row * 1024 + col0; float ss = 0.f;
#pragma unroll
                for (int bj = 0; bj < 2; ++bj)
#pragma unroll
                    for (int n = 0; n < 2; ++n) { const size_t o2 = off + bj * HALF + n * 16; const f32x4 a = acc[ai][bj][m][n] * rs; const u32x2 pw = *(const u32x2*)(pp + o2); const u32x2 hw = *(const u32x2*)(hin + o2);
                        f32x4 o;
                        o[0] = __uint_as_float(hw.x << 16) + __uint_as_float(pw.x << 16) * sigmoidf_(a[0]); o[1] = __uint_as_float(hw.x & 0xffff0000u) + __uint_as_float(pw.x & 0xffff0000u) * sigmoidf_(a[1]);
                        o[2] = __uint_as_float(hw.y << 16) + __uint_as_float(pw.y << 16) * sigmoidf_(a[2]); o[3] = __uint_as_float(hw.y & 0xffff0000u) + __uint_as_float(pw.y & 0xffff0000u) * sigmoidf_(a[3]);
                        ss += (o[0] * o[0] + o[1] * o[1]) + (o[2] * o[2] + o[3] * o[3]);
                        u32x2 w; w.x = cvt_pk_bf16(o[0], o[1]); w.y = cvt_pk_bf16(o[2], o[3]); *(u32x2*)(hb + o2) = w; }
                ss += __shfl_xor(ss, 16); ss += __shfl_xor(ss, 32);
                if (fq == 0) ssq_out[(size_t)row * 16 + u.pn * 4 + wc] = ss; }
    }
};
struct EpiGlu {
    static constexpr bool PERM = false, AFTER_DRAIN = false;
    const bf16_t* Z; int ldz; const float* bias; bf16_t* O; int ldo; int ocol0;
    __device__ __forceinline__ void operator()(const f32x4 (&acc)[2][2][4][2], const Unit& u, int wr, int wc, int fr, int fq) const {
        const int row0 = u.pm * BM + wr * 64 + fr, col0 = u.pn * BM + wc * 32 + 4 * fq;
        f32x4 bv[2][2];
#pragma unroll
        for (int bj = 0; bj < 2; ++bj)
#pragma unroll
            for (int n = 0; n < 2; ++n) bv[bj][n] = *(const f32x4*)(bias + col0 + bj * HALF + n * 16);
#pragma unroll
        for (int ai = 0; ai < 2; ++ai)
#pragma unroll
            for (int m = 0; m < 4; ++m) { const int row = row0 + ai * HALF + m * 16;
#pragma unroll
                for (int bj = 0; bj < 2; ++bj)
#pragma unroll
                    for (int n = 0; n < 2; ++n) { const int col = col0 + bj * HALF + n * 16; const f32x4 a = acc[ai][bj][m][n] + bv[bj][n]; const u32x2 zw = *(const u32x2*)(Z + (size_t)row * ldz + col);
                        const float o0 = __uint_as_float(zw.x << 16) * sigmoidf_(a[0]), o1 = __uint_as_float(zw.x & 0xffff0000u) * sigmoidf_(a[1]);
                        const float o2 = __uint_as_float(zw.y << 16) * sigmoidf_(a[2]), o3 = __uint_as_float(zw.y & 0xffff0000u) * sigmoidf_(a[3]);
                        u32x2 w; w.x = cvt_pk_bf16(o0, o1); w.y = cvt_pk_bf16(o2, o3); *(u32x2*)(O + (size_t)row * ldo + ocol0 + col) = w; } }
    }
};
template <class Epi, class Sched, bool ALIGN_EPI = false, bool SP2 = false>
__device__ __forceinline__ void gemm_phase(PG8_LAS unsigned char* lds, const Gemm g, const Sched& S, const Epi& E) {
    int tid_o = threadIdx.x; asm volatile("" : "+v"(tid_o));
    const int tid = tid_o, wid = __builtin_amdgcn_readfirstlane(tid >> 6), lane = tid & 63, wr = wid >> 2, wc = wid & 3, fr = lane & 15, fq = lane >> 4;
    const int K = g.K, nt = K / BK;
    unsigned voffA[2], voffB[2];
#pragma unroll
    for (int i = 0; i < 2; ++i) { int R, C; stage_rc(tid * 16 + i * 8192, R, C); const int Rb = Epi::PERM ? ((R & ~31) + perm32(R & 31)) : R;
        voffA[i] = (unsigned)(R * K + C) * 2u; voffB[i] = (unsigned)(Rb * K + C) * 2u; }
    const size_t kstep = (size_t)(BK * 2);
    const size_t hstep = (size_t)HALF * K * 2;
    const size_t tstep = 2 * hstep;
    const unsigned ldsw = (unsigned)wid * 1024u;
    const int aoff = lds_byte(wr * 64 + fr, fq * 8), boff = lds_byte(wc * 32 + fr, fq * 8);
#define PG8_SA(b, h) (((b) * 2 + (h)) * HTB)
#define PG8_SB(b, h) ((4 + (b) * 2 + (h)) * HTB)
#define PG8_STAGE(bufoff, gbase, voff) do { _Pragma("unroll") for (int _i = 0; _i < 2; ++_i) \
        __builtin_amdgcn_global_load_lds((const unsigned*)((const char*)(gbase) + (voff)[_i]), (PG8_LAS unsigned*)(lds + (bufoff) + ldsw + _i * 8192), 16, 0, 0); } while (0)
#define PG8_LDA(dst, b, h) do { _Pragma("unroll") for (int m = 0; m < 4; ++m) _Pragma("unroll") for (int k = 0; k < 2; ++k) dst[m][k] = *(const PG8_LAS bf16x8*)(lds + PG8_SA(b, h) + aoff + m * 2048 + k * 1024); } while (0)
#define PG8_LDB(dst, b, h) do { _Pragma("unroll") for (int n = 0; n < 2; ++n) _Pragma("unroll") for (int k = 0; k < 2; ++k) dst[n][k] = *(const PG8_LAS bf16x8*)(lds + PG8_SB(b, h) + boff + n * 2048 + k * 1024); } while (0)
#define PG8_MMA(ai, bj, At, Bt) do { __builtin_amdgcn_s_setprio(1); _Pragma("unroll") for (int m = 0; m < 4; ++m) _Pragma("unroll") for (int n = 0; n < 2; ++n) _Pragma("unroll") for (int k = 0; k < 2; ++k) \
        acc[ai][bj][m][n] = __builtin_amdgcn_mfma_f32_16x16x32_bf16(Bt[n][k], At[m][k], acc[ai][bj][m][n], 0, 0, 0); __builtin_amdgcn_s_setprio(0); } while (0)
#define PG8_WAIT_V(n) asm volatile("s_waitcnt vmcnt(" #n ")" ::: "memory")
#define PG8_WAIT_L(n) asm volatile("s_waitcnt lgkmcnt(" #n ")" ::: "memory")
#define PG8_BAR __builtin_amdgcn_s_barrier()
#define PG8_SCHED __builtin_amdgcn_sched_barrier(0)
    Unit cur, nxt; int ui = 0;
    if (!S.next(0, cur)) return;
    f32x4 acc[2][2][4][2];
#pragma unroll
    for (int a = 0; a < 2; ++a)
#pragma unroll
        for (int b = 0; b < 2; ++b)
#pragma unroll
            for (int m = 0; m < 4; ++m)
#pragma unroll
                for (int n = 0; n < 2; ++n) acc[a][b][m][n] = (f32x4){0.f, 0.f, 0.f, 0.f};
    bf16x8 At[4][2], B0[2][2], B1[2][2];
    const char* cA = (const char*)g.A + (size_t)cur.pm * tstep; const char* cB = (const char*)g.Bt + (size_t)cur.pn * tstep;
    S.a_ready(cur);
    if constexpr (SP2) {
        PG8_STAGE(PG8_SB(0, 0), cB, voffB); PG8_STAGE(PG8_SB(0, 1), cB + hstep, voffB); PG8_STAGE(PG8_SA(0, 0), cA, voffA); PG8_STAGE(PG8_SA(0, 1), cA + hstep, voffA);
        if (wr == 1) PG8_BAR;
        PG8_WAIT_V(2); PG8_BAR;
        PG8_STAGE(PG8_SB(1, 0), cB + kstep, voffB); PG8_STAGE(PG8_SA(1, 0), cA + kstep, voffA); PG8_STAGE(PG8_SB(1, 1), cB + hstep + kstep, voffB);
        PG8_WAIT_V(6); PG8_BAR;
    } else {
        PG8_STAGE(PG8_SB(0, 0), cB, voffB); PG8_STAGE(PG8_SA(0, 0), cA, voffA); PG8_STAGE(PG8_SB(0, 1), cB + hstep, voffB); PG8_STAGE(PG8_SA(0, 1), cA + hstep, voffA);
        if (wr == 1) PG8_BAR;
        PG8_WAIT_V(4); PG8_BAR;
        PG8_STAGE(PG8_SB(1, 0), cB + kstep, voffB); PG8_STAGE(PG8_SA(1, 0), cA + kstep, voffA); PG8_STAGE(PG8_SB(1, 1), cB + hstep + kstep, voffB);
        PG8_WAIT_V(6); PG8_BAR;
    }
    for (;;) {
        const bool has_next = S.next(ui + 1, nxt);
        const char* nA = has_next ? (const char*)g.A + (size_t)nxt.pm * tstep : cA; const char* nB = has_next ? (const char*)g.Bt + (size_t)nxt.pn * tstep : cB;
        for (int t = 0; t < nt; t += 2) {
            const bool last = (t == nt - 2);
            const char* a1 = cA + (size_t)(t + 1) * kstep;
            const char* a2 = last ? nA : cA + (size_t)(t + 2) * kstep; const char* b2 = last ? nB : cB + (size_t)(t + 2) * kstep;
            const char* a3 = a2 + kstep; const char* b3 = b2 + kstep;
            if (last && has_next) S.a_ready(nxt);
            if constexpr (SP2) {
            PG8_LDB(B0, 0, 0); PG8_LDB(B1, 0, 1); PG8_SCHED; PG8_LDA(At, 0, 0); PG8_STAGE(PG8_SA(1, 1), a1 + hstep, voffA);
            PG8_WAIT_V(8); PG8_WAIT_L(0); PG8_BAR; PG8_MMA(0, 0, At, B0); PG8_MMA(0, 1, At, B1); PG8_BAR; PG8_SCHED;
            PG8_LDA(At, 0, 1); PG8_STAGE(PG8_SB(0, 0), b2, voffB); PG8_STAGE(PG8_SB(0, 1), b2 + hstep, voffB); PG8_STAGE(PG8_SA(0, 0), a2, voffA);
            PG8_WAIT_V(8); PG8_WAIT_L(0); PG8_BAR; PG8_MMA(1, 0, At, B0); PG8_MMA(1, 1, At, B1); PG8_BAR; PG8_SCHED;
            PG8_LDB(B0, 1, 0); PG8_LDB(B1, 1, 1); PG8_SCHED; PG8_LDA(At, 1, 0); PG8_STAGE(PG8_SA(0, 1), a2 + hstep, voffA);
            PG8_WAIT_V(8); PG8_WAIT_L(0); PG8_BAR; PG8_MMA(0, 0, At, B0); PG8_MMA(0, 1, At, B1); PG8_BAR; PG8_SCHED;
            PG8_LDA(At, 1, 1); PG8_STAGE(PG8_SB(1, 0), b3, voffB); PG8_STAGE(PG8_SB(1, 1), b3 + hstep, voffB); PG8_STAGE(PG8_SA(1, 0), a3, voffA);
            PG8_WAIT_V(8); PG8_WAIT_L(0); PG8_BAR; PG8_MMA(1, 0, At, B0); PG8_MMA(1, 1, At, B1); PG8_BAR; PG8_SCHED;
            } else {
            PG8_LDB(B0, 0, 0); PG8_SCHED; PG8_LDA(At, 0, 0); PG8_STAGE(PG8_SA(1, 1), a1 + hstep, voffA);
            PG8_WAIT_L(8); PG8_BAR; PG8_WAIT_L(0); PG8_MMA(0, 0, At, B0); PG8_BAR; PG8_SCHED;
            PG8_LDB(B1, 0, 1); PG8_STAGE(PG8_SB(0, 0), b2, voffB);
            PG8_BAR; PG8_WAIT_L(0); PG8_MMA(0, 1, At, B1); PG8_BAR;
            PG8_LDA(At, 0, 1); PG8_STAGE(PG8_SA(0, 0), a2, voffA);
            PG8_BAR; PG8_WAIT_L(0); PG8_MMA(1, 0, At, B0); PG8_BAR; PG8_SCHED;
            PG8_STAGE(PG8_SB(0, 1), b2 + hstep, voffB);
            PG8_WAIT_V(6); PG8_BAR; PG8_MMA(1, 1, At, B1); PG8_BAR;
            PG8_LDB(B0, 1, 0); PG8_SCHED; PG8_LDA(At, 1, 0); PG8_STAGE(PG8_SA(0, 1), a2 + hstep, voffA);
            PG8_WAIT_L(8); PG8_BAR; PG8_WAIT_L(0); PG8_MMA(0, 0, At, B0); PG8_BAR; PG8_SCHED;
            PG8_LDB(B1, 1, 1); PG8_STAGE(PG8_SB(1, 0), b3, voffB);
            PG8_BAR; PG8_WAIT_L(0); PG8_MMA(0, 1, At, B1); PG8_BAR;
            PG8_LDA(At, 1, 1); PG8_STAGE(PG8_SA(1, 0), a3, voffA);
            PG8_BAR; PG8_WAIT_L(0); PG8_MMA(1, 0, At, B0); PG8_BAR; PG8_SCHED;
            PG8_STAGE(PG8_SB(1, 1), b3 + hstep, voffB);
            PG8_WAIT_V(6); PG8_BAR; PG8_MMA(1, 1, At, B1); PG8_BAR;
            }
        }
        if constexpr (ALIGN_EPI) { if (wr == 0) PG8_BAR; }
        if constexpr (!Epi::AFTER_DRAIN) { E(acc, cur, wr, wc, fr, fq); S.done(cur); }
        if (!has_next) break;
#pragma unroll
        for (int a = 0; a < 2; ++a)
#pragma unroll
            for (int b = 0; b < 2; ++b)
#pragma unroll
                for (int m = 0; m < 4; ++m)
#pragma unroll
                    for (int n = 0; n < 2; ++n) acc[a][b][m][n] = (f32x4){0.f, 0.f, 0.f, 0.f};
        cur = nxt; cA = nA; cB = nB; ++ui;
        if constexpr (ALIGN_EPI) { if (wr == 1) PG8_BAR; }
    }
    PG8_WAIT_V(0);
    if constexpr (!ALIGN_EPI) { if (wr == 0) PG8_BAR; }
    PG8_BAR;
    if constexpr (Epi::AFTER_DRAIN) { E.fused(acc, cur, wr, wc, fr, fq, lds, wid, lane); S.done(cur); }
#undef PG8_SA
#undef PG8_SB
#undef PG8_STAGE
#undef PG8_LDA
#undef PG8_LDB
#undef PG8_MMA
#undef PG8_WAIT_V
#undef PG8_WAIT_L
#undef PG8_BAR
#undef PG8_SCHED
}
}
#define GAS __attribute__((address_space(1)))
#define LAS __attribute__((address_space(3)))
typedef unsigned short bf16;
typedef unsigned v4u __attribute__((ext_vector_type(4)));
typedef float f32x4 __attribute__((ext_vector_type(4)));
typedef short bf16x8 __attribute__((ext_vector_type(8)));
typedef GAS unsigned gu32;
typedef GAS unsigned long long gu64;
#define RLX_AGENT __ATOMIC_RELAXED, __HIP_MEMORY_SCOPE_AGENT
#define LDS_WAIT() asm volatile("s_waitcnt lgkmcnt(0)" ::: "memory")
#define VM_WAIT() asm volatile("s_waitcnt vmcnt(0)" ::: "memory")
__device__ __forceinline__ unsigned long long rt() { return __builtin_amdgcn_s_memrealtime(); }
__device__ __forceinline__ unsigned f2bf(float f) { unsigned u = __builtin_bit_cast(unsigned, f); return (u + 0x7fffu + ((u >> 16) & 1u)) >> 16; }
__device__ __forceinline__ unsigned pk2(float lo, float hi) { return f2bf(lo) | (f2bf(hi) << 16); }
#define XB_TMO      128
#define XB_XCNT(j)  (256  + 64 * (j))
#define XB_XSUB(j)  (1280 + 64 * (j))
#define XB_XGEN(j)  (2304 + 64 * (j))
#define XB_TOP      3328
#define XB_TOPGEN   3392
#define XCD_BAR_WORDS 3456
#define XB_SPIN_CAP (1u << 18)

__device__ __forceinline__ unsigned xb_ld(unsigned* p)              { return __hip_atomic_load(p, __ATOMIC_RELAXED, __HIP_MEMORY_SCOPE_AGENT); }
__device__ __forceinline__ unsigned xb_add(unsigned* p, unsigned v) { return __hip_atomic_fetch_add(p, v, __ATOMIC_RELAXED, __HIP_MEMORY_SCOPE_AGENT); }
__device__ __forceinline__ unsigned xb_xcc_id() { return (unsigned)__builtin_amdgcn_s_getreg((3 << 11) | 20) & 0xFu; }
#define XB_SPIN(cond, bar) do { unsigned _sp = 0; while (cond) { __builtin_amdgcn_s_sleep(1); \
    if ((++_sp & 255u) == 0u) { if (xb_ld(&(bar)[XB_TMO])) break; if (_sp > XB_SPIN_CAP) { atomicAdd(&(bar)[XB_TMO], 1u); break; } } } } while (0)

struct XcdBarrier {
    unsigned* bar; unsigned x;
    volatile LAS unsigned* st;
};

__device__ __forceinline__ XcdBarrier xcd_barrier_post(unsigned* bar, volatile LAS unsigned* st) {
    XcdBarrier b; b.bar = bar; b.x = xb_xcc_id(); b.st = st;
    if (threadIdx.x == 0) (void)xb_add(&bar[XB_XCNT(b.x)], 1u);
    return b;
}
__device__ __forceinline__ void xcd_barrier_complete(unsigned* bar, unsigned x, unsigned& nloc, unsigned& nx) {
    const unsigned G = gridDim.x * gridDim.y * gridDim.z;
    unsigned sum, cnt, mine, sp = 0u;
    for (;;) {
        sum = 0u; cnt = 0u; mine = 0u;
#pragma unroll
        for (unsigned j = 0; j < 16; ++j) { const unsigned c = xb_ld(&bar[XB_XCNT(j)]); sum += c; cnt += (c > 0u) ? 1u : 0u; mine = (j == x) ? c : mine; }
        if (sum == G) break;
        __builtin_amdgcn_s_sleep(1);
        if ((++sp & 255u) == 0u) { if (xb_ld(&bar[XB_TMO])) break; if (sp > XB_SPIN_CAP) { atomicAdd(&bar[XB_TMO], 1u); break; } }
    }
    nloc = mine > 0u ? mine : 1u; nx = cnt > 0u ? cnt : 1u;
}

__device__ __forceinline__ void xcd_barrier(const XcdBarrier& b) {
    asm volatile("s_waitcnt vmcnt(0)" ::: "memory");
    __syncthreads();
    if (threadIdx.x == 0) {
        unsigned* bar = b.bar;
        __builtin_amdgcn_s_waitcnt(0);
        unsigned nloc = b.st[0], nx = b.st[1];
        if (nloc == 0u) { xcd_barrier_complete(bar, b.x, nloc, nx); b.st[0] = nloc; b.st[1] = nx; }
        const unsigned old = xb_add(&bar[XB_XSUB(b.x)], 1u);
        const unsigned gen = old / nloc;
        if (old + 1u == (gen + 1u) * nloc) {
            __builtin_amdgcn_fence(__ATOMIC_RELEASE, "agent");
            asm volatile("s_waitcnt vmcnt(0)" ::: "memory");
            const unsigned og = xb_add(&bar[XB_TOP], 1u);
            const unsigned tg = og / nx;
            if (og + 1u == (tg + 1u) * nx) xb_add(&bar[XB_TOPGEN], 1u);
            else XB_SPIN(xb_ld(&bar[XB_TOPGEN]) == tg, bar);
            __builtin_amdgcn_fence(__ATOMIC_ACQUIRE, "agent");
            xb_add(&bar[XB_XGEN(b.x)], 1u);
            asm volatile("s_waitcnt vmcnt(0)" ::: "memory");
        } else {
            XB_SPIN(xb_ld(&bar[XB_XGEN(b.x)]) == gen, bar);
            __builtin_amdgcn_fence(__ATOMIC_ACQUIRE, "agent");
            asm volatile("s_waitcnt vmcnt(0)" ::: "memory");
        }
    }
    __syncthreads();
}

constexpr int NWAVES = 8, NTHREADS = 512;
constexpr int NT = 32768, DM = 1024, SEQ = 8192, NCHUNK = 128, PROJW = 3328;
constexpr float EPS = 1e-6f;
enum { I_X = 0, I_P, I_POS, I_NMW, I_NFW, I_NPW, I_FNW, I_EWIN, I_GWUP, I_GBUP, I_GNW, I_RNW, I_EWOUT, I_OWIN, I_POOLW, I_POOLS, I_ARE, I_AIM, I_LDT, I_BRE, I_BIM, I_CRE, I_CIM, I_DSK,
       I_WGLU, I_BGLU, I_OWOUT, I_PWQ, I_PKEYS, I_PU, I_PV, I_PLEP, I_PLEG, N_IN };
constexpr size_t MiB = 1u << 20;
constexpr size_t WS_CTL = 0, CTL_ZERO_BYTES = 64 * 1024;
constexpr size_t WS_WIN0 = 1 * MiB, WS_WOUT0 = 8 * MiB, WS_WEFF = 10 * MiB  , WS_WG = 18 * MiB  , WS_WP = 22 * MiB  , WS_WIN1 = 23 * MiB, WS_WGLU = 25 * MiB, WS_WOUT1 = 26 * MiB;
constexpr size_t WS_ROT = 28 * MiB, WS_S5C = 30 * MiB, WS_SSQ0 = 31 * MiB, WS_SSQ1 = 33 * MiB, WS_DEC = 35 * MiB;
constexpr size_t S5_ABAR = 0, S5_A64 = 16384, S5_BBAR = 32768  , S5_CM = 32768 + 262144  , S5_BB16 = S5_CM + 131072  ;
constexpr size_t WS_A0 = 36 * MiB, WS_A1 = 100 * MiB, WS_R1 = 164 * MiB;
constexpr size_t WS_PROJ = WS_R1, WS_KV = WS_R1 + 208 * MiB;
constexpr size_t WS_SC = WS_R1, WS_EID = WS_R1 + 256 * MiB, WS_GATE = WS_R1 + 272 * MiB;
constexpr size_t WS_COEF = WS_R1 + 160 * MiB;
constexpr size_t WS_XQ = WS_R1 + 224 * MiB;
constexpr size_t WS_UT4 = WS_R1 + 288 * MiB, WS_VT4 = WS_UT4 + 8 * MiB, WS_SCL = WS_UT4 + 16 * MiB, WS_PB = WS_UT4 + 18 * MiB, WS_PP = WS_R1 + 80 * MiB;
constexpr size_t WS_U = WS_R1, WS_Z = WS_R1 + 64 * MiB, WS_E = WS_R1 + 96 * MiB;
constexpr size_t WS_END = WS_R1 + 288 * MiB + 34 * MiB;
constexpr int RING_BYTES = 131072, MISC_OFF = RING_BYTES + 320, LDS_BYTES = 147456;

__device__ __forceinline__ float bf2f(unsigned short b) { return __uint_as_float((unsigned)b << 16); }
__device__ __forceinline__ float bf2f(unsigned b) { return __uint_as_float(b << 16); }
__device__ __forceinline__ float bflo(unsigned w) { return __uint_as_float(w << 16); }
__device__ __forceinline__ float bfhi(unsigned w) { return __uint_as_float(w & 0xffff0000u); }
__device__ __forceinline__ float wave_sum(float v) {
#pragma unroll
    for (int o = 1; o < 64; o <<= 1) v += __shfl_xor(v, o);
    return v;
}
__device__ __forceinline__ float gelu1(float v) {
    const float av = fabsf(v), t = __builtin_amdgcn_rcpf(av * 0.2316418882f + 1.0f);
    float q = t * 0.5307027145f + (-0.7265760135f); q = q * t + 0.7107068705f; q = q * t + (-0.142248368f); q = q * t + 0.127414796f; q = q * t;
    const float e = __builtin_amdgcn_exp2f((v * v) * (-0.72134752044f));
    const float m = v * (q * e);
    return v < 0.f ? m : v - m;
}
__device__ __forceinline__ float logsigf(float x) { return fminf(x, 0.f) - __logf(1.0f + __expf(-fabsf(x))); }
__device__ __forceinline__ float siluf(float x) { return x * __builtin_amdgcn_rcpf(1.0f + __expf(-x)); }

struct Ctx {
    LAS unsigned char* lds;
    int tid, lane, wave, G, bid;
    float* h;
    unsigned char* ws;
};
struct Args { const void* in[N_IN]; float* out; unsigned char* ws; };
constexpr int PTR_OFF = 131072 + 1024;
#define IN(i) inptr(C, (i))
#define WSP(T, off) ((T*)(C.ws + (off)))
#define PHASE_ENTER(C) do { int t_ = threadIdx.x; asm volatile("" : "+v"(t_)); C.tid = t_; C.lane = t_ & 63; C.wave = __builtin_amdgcn_readfirstlane(t_ >> 6); asm volatile("" : "+s"(C.ws), "+s"(C.h)); C.ws = (unsigned char*)(GAS unsigned char*)C.ws; C.h = (float*)(GAS float*)C.h; } while (0)
__device__ __forceinline__ const float* inptr(const Ctx& C, int i) { const LAS unsigned* t = (const LAS unsigned*)(C.lds + PTR_OFF) + 2 * i;
    const unsigned lo = __builtin_amdgcn_readfirstlane(t[0]), hi = __builtin_amdgcn_readfirstlane(t[1]); return (const float*)(const GAS float*)(((unsigned long long)hi << 32) | lo); }

__device__ __forceinline__ void tr_item(const float* W, int ldw, int c0, bf16* WT, int K, int r0, const float* ks, float cs, LAS float* scr, int item, int nblk, int lane) {
    const int kb = item / nblk, nb = item % nblk, k0 = 64 * kb, n0 = 32 * nb;
#pragma unroll 8
    for (int i = 0; i < 32; ++i) { const int kk = 2 * i + (lane >> 5); float v = W[(size_t)(k0 + kk) * ldw + c0 + n0 + (lane & 31)]; if (ks) v *= ks[k0 + kk]; scr[kk * 33 + (lane & 31)] = v * cs; }
    LDS_WAIT(); asm volatile("" ::: "memory");
    const int c = lane & 7;
#pragma unroll
    for (int j = 0; j < 4; ++j) { const int n = (lane >> 3) + 8 * j; const LAS float* s = scr + (8 * c) * 33 + n;
        v4u o; o.x = pk2(s[0 * 33], s[1 * 33]); o.y = pk2(s[2 * 33], s[3 * 33]); o.z = pk2(s[4 * 33], s[5 * 33]); o.w = pk2(s[6 * 33], s[7 * 33]);
        *(v4u*)(WT + (size_t)(r0 + n0 + n) * K + k0 + 8 * c) = o; }
    LDS_WAIT(); asm volatile("" ::: "memory");
}
__device__ __forceinline__ void fold_item(const float* KM, int sk, int sc, const float* W, int ldw, int wc0, int kb, bf16* OUT, const float* kscale, const float* nscale, LAS float* lds, int tid) {
    LAS float* KL = lds;
    LAS float* WL = lds + 128 * 132;
    if (sc == 1) { for (int idx = tid; idx < 4096; idx += NTHREADS) { const int key = idx >> 5, c = (idx & 31) * 4; *(LAS f32x4*)(KL + key * 132 + c) = *(const GAS f32x4*)(KM + (size_t)key * sk + c); } }
    else         { for (int idx = tid; idx < 16384; idx += NTHREADS) { const int c = idx >> 7, key = idx & 127; KL[key * 132 + c] = KM[(size_t)key * sk + (size_t)c * sc]; } }
    for (int idx = tid; idx < 2048; idx += NTHREADS) { const int k = idx >> 5, c = (idx & 31) * 4; *(LAS f32x4*)(WL + k * 132 + c) = *(const GAS f32x4*)(W + (size_t)(kb * 64 + k) * ldw + wc0 + c); }
    __syncthreads();
    { const int lane = tid & 63, wv = tid >> 6, i16 = lane & 15, kq = lane >> 4;
      f32x4 ar[8];
#pragma unroll
      for (int m = 0; m < 8; ++m) ar[m] = *(const LAS f32x4*)(KL + (16 * wv + i16) * 132 + 32 * kq + 4 * m);
#pragma unroll
      for (int kt = 0; kt < 4; ++kt) {
          f32x4 br[8];
#pragma unroll
          for (int m = 0; m < 8; ++m) br[m] = *(const LAS f32x4*)(WL + (16 * kt + i16) * 132 + 32 * kq + 4 * m);
          f32x4 d = (f32x4){0.f, 0.f, 0.f, 0.f};
#pragma unroll
          for (int m = 0; m < 8; ++m)
#pragma unroll
              for (int e = 0; e < 4; ++e) d = __builtin_amdgcn_mfma_f32_16x16x4f32(ar[m][e], br[m][e], d, 0, 0, 0);
          const int k = kb * 64 + 16 * kt + i16; const float ks = kscale[k];
#pragma unroll
          for (int r = 0; r < 4; ++r) { const int key = 16 * wv + 4 * kq + r; const float ns = nscale ? nscale[key] : 1.0f; OUT[(size_t)key * 1024 + k] = (bf16)f2bf(d[r] * ks * ns); } } }
    __syncthreads();
}

__device__ __forceinline__ void phase_prologue(Ctx C, const Args& A) {
    PHASE_ENTER(C);
    const int tid = C.tid, lane = C.lane;
    const bool split = C.G >= 192; const int NF = split ? 80 : C.G;
    const bool do_fold = !split || C.bid < NF, do_rest = !split || C.bid >= NF;
    const int wb = split ? C.bid - NF : C.bid, nwb = split ? C.G - NF : C.G;
    const int gw = wb * NWAVES + C.wave, NGW = nwb * NWAVES;
    const int gt = wb * NTHREADS + tid, NGT = nwb * NTHREADS;
    if (do_fold) for (int it = C.bid; it < 576; it += NF) {
        if (it < 512) { const int l = it >> 8, hp = (it >> 4) & 15, kb = it & 15;
            fold_item(IN(I_PKEYS) + (size_t)(l * 16 + hp) * 16384, 128, 1, IN(I_PWQ) + (size_t)l * 1024 * 2048, 2048, hp * 128, kb,
                      WSP(bf16, WS_WEFF) + (size_t)l * 2048 * 1024 + (size_t)hp * 128 * 1024, IN(I_NFW) + l * 1024, nullptr, (LAS float*)C.lds, tid);
        } else { const int r = it - 512, g = r >> 4, kb = r & 15;
            fold_item(IN(I_POOLW) + (size_t)g * 16384, 1, 128, IN(I_OWIN), 1024, g * 128, kb,
                      WSP(bf16, WS_WIN1) + (size_t)g * 128 * 1024, IN(I_NMW) + 1024, IN(I_POOLS) + g * 128, (LAS float*)C.lds, tid);
        }
    }
    if (do_rest) {
    LAS float* scr = (LAS float*)(C.lds + C.wave * 8448);
    constexpr int TR_ITEMS = 128 + 640 + 128 + 128 + 512 + 512 + 512 + 512 + 128 + 128 + 256 + 128 + 512;
    for (int it = gw; it < TR_ITEMS; it += NGW) {
        int r = it;
#define TRJOB(W, ldw, c0, ncols, Krows, WT, r0, ks, cs) { constexpr int nb_ = (ncols) / 32, ni_ = ((Krows) / 64) * nb_; if (r < ni_) { tr_item(W, ldw, c0, WT, Krows, r0, ks, cs, scr, r, nb_, lane); continue; } r -= ni_; }
        TRJOB(IN(I_EWIN), 3088, 0,    256,  1024, WSP(bf16, WS_WIN0), 0,    IN(I_NMW), 0.125f)
        TRJOB(IN(I_EWIN), 3088, 256,  1280, 1024, WSP(bf16, WS_WIN0), 256,  IN(I_NMW), 1.0f)
        TRJOB(IN(I_EWIN), 3088, 1552, 256,  1024, WSP(bf16, WS_WIN0), 1792, IN(I_NMW), 1.0f)
        TRJOB(IN(I_EWIN), 3088, 1808, 256,  1024, WSP(bf16, WS_WIN0), 2048, IN(I_NMW), 0.125f)
        TRJOB(IN(I_EWIN), 3088, 2064, 1024, 1024, WSP(bf16, WS_WIN0), 2304, IN(I_NMW), 1.0f)
        TRJOB(IN(I_EWOUT), 1024, 0, 1024, 1024, WSP(bf16, WS_WOUT0), 0, (const float*)nullptr, 1.0f)
        TRJOB(IN(I_PLEG), 1024, 0, 1024, 1024, WSP(bf16, WS_WG), 0, IN(I_NPW), 1.0f)
        TRJOB(IN(I_PLEG) + 1024 * 1024, 1024, 0, 1024, 1024, WSP(bf16, WS_WG) + 1024 * 1024, 0, IN(I_NPW) + 1024, 1.0f)
        TRJOB(IN(I_PLEP), 1024, 0, 1024, 256, WSP(bf16, WS_WP), 0, (const float*)nullptr, 1.0f)
        TRJOB(IN(I_PLEP) + 256 * 1024, 1024, 0, 1024, 256, WSP(bf16, WS_WP) + 1024 * 256, 0, (const float*)nullptr, 1.0f)
        TRJOB(IN(I_OWIN), 1024, 512, 512, 1024, WSP(bf16, WS_WIN1), 512, IN(I_NMW) + 1024, 1.0f)
        TRJOB(IN(I_WGLU), 512, 0, 512, 512, WSP(bf16, WS_WGLU), 0, (const float*)nullptr, 1.0f)
        TRJOB(IN(I_OWOUT), 1024, 0, 1024, 1024, WSP(bf16, WS_WOUT1), 0, (const float*)nullptr, 1.0f)
#undef TRJOB
    }
    for (int idx = gt; idx < 256 * 1024; idx += NGT) { const int j = idx >> 10, k = idx & 1023; const float* wr = IN(I_EWIN) + (size_t)k * 3088 + 1536; const float* wu = IN(I_GWUP) + j; float s = 0.f;
#pragma unroll
        for (int r = 0; r < 16; ++r) s += wr[r] * wu[r * 256];
        WSP(bf16, WS_WIN0)[(size_t)(1536 + j) * 1024 + k] = (bf16)f2bf(s * IN(I_NMW)[k]); }
    for (int idx = gt; idx < SEQ * 32; idx += NGT) { const int s = idx >> 5, i = idx & 31; const double pos = (double)((const int*)IN(I_POS))[s];
        const double ang = pos * exp2(-(double)i * (13.287712379549449 / 32.0)); const double r = ang - 6.283185307179586 * rint(ang * 0.15915494309189535);
        float sn, cs; sincosf((float)r, &sn, &cs); WSP(float, WS_ROT)[2 * idx] = cs; WSP(float, WS_ROT)[2 * idx + 1] = sn; }
    for (int idx = gt; idx < 2048; idx += NGT) { const int g = idx >> 6;
        const double dt = exp((double)IN(I_LDT)[g]), are = (double)IN(I_ARE)[idx], aim = (double)IN(I_AIM)[idx];
        const double mag = exp(are * dt); double th = aim * dt; th -= 6.283185307179586 * rint(th * 0.15915494309189535);
        const double abr = mag * cos(th), abi = mag * sin(th);
        const double den = are * are + aim * aim, nr = abr - 1.0, ni = abi;
        const double cre = (nr * are + ni * aim) / den, cim = (ni * are - nr * aim) / den;
        const double m64 = exp(64.0 * are * dt); double t64 = 64.0 * aim * dt; t64 -= 6.283185307179586 * rint(t64 * 0.15915494309189535);
        float* s5 = WSP(float, WS_S5C);
        s5[S5_ABAR / 4 + 2 * idx] = (float)abr; s5[S5_ABAR / 4 + 2 * idx + 1] = (float)abi;
        s5[S5_A64 / 4 + 2 * idx] = (float)(m64 * cos(t64)); s5[S5_A64 / 4 + 2 * idx + 1] = (float)(m64 * sin(t64));
        for (int hh = 0; hh < 16; ++hh) { const double br = (double)IN(I_BRE)[idx * 16 + hh], bi = (double)IN(I_BIM)[idx * 16 + hh];
            s5[S5_BBAR / 4 + (idx * 16 + hh) * 2] = (float)(cre * br - cim * bi); s5[S5_BBAR / 4 + (idx * 16 + hh) * 2 + 1] = (float)(cre * bi + cim * br);
            bf16* bb = (bf16*)(C.ws + WS_S5C + S5_BB16) + (size_t)g * 128 * 16; const int pp_ = idx & 63;
            bb[(pp_) * 16 + hh] = (bf16)f2bf((float)(cre * br - cim * bi)); bb[(64 + pp_) * 16 + hh] = (bf16)f2bf((float)(cre * bi + cim * br)); } }
    for (int idx = gt; idx < 32 * 16 * 128; idx += NGT) { const int k = idx & 127, gh = idx >> 7;
        const float v = k < 64 ? IN(I_CRE)[gh * 64 + k] : -IN(I_CIM)[gh * 64 + k - 64]; ((bf16*)(C.ws + WS_S5C + S5_CM))[idx] = (bf16)f2bf(v); }
#pragma unroll 4
    for (int m = gw; m < NT; m += NGW) { const f32x4* xr = (const f32x4*)(IN(I_X) + (size_t)m * DM) + lane; f32x4 v[4]; float s = 0.f;
#pragma unroll
        for (int j = 0; j < 4; ++j) { v[j] = xr[64 * j]; s += (v[j][0] * v[j][0] + v[j][1] * v[j][1]) + (v[j][2] * v[j][2] + v[j][3] * v[j][3]); }
        const float rs = 1.0f / sqrtf(wave_sum(s) * (1.0f / DM) + EPS);
        unsigned long long* o8 = (unsigned long long*)(WSP(bf16, WS_A0) + (size_t)m * DM) + lane;
#pragma unroll
        for (int j = 0; j < 4; ++j) o8[64 * j] = (unsigned long long)pk2(v[j][0] * rs, v[j][1] * rs) | ((unsigned long long)pk2(v[j][2] * rs, v[j][3] * rs) << 32); }
    }
}

__device__ __forceinline__ float lg2gamma(int hh) { return __log2f(1.0f - exp2f(-5.0f - (float)hh)); }

__device__ __forceinline__ void gla_gate_local(const unsigned (&rla)[16], float bu, float (&g)[16]) {
    float run = 0.f;
#pragma unroll
    for (int c = 0; c < 16; ++c) { const float x = bf2f(rla[c]) + bu; run += logsigf(x) * (1.0f / 16.0f); g[c] = run; }
}
__device__ __forceinline__ void stage_vt(const unsigned (&v0)[16], const unsigned (&v1)[16], LAS bf16* Vt, int c0, int lane) {
    unsigned w[8];
#pragma unroll
    for (int c = 0; c < 16; c += 2) w[c >> 1] = (unsigned)v0[c] | ((unsigned)v0[c + 1] << 16);
    *(LAS v4u*)(Vt + lane * 72 + c0) = (v4u){w[0], w[1], w[2], w[3]}; *(LAS v4u*)(Vt + lane * 72 + c0 + 8) = (v4u){w[4], w[5], w[6], w[7]};
#pragma unroll
    for (int c = 0; c < 16; c += 2) w[c >> 1] = (unsigned)v1[c] | ((unsigned)v1[c + 1] << 16);
    *(LAS v4u*)(Vt + (lane + 64) * 72 + c0) = (v4u){w[0], w[1], w[2], w[3]}; *(LAS v4u*)(Vt + (lane + 64) * 72 + c0 + 8) = (v4u){w[4], w[5], w[6], w[7]};
}

__device__ __forceinline__ void phase_kv(Ctx C, const Args& A) {
    PHASE_ENTER(C);
    const int half = C.wave >> 2;
    LAS unsigned char* hb = C.lds + half * 28672;
    LAS bf16* Kt = (LAS bf16*)hb; LAS bf16* Vt = (LAS bf16*)(hb + 9216); LAS float* TOT = (LAS float*)(hb + 27648);
    const bf16* PROJ = WSP(bf16, WS_PROJ);
    unsigned r_la[16], r_k[16], r_kx[16], r_v0[16], r_v1[16]; float r_cs[16], r_sn[16]; float bu = 0.f;
#pragma unroll
    for (int c = 0; c < 16; ++c) { r_la[c] = 0u; r_kx[c] = 0u; r_cs[c] = 0.f; r_sn[c] = 0.f; r_k[c] = 0u; r_v0[c] = 0u; r_v1[c] = 0u; }
#define KV_LOAD(IT, LANE, C0) do { const int pair_ = (IT) & 3, n_ = ((IT) >> 2) & 127, b_ = (IT) >> 9; const bool ret_ = pair_ >= 2; const int hh_ = (pair_ & 1) * 2 + half; \
        const bf16* prow_ = PROJ + (size_t)(b_ * SEQ + n_ * 64 + (C0)) * PROJW; const int xoff_ = (LANE) < 32 ? 32 : -32; \
        const bf16* bK_ = prow_ + (ret_ ? 2048 + hh_ * 64 : 256 + hh_ * 64); const bf16* bV_ = prow_ + (ret_ ? 2304 + hh_ * 128 : 512 + hh_ * 128); const bf16* bL_ = prow_ + 1536 + hh_ * 64; \
        if (!ret_) { bu = IN(I_GBUP)[hh_ * 64 + (LANE)]; _Pragma("unroll") for (int c = 0; c < 16; ++c) r_la[c] = bL_[c * PROJW + (LANE)]; } \
        else { const float* rot_ = WSP(float, WS_ROT) + ((size_t)(n_ * 64 + (C0)) * 32 + ((LANE) & 31)) * 2; \
               _Pragma("unroll") for (int c = 0; c < 16; ++c) { r_kx[c] = bK_[c * PROJW + (LANE) + xoff_]; r_cs[c] = rot_[c * 64]; r_sn[c] = rot_[c * 64 + 1]; } } \
        _Pragma("unroll") for (int c = 0; c < 16; ++c) { r_k[c] = bK_[c * PROJW + (LANE)]; r_v0[c] = bV_[c * PROJW + (LANE)]; r_v1[c] = bV_[c * PROJW + (LANE) + 64]; } } while (0)
    if (C.bid < 2048) KV_LOAD(C.bid, C.lane, 16 * (C.wave & 3));
    for (int item = C.bid; item < 2048; item += C.G) {
        int lane_o = C.lane, w4_o = C.wave & 3; asm volatile("" : "+v"(lane_o), "+s"(w4_o));
        const int lane = lane_o, w4 = w4_o, fr = lane & 15, fq = lane >> 4, c0 = 16 * w4;
        const int pair = item & 3, n = (item >> 2) & 127, b = item >> 9; const bool isret = pair >= 2;
        const int hh = (pair & 1) * 2 + half, t0 = b * SEQ + n * 64;
        const bf16* prow = PROJ + (size_t)(t0 + c0) * PROJW;
        float g[16]; float glast = 0.f, off = 0.f;
        if (!isret) { gla_gate_local(r_la, bu, g); TOT[w4 * 64 + lane] = g[15]; }
        __syncthreads();
        if (!isret) {
#pragma unroll
            for (int w = 0; w < 4; ++w) { const float tv = TOT[w * 64 + lane]; glast += tv; if (w < w4) off += tv; } }
        unsigned kw[8];
        if (!isret) {
#pragma unroll
            for (int c = 0; c < 16; c += 2) { const float k0 = bf2f(r_k[c]) * __expf(glast - (off + g[c])), k1 = bf2f(r_k[c + 1]) * __expf(glast - (off + g[c + 1])); kw[c >> 1] = pk2(k0, k1); }
        } else { const float lg = lg2gamma(hh); float kv[2];
#pragma unroll
            for (int c = 0; c < 16; ++c) { const float own = bf2f(r_k[c]), oth = bf2f(r_kx[c]); const float cs = r_cs[c], sn = r_sn[c];
                const float r = lane < 32 ? own * cs - oth * sn : own * cs + oth * sn; kv[c & 1] = r * exp2f(lg * (float)(63 - (c0 + c))); if (c & 1) kw[c >> 1] = pk2(kv[0], kv[1]); } }
        *(LAS v4u*)(Kt + lane * 72 + c0) = (v4u){kw[0], kw[1], kw[2], kw[3]}; *(LAS v4u*)(Kt + lane * 72 + c0 + 8) = (v4u){kw[4], kw[5], kw[6], kw[7]};
        stage_vt(r_v0, r_v1, Vt, c0, lane);
        if (!isret && w4 == 0) WSP(float, WS_DEC)[(size_t)((b * 4 + hh) * 128 + n) * 64 + lane] = __expf(glast);
        asm volatile("" ::: "memory");
        if (item + C.G < 2048) KV_LOAD(item + C.G, lane, c0);
        __syncthreads();
        f32x4 acc[2][4];
#pragma unroll
        for (int et = 0; et < 2; ++et)
#pragma unroll
            for (int dt = 0; dt < 4; ++dt) acc[et][dt] = (f32x4){0.f, 0.f, 0.f, 0.f};
#pragma unroll
        for (int kk = 0; kk < 2; ++kk) { bf16x8 bfr[4];
#pragma unroll
            for (int dt = 0; dt < 4; ++dt) bfr[dt] = *(const LAS bf16x8*)(Kt + (dt * 16 + fr) * 72 + kk * 32 + 8 * fq);
#pragma unroll
            for (int et = 0; et < 2; ++et) { const bf16x8 afr = *(const LAS bf16x8*)(Vt + ((2 * w4 + et) * 16 + fr) * 72 + kk * 32 + 8 * fq);
#pragma unroll
                for (int dt = 0; dt < 4; ++dt) acc[et][dt] = __builtin_amdgcn_mfma_f32_16x16x32_bf16(bfr[dt], afr, acc[et][dt], 0, 0, 0); } }
        bf16* KV = WSP(bf16, WS_KV) + (size_t)((b * 8 + (isret ? 4 + hh : hh)) * 128 + n) * 8192;
#pragma unroll
        for (int et = 0; et < 2; ++et)
#pragma unroll
            for (int dt = 0; dt < 4; ++dt)
                *(GAS pg8::u32x2*)(KV + ((2 * w4 + et) * 16 + fr) * 64 + dt * 16 + 4 * fq) = (pg8::u32x2){pk2(acc[et][dt][0], acc[et][dt][1]), pk2(acc[et][dt][2], acc[et][dt][3])};
        __syncthreads();
    }
#undef KV_LOAD
}

__device__ __forceinline__ void phase_scan(Ctx C, const Args& A) {
    PHASE_ENTER(C);
    for (int gid = C.bid * NTHREADS + C.tid; gid < 131072; gid += C.G * NTHREADS) {
        const int dp = gid & 31, e = (gid >> 5) & 127, bh = gid >> 12, h8 = bh & 7, b = bh >> 3;
        unsigned* p = (unsigned*)(WSP(bf16, WS_KV) + (size_t)bh * 128 * 8192 + e * 64) + dp;
        float s0 = 0.f, s1 = 0.f;
        if (h8 < 4) { const float* dec = WSP(float, WS_DEC) + (size_t)(b * 4 + h8) * 128 * 64 + 2 * dp;
#pragma unroll 8
            for (int n = 0; n < NCHUNK; ++n) { const unsigned kv = p[(size_t)n * 4096]; const float d0 = dec[n * 64], d1 = dec[n * 64 + 1]; p[(size_t)n * 4096] = pk2(s0, s1); s0 = d0 * s0 + bflo(kv); s1 = d1 * s1 + bfhi(kv); }
        } else { const float d = exp2f(64.0f * lg2gamma(h8 - 4));
#pragma unroll 8
            for (int n = 0; n < NCHUNK; ++n) { const unsigned kv = p[(size_t)n * 4096]; p[(size_t)n * 4096] = pk2(s0, s1); s0 = d * s0 + bflo(kv); s1 = d * s1 + bfhi(kv); } }
    }
}

__device__ __forceinline__ void phase_mix0_out(Ctx C, const Args& A) {
    PHASE_ENTER(C);
    const int half = C.wave >> 2;
    LAS unsigned char* hb = C.lds + half * 56320;
    LAS bf16* Qp = (LAS bf16*)hb; LAS bf16* Kp = (LAS bf16*)(hb + 9216); LAS bf16* Qpp = (LAS bf16*)(hb + 18432); LAS bf16* Vt = (LAS bf16*)(hb + 27648); LAS bf16* Pm = (LAS bf16*)(hb + 46080);
    LAS float* TOT = (LAS float*)(hb + 55296);
    const bf16* PROJ = WSP(bf16, WS_PROJ); bf16* Y = WSP(bf16, WS_A1);
    for (int item = C.bid; item < 2048; item += C.G) {
        int lane_o = C.lane, w4_o = C.wave & 3; asm volatile("" : "+v"(lane_o), "+s"(w4_o));
        const int lane = lane_o, w4 = w4_o, fr = lane & 15, fq = lane >> 4, c0 = 16 * w4;
        const int pair = item & 3, n = (item >> 2) & 127, b = item >> 9; const bool isret = pair >= 2;
        const int hh = (pair & 1) * 2 + half, t0 = b * SEQ + n * 64;
        const bf16* prow = PROJ + (size_t)(t0 + c0) * PROJW;
        const float lg = lg2gamma(hh);
        const int gcol0 = isret ? 2816 + hh * 128 : 1024 + hh * 128, ycol0 = isret ? 512 + hh * 128 : hh * 128;
        const bf16* bQ = prow + (isret ? 1792 + hh * 64 : hh * 64); const bf16* bK = prow + (isret ? 2048 + hh * 64 : 256 + hh * 64); const bf16* bV = prow + (isret ? 2304 + hh * 128 : 512 + hh * 128); const bf16* bL = prow + 1536 + hh * 64;
        const int xoff = lane < 32 ? 32 : -32;
        unsigned r_la[16], r_q[16], r_k[16], r_qx[16], r_kx[16], r_v0[16], r_v1[16]; float bu = 0.f;
#pragma unroll
        for (int c = 0; c < 16; ++c) { r_la[c] = 0u; r_qx[c] = 0u; r_kx[c] = 0u; }
        const float* rot = WSP(float, WS_ROT) + ((size_t)(n * 64 + c0) * 32 + (lane & 31)) * 2;
        if (!isret) { bu = IN(I_GBUP)[hh * 64 + lane];
#pragma unroll
            for (int c = 0; c < 16; ++c) r_la[c] = bL[c * PROJW + lane];
        } else {
#pragma unroll
            for (int c = 0; c < 16; ++c) { r_qx[c] = bQ[c * PROJW + lane + xoff]; r_kx[c] = bK[c * PROJW + lane + xoff]; } }
#pragma unroll
        for (int c = 0; c < 16; ++c) { r_q[c] = bQ[c * PROJW + lane]; r_k[c] = bK[c * PROJW + lane]; r_v0[c] = bV[c * PROJW + lane]; r_v1[c] = bV[c * PROJW + lane + 64]; }
        float g[16]; float glast = 0.f, off = 0.f;
        if (!isret) { gla_gate_local(r_la, bu, g); TOT[w4 * 64 + lane] = g[15]; }
        __syncthreads();
        if (!isret) {
#pragma unroll
            for (int w = 0; w < 4; ++w) { const float tv = TOT[w * 64 + lane]; glast += tv; if (w < w4) off += tv; }
            const float ref = 0.5f * glast;
#pragma unroll
            for (int c = 0; c < 16; ++c) { const float gq = off + g[c], q = bf2f(r_q[c]), k = bf2f(r_k[c]); const int o = (c0 + c) * 72 + lane;
                Qp[o] = (bf16)f2bf(q * __expf(gq - ref)); Kp[o] = (bf16)f2bf(k * __expf(ref - gq)); Qpp[o] = (bf16)f2bf(q * __expf(gq)); }
        } else {
#pragma unroll
            for (int c = 0; c < 16; ++c) { const float cs = rot[c * 64], sn = rot[c * 64 + 1];
                const float qo = bf2f(r_q[c]), qx = bf2f(r_qx[c]), ko = bf2f(r_k[c]), kx = bf2f(r_kx[c]);
                const float qr = lane < 32 ? qo * cs - qx * sn : qo * cs + qx * sn, kr = lane < 32 ? ko * cs - kx * sn : ko * cs + kx * sn; const int o = (c0 + c) * 72 + lane;
                Qp[o] = (bf16)f2bf(qr); Kp[o] = (bf16)f2bf(kr); Qpp[o] = (bf16)f2bf(qr * exp2f(lg * (float)(c0 + c + 1))); } }
        stage_vt(r_v0, r_v1, Vt, c0, lane);
        asm volatile("" ::: "memory");
        const bf16* St = WSP(bf16, WS_KV) + (size_t)((b * 8 + (isret ? 4 + hh : hh)) * 128 + n) * 8192;
        bf16x8 sfr[2][8]; unsigned r_g[8][4];
#pragma unroll
        for (int kk = 0; kk < 2; ++kk)
#pragma unroll
            for (int et = 0; et < 8; ++et) sfr[kk][et] = *(const bf16x8*)(St + (16 * et + fr) * 64 + kk * 32 + 8 * fq);
#pragma unroll
        for (int et = 0; et < 8; ++et)
#pragma unroll
            for (int r = 0; r < 4; ++r) r_g[et][r] = (PROJ + (size_t)(t0 + 16 * w4) * PROJW + gcol0)[(4 * fq + r) * PROJW + 16 * et + fr];
        __syncthreads();
        { f32x4 sc[4];
#pragma unroll
            for (int jt = 0; jt < 4; ++jt) sc[jt] = (f32x4){0.f, 0.f, 0.f, 0.f};
#pragma unroll
            for (int kk = 0; kk < 2; ++kk) { const bf16x8 afr = *(const LAS bf16x8*)(Qp + (16 * w4 + fr) * 72 + kk * 32 + 8 * fq);
#pragma unroll
                for (int jt = 0; jt < 4; ++jt) { const bf16x8 bfr = *(const LAS bf16x8*)(Kp + (16 * jt + fr) * 72 + kk * 32 + 8 * fq); sc[jt] = __builtin_amdgcn_mfma_f32_16x16x32_bf16(afr, bfr, sc[jt], 0, 0, 0); } }
#pragma unroll
            for (int jt = 0; jt < 4; ++jt)
#pragma unroll
                for (int r = 0; r < 4; ++r) { const int i = 16 * w4 + 4 * fq + r, j = 16 * jt + fr; float v = sc[jt][r]; if (isret) v *= exp2f(lg * (float)(i - j)); if (j > i) v = 0.f; Pm[i * 72 + j] = (bf16)f2bf(v); } }
        asm volatile("s_waitcnt lgkmcnt(0)" ::: "memory");
        f32x4 o[8];
#pragma unroll
        for (int et = 0; et < 8; ++et) o[et] = (f32x4){0.f, 0.f, 0.f, 0.f};
#pragma unroll
        for (int kk = 0; kk < 2; ++kk) { const bf16x8 afr = *(const LAS bf16x8*)(Pm + (16 * w4 + fr) * 72 + kk * 32 + 8 * fq), afr2 = *(const LAS bf16x8*)(Qpp + (16 * w4 + fr) * 72 + kk * 32 + 8 * fq);
#pragma unroll
            for (int et = 0; et < 8; ++et) { const bf16x8 bfr = *(const LAS bf16x8*)(Vt + (16 * et + fr) * 72 + kk * 32 + 8 * fq);
                o[et] = __builtin_amdgcn_mfma_f32_16x16x32_bf16(afr, bfr, o[et], 0, 0, 0); o[et] = __builtin_amdgcn_mfma_f32_16x16x32_bf16(afr2, sfr[kk][et], o[et], 0, 0, 0); } }
        float mu[4], rs[4];
#pragma unroll
        for (int r = 0; r < 4; ++r) { float s1 = 0.f;
            if (isret) {
#pragma unroll
                for (int et = 0; et < 8; ++et) s1 += o[et][r];
                s1 += __shfl_xor(s1, 1); s1 += __shfl_xor(s1, 2); s1 += __shfl_xor(s1, 4); s1 += __shfl_xor(s1, 8); }
            mu[r] = s1 * (1.0f / 128.0f); float s2 = 0.f;
#pragma unroll
            for (int et = 0; et < 8; ++et) { const float d = o[et][r] - mu[r]; s2 += d * d; }
            s2 += __shfl_xor(s2, 1); s2 += __shfl_xor(s2, 2); s2 += __shfl_xor(s2, 4); s2 += __shfl_xor(s2, 8);
            rs[r] = 1.0f / sqrtf(s2 * (1.0f / 128.0f) + EPS); }
#pragma unroll
        for (int et = 0; et < 8; ++et) { const int e = 16 * et + fr; const float nw = isret ? IN(I_RNW)[hh * 128 + e] : IN(I_GNW)[e];
#pragma unroll
            for (int r = 0; r < 4; ++r) { const int t = t0 + 16 * w4 + 4 * fq + r; const float gate = siluf(bf2f(r_g[et][r]));
                Y[(size_t)t * DM + ycol0 + e] = (bf16)f2bf((o[et][r] - mu[r]) * rs[r] * nw * gate); } }
        __syncthreads();
    }
}

__device__ __forceinline__ unsigned mono_key(float v) { const unsigned u = __float_as_uint(v); return u ^ ((unsigned)((int)u >> 31) | 0x80000000u); }
__device__ __forceinline__ float key16_val(unsigned k) { return __uint_as_float((k & 0x80000000u) ? ((k ^ 0x80000000u) & 0xffff0000u) : (~k & 0xffff0000u)); }
__device__ __forceinline__ float mono_val(unsigned k) { return __uint_as_float((k & 0x80000000u) ? (k ^ 0x80000000u) : ~k); }
#define CE_DESC(a, b) { const unsigned hi_ = max((a), (b)), lo_ = min((a), (b)); (a) = hi_; (b) = lo_; }
__device__ __forceinline__ void sort16_desc(unsigned (&v)[16]) {
    CE_DESC(v[0], v[1]); CE_DESC(v[2], v[3]); CE_DESC(v[4], v[5]); CE_DESC(v[6], v[7]); CE_DESC(v[8], v[9]); CE_DESC(v[10], v[11]); CE_DESC(v[12], v[13]); CE_DESC(v[14], v[15]); CE_DESC(v[0], v[2]); CE_DESC(v[1], v[3]); CE_DESC(v[4], v[6]); CE_DESC(v[5], v[7]); CE_DESC(v[8], v[10]); CE_DESC(v[9], v[11]); CE_DESC(v[12], v[14]); CE_DESC(v[13], v[15]); CE_DESC(v[1], v[2]); CE_DESC(v[5], v[6]); CE_DESC(v[9], v[10]); CE_DESC(v[13], v[14]); CE_DESC(v[0], v[4]); CE_DESC(v[1], v[5]); CE_DESC(v[2], v[6]); CE_DESC(v[3], v[7]); CE_DESC(v[8], v[12]); CE_DESC(v[9], v[13]); CE_DESC(v[10], v[14]); CE_DESC(v[11], v[15]); CE_DESC(v[2], v[4]); CE_DESC(v[3], v[5]); CE_DESC(v[10], v[12]); CE_DESC(v[11], v[13]); CE_DESC(v[1], v[2]); CE_DESC(v[3], v[4]); CE_DESC(v[5], v[6]); CE_DESC(v[9], v[10]); CE_DESC(v[11], v[12]); CE_DESC(v[13], v[14]); CE_DESC(v[0], v[8]); CE_DESC(v[1], v[9]); CE_DESC(v[2], v[10]); CE_DESC(v[3], v[11]); CE_DESC(v[4], v[12]); CE_DESC(v[5], v[13]); CE_DESC(v[6], v[14]); CE_DESC(v[7], v[15]); CE_DESC(v[4], v[8]); CE_DESC(v[5], v[9]); CE_DESC(v[6], v[10]); CE_DESC(v[7], v[11]); CE_DESC(v[2], v[4]); CE_DESC(v[3], v[5]); CE_DESC(v[6], v[8]); CE_DESC(v[7], v[9]); CE_DESC(v[10], v[12]); CE_DESC(v[11], v[13]); CE_DESC(v[1], v[2]); CE_DESC(v[3], v[4]); CE_DESC(v[5], v[6]); CE_DESC(v[7], v[8]); CE_DESC(v[9], v[10]); CE_DESC(v[11], v[12]); CE_DESC(v[13], v[14]);
}
__device__ __forceinline__ void merge_top16(unsigned (&T)[16], const unsigned (&G)[16]) {
#pragma unroll
    for (int i = 0; i < 16; ++i) T[i] = max(T[i], G[15 - i]);
#pragma unroll
    for (int j = 8; j > 0; j >>= 1)
#pragma unroll
        for (int i = 0; i < 16; ++i) { const int l = i ^ j; if (l > i) CE_DESC(T[i], T[l]); }
}
__device__ __forceinline__ void topk_load_chunk(const bf16* SC, int tok0, int X, int q, int lane, uint2 (&nxt)[8]) {
#pragma unroll
    for (int m = 0; m < 8; ++m) { const int li = m * 8 + (lane >> 3); nxt[m] = *(const uint2*)(SC + (size_t)(tok0 + (li >> 3)) * 2048 + (li & 7) * 256 + X * 128 + q * 32 + (lane & 7) * 4); }
}
__device__ __forceinline__ void top16_list(const bf16* SC, int tok0, int X, int tok0n, int Xn, LAS float* row, int lane, unsigned (&L)[16], uint2 (&nxt)[8]) {
#pragma unroll
    for (int q = 0; q < 4; ++q) {
#pragma unroll
        for (int m = 0; m < 8; ++m) { const int li = m * 8 + (lane >> 3); const uint2 v = nxt[m];
            LAS float* dst = row + li * 33 + (lane & 7) * 4; dst[0] = bflo(v.x); dst[1] = bfhi(v.x); dst[2] = bflo(v.y); dst[3] = bfhi(v.y); }
        if (q < 3) topk_load_chunk(SC, tok0, X, q + 1, lane, nxt); else topk_load_chunk(SC, tok0n, Xn, 0, lane, nxt);
        asm volatile("s_waitcnt lgkmcnt(0)" ::: "memory");
#pragma unroll
        for (int hgrp = 0; hgrp < 2; ++hgrp) { unsigned G[16];
#pragma unroll
            for (int i = 0; i < 16; ++i) { const float v = row[lane * 33 + hgrp * 16 + i]; G[i] = __float_as_uint(v) | (unsigned)(127 - (q * 32 + hgrp * 16 + i)); }
            sort16_desc(G);
            if (q == 0 && hgrp == 0) {
#pragma unroll
                for (int i = 0; i < 16; ++i) L[i] = G[i];
            } else merge_top16(L, G); }
        asm volatile("s_waitcnt lgkmcnt(0)" ::: "memory");
    }
}
__device__ __forceinline__ void phase_topk(Ctx C, const Args& A) {
    PHASE_ENTER(C);
    const int lane = C.lane; const int gw = C.bid * NWAVES + C.wave, NGW = C.G * NWAVES;
    LAS float* row = (LAS float*)(C.lds + C.wave * 8448);
    const bf16* SC = WSP(bf16, WS_SC);
    uint2 nxt[8]; if (gw < NT / 8) topk_load_chunk(SC, gw * 8, 0, 0, lane, nxt);
    for (int it = gw; it < NT / 8; it += NGW) {
        const int tok0 = it * 8, mytok = tok0 + (lane >> 3), myh = lane & 7;
        unsigned TA[16], TB[16];
        const int tok0n = (it + NGW < NT / 8) ? (it + NGW) * 8 : tok0;
        top16_list(SC, tok0, 0, tok0, 1, row, lane, TA, nxt);
        top16_list(SC, tok0, 1, tok0n, 0, row, lane, TB, nxt);
        float sa[16], sb[16]; LAS int* irow = (LAS int*)(row + lane * 33);
#pragma unroll
        for (int i = 0; i < 16; ++i) { sa[i] = key16_val(TA[i]); sb[i] = key16_val(TB[i]); irow[i] = 127 - (int)(TA[i] & 127u); irow[16 + i] = 127 - (int)(TB[i] & 127u); }
        unsigned B[16];
        {
            unsigned Gp[16];
#pragma unroll
            for (int grp = 0; grp < 3; ++grp) {
                int cnt = 0, slot = 0;
#pragma unroll
                for (int i = 0; i < 16; ++i)
#pragma unroll
                    for (int j = 0; j < 16; ++j) if ((i + 1) * (j + 1) <= 16) { if (cnt >= grp * 16 && cnt < grp * 16 + 16) { Gp[slot] = (mono_key(sa[i] + sb[j]) & ~255u) | (unsigned)(255 - (i * 16 + j)); ++slot; } ++cnt; }
                if (grp == 0) {
#pragma unroll
                    for (int i = 0; i < 16; ++i) B[i] = Gp[i];
                } else { sort16_desc(Gp); merge_top16(B, Gp); }
            }
#pragma unroll
            for (int i = 14; i < 16; ++i) { unsigned xk = (mono_key(sa[i] + sb[0]) & ~255u) | (unsigned)(255 - i * 16);
#pragma unroll
                for (int k = 0; k < 16; ++k) CE_DESC(B[k], xk); }
        }
        asm volatile("s_waitcnt lgkmcnt(0)" ::: "memory");
        const float mx = mono_val(B[0] & ~255u); float ex[16]; float zs = 0.f;
#pragma unroll
        for (int r = 0; r < 16; ++r) { ex[r] = __expf(mono_val(B[r] & ~255u) - mx); zs += ex[r]; }
        const float iz = 1.0f / zs;
        int* eo = WSP(int, WS_EID) + (size_t)mytok * 128 + myh * 16; float* go = WSP(float, WS_GATE) + (size_t)mytok * 128 + myh * 16;
#pragma unroll
        for (int r4 = 0; r4 < 4; ++r4) { int ev[4]; float gv[4];
#pragma unroll
            for (int r = 0; r < 4; ++r) { const int flat = 255 - (int)(B[r4 * 4 + r] & 255u); ev[r] = irow[flat >> 4] * 128 + irow[16 + (flat & 15)]; gv[r] = ex[r4 * 4 + r] * iz; }
            *(int4*)(eo + r4 * 4) = make_int4(ev[0], ev[1], ev[2], ev[3]); *(f32x4*)(go + r4 * 4) = (f32x4){gv[0], gv[1], gv[2], gv[3]}; }
        asm volatile("s_waitcnt lgkmcnt(0)" ::: "memory");
    }
}

__device__ __forceinline__ unsigned fp4_code(float y) {
    const float a = fabsf(y);
    const unsigned c = (a > 0.25f) + (a > 0.75f) + (a > 1.25f) + (a > 1.75f) + (a > 2.5f) + (a > 3.5f) + (a > 5.0f);
    return c | (y < 0.f ? 8u : 0u);
}
__device__ __forceinline__ float wave_max64(float v) {
#pragma unroll
    for (int o = 1; o < 64; o <<= 1) v = fmaxf(v, __shfl_xor(v, o));
    return v;
}
__device__ __forceinline__ void quant_row16(const f32x4 (&v)[4], float inv, unsigned& d0, unsigned& d1) {
    unsigned w0 = 0u, w1 = 0u;
    w0 = __builtin_amdgcn_cvt_scalef32_pk_fp4_f32(w0, v[0][0] * inv, v[0][1] * inv, 1.0f, 0); w0 = __builtin_amdgcn_cvt_scalef32_pk_fp4_f32(w0, v[0][2] * inv, v[0][3] * inv, 1.0f, 1);
    w0 = __builtin_amdgcn_cvt_scalef32_pk_fp4_f32(w0, v[1][0] * inv, v[1][1] * inv, 1.0f, 2); w0 = __builtin_amdgcn_cvt_scalef32_pk_fp4_f32(w0, v[1][2] * inv, v[1][3] * inv, 1.0f, 3);
    w1 = __builtin_amdgcn_cvt_scalef32_pk_fp4_f32(w1, v[2][0] * inv, v[2][1] * inv, 1.0f, 0); w1 = __builtin_amdgcn_cvt_scalef32_pk_fp4_f32(w1, v[2][2] * inv, v[2][3] * inv, 1.0f, 1);
    w1 = __builtin_amdgcn_cvt_scalef32_pk_fp4_f32(w1, v[3][0] * inv, v[3][1] * inv, 1.0f, 2); w1 = __builtin_amdgcn_cvt_scalef32_pk_fp4_f32(w1, v[3][2] * inv, v[3][3] * inv, 1.0f, 3);
    d0 = w0; d1 = w1;
}
__device__ __forceinline__ void phase_convert_peer(Ctx C, const Args& A, int l, int wg0, int nwg) {
    PHASE_ENTER(C);
    if (C.bid < wg0) return;
    const int gt = (C.bid - wg0) * NTHREADS + C.tid, NGT = nwg * NTHREADS;
    const float* U = IN(I_PU) + (size_t)l * 16384 * 1024; const float* V = IN(I_PV) + (size_t)l * 16384 * 1024; const float* nw = IN(I_NFW) + l * 1024;
#pragma unroll 2
    for (int i = gt; i < 16384 * 64; i += NGT) {
        const f32x4* up = (const f32x4*)(U + (size_t)i * 16); const f32x4* wp = (const f32x4*)(nw + (i & 63) * 16); const f32x4* vp = (const f32x4*)(V + (size_t)i * 16);
        f32x4 a[4], b[4];
#pragma unroll
        for (int c = 0; c < 4; ++c) { a[c] = up[c] * wp[c]; b[c] = vp[c]; }
        float au = 0.f, av = 0.f;
#pragma unroll
        for (int c = 0; c < 4; ++c) { au = fmaxf(au, fmaxf(fmaxf(fabsf(a[c][0]), fabsf(a[c][1])), fmaxf(fabsf(a[c][2]), fabsf(a[c][3])))); av = fmaxf(av, fmaxf(fmaxf(fabsf(b[c][0]), fabsf(b[c][1])), fmaxf(fabsf(b[c][2]), fabsf(b[c][3])))); }
        au = wave_max64(au); av = wave_max64(av);
        const float su = au > 0.f ? au * (1.0f / 6.0f) : 1.0f, sv = av > 0.f ? av * (1.0f / 6.0f) : 1.0f;
        unsigned u0, u1, v0, v1;
        quant_row16(a, 1.0f / su, u0, u1); quant_row16(b, 1.0f / sv, v0, v1);
        const int e = i >> 6, bl = i & 63;
        *(uint2*)(C.ws + WS_UT4 + (size_t)e * 512 + bl * 8) = make_uint2(u0, u1);
        *(uint2*)(C.ws + WS_VT4 + ((size_t)(bl >> 3) * 16384 + e) * 64 + (bl & 7) * 8) = make_uint2(v0, v1);
        if (bl == 0) *(float2*)(C.ws + WS_SCL + (size_t)e * 8) = make_float2(su, sv); }
    const float* P = IN(I_P) + (size_t)l * NT * 256;
#pragma unroll 4
    for (int i = gt; i < NT * 32; i += NGT) { const f32x4 a = *(const f32x4*)(P + (size_t)i * 8), b = *(const f32x4*)(P + (size_t)i * 8 + 4);
        *(v4u*)(WSP(bf16, WS_PB) + (size_t)i * 8) = (v4u){pk2(a[0], a[1]), pk2(a[2], a[3]), pk2(b[0], b[1]), pk2(b[2], b[3])}; }
}

typedef float f32x2 __attribute__((ext_vector_type(2)));
#define DPP_ADD(v, ctrl) ((v) + __builtin_bit_cast(float, __builtin_amdgcn_update_dpp(0, __builtin_bit_cast(int, (v)), (ctrl), 0xF, 0xF, true)))
__device__ __forceinline__ float row16_sum(float v) {
    v = DPP_ADD(v, 0xB1); v = DPP_ADD(v, 0x4E); v = DPP_ADD(v, 0x141); v = DPP_ADD(v, 0x140); return v;
}
__device__ __forceinline__ float wave_sum_fast(float v) { v = row16_sum(v); v += __shfl_xor(v, 16); v += __shfl_xor(v, 32); return v; }
typedef int v8i_t __attribute__((ext_vector_type(8)));
#define FP4X2(w, b) __builtin_amdgcn_cvt_scalef32_pk_f32_fp4((w), 1.0f, (b))

typedef unsigned u32x2_t __attribute__((ext_vector_type(2)));
constexpr int EU_TOK = 4, EU_CAP = 128 * EU_TOK, EU_WAVE_LDS = 8192 + 1024 * EU_TOK + 2 * 4 * EU_CAP;
__device__ __forceinline__ int eu_build(const v4u (&E)[2], LAS unsigned* wl, int lane) {
#pragma unroll
    for (int q = 0; q < 2; ++q) { v4u w;
#pragma unroll
        for (int j = 0; j < 4; ++j) w[j] = E[q][j] | ((unsigned)(q * 256 + 4 * lane + j) << 14);
        *(LAS v4u*)(wl + q * 256 + 4 * lane) = w; }
    return EU_CAP;
}
#define EU_STEP(st) { const v4u a_ = *(const LAS v4u*)((((st) & 3) == 0 ? pa0 : (((st) & 3) == 1 ? pa1 : (((st) & 3) == 2 ? pa2 : pa3))) + 256 * ((st) >> 2)); \
        const v4u b0 = *(const LAS v4u*)(((st) & 1 ? p10 : p00) + 256 * ((st) >> 1)), b1 = *(const LAS v4u*)(((st) & 1 ? p11 : p01) + 256 * ((st) >> 1)); \
        const v8i_t bb = {(int)b0[0], (int)b0[1], (int)b0[2], (int)b0[3], (int)b1[0], (int)b1[1], (int)b1[2], (int)b1[3]}; \
        const v8i_t aa = {(int)a_[0], (int)a_[1], (int)a_[2], (int)a_[3], 0, 0, 0, 0}; \
        d = __builtin_amdgcn_mfma_scale_f32_16x16x128_f8f6f4(aa, bb, d, 4, 0, 0, 0x7f7f7f7f, 0, 0x7f7f7f7f); }
__device__ __forceinline__ void eu_block_loads(v4u (&EN)[2], v4u (&XN)[EU_TOK], f32x4 (&sq)[4], const int* EID, const unsigned char* XQ, const float* SSQ, int blk, int lane) {
    const GAS v4u* ep = (const GAS v4u*)(EID + (size_t)blk * EU_CAP) + lane;
#pragma unroll
    for (int q = 0; q < 2; ++q) EN[q] = ep[64 * q];
    const GAS v4u* xp = (const GAS v4u*)(XQ + (size_t)blk * (1024 * EU_TOK)) + lane;
#pragma unroll
    for (int s = 0; s < EU_TOK; ++s) XN[s] = xp[64 * s];
    { const GAS f32x4* sp = (const GAS f32x4*)(SSQ + (size_t)(blk * EU_TOK + (lane & 3)) * 16); sq[0] = sp[0]; sq[1] = sp[1]; sq[2] = sp[2]; sq[3] = sp[3]; }
}
__device__ __forceinline__ float eu_rstd(const f32x4 (&sq)[4]) {
    const f32x4 a = sq[0], b = sq[1], c = sq[2], d = sq[3];
    const float s = (((a[0] + a[1]) + (a[2] + a[3])) + ((b[0] + b[1]) + (b[2] + b[3]))) + (((c[0] + c[1]) + (c[2] + c[3])) + ((d[0] + d[1]) + (d[2] + d[3])));
    return 1.0f / sqrtf(s * (1.0f / 1024.0f) + 1e-6f);
}
__device__ __forceinline__ void phase_experts_u(Ctx C, const Args& A) {
    PHASE_ENTER(C);
    const int lane = C.lane; const int ncls = C.G >> 3;
    if (C.bid >= ncls * 8) return;
    const int wi = C.bid * NWAVES + C.wave, NWC = ncls * 8 * NWAVES;
    const GAS unsigned char* UT = (const GAS unsigned char*)(C.ws + WS_UT4); const GAS u32x2_t* SC2 = (const GAS u32x2_t*)(C.ws + WS_SCL);
    const int* EID = WSP(int, WS_EID); const GAS float* GATE = (const GAS float*)WSP(float, WS_GATE); GAS unsigned char* COEF = (GAS unsigned char*)(C.ws + WS_COEF);
    const unsigned char* XQ = C.ws + WS_XQ; const float* SSQ = WSP(float, WS_SSQ0);
    LAS unsigned char* at = C.lds + C.wave * EU_WAVE_LDS; LAS unsigned char* xq = at + 8192; LAS unsigned* wl = (LAS unsigned*)(xq + 1024 * EU_TOK);
    constexpr int NBLK = NT / EU_TOK;
    int blk = wi; if (blk >= NBLK) return;
    v4u EN[2], XN[EU_TOK]; f32x4 rsn[4];
    eu_block_loads(EN, XN, rsn, EID, XQ, SSQ, blk, lane);
    const int kg = lane >> 4, i16 = lane & 15, s4 = lane & 3;
    const int mB = kg | (s4 << 2);
    const LAS unsigned char* xr = xq + s4 * 1024;
    const LAS unsigned char* p00 = xr + 16 * (0 ^ mB); const LAS unsigned char* p01 = xr + 16 * (4 ^ mB); const LAS unsigned char* p10 = xr + 16 * (8 ^ mB); const LAS unsigned char* p11 = xr + 16 * (12 ^ mB);
    const int mA = kg ^ i16;
    const LAS unsigned char* ar = at + 512 * i16;
    const LAS unsigned char* pa0 = ar + 16 * (0 ^ mA); const LAS unsigned char* pa1 = ar + 16 * (4 ^ mA); const LAS unsigned char* pa2 = ar + 16 * (8 ^ mA); const LAS unsigned char* pa3 = ar + 16 * (12 ^ mA);
    const GAS unsigned char* usrc[8];
    const int hrow = lane >> 5, hpos = lane & 31;
    struct UMeta { u32x2_t sc; float gate; unsigned ent; };
#define EU_PREP(WL, G, TOK0, M) { const LAS unsigned* wg_ = (WL) + 16 * (G); unsigned erw[8]; \
        _Pragma("unroll") for (int j = 0; j < 8; ++j) erw[j] = wg_[2 * j + hrow]; \
        M.ent = wg_[i16]; \
        asm volatile("s_waitcnt lgkmcnt(0)" : "+v"(erw[0]), "+v"(erw[1]), "+v"(erw[2]), "+v"(erw[3]), "+v"(erw[4]), "+v"(erw[5]), "+v"(erw[6]), "+v"(erw[7]), "+v"(M.ent) :: "memory"); \
        _Pragma("unroll") for (int j = 0; j < 8; ++j) { const int r = 2 * j + hrow; usrc[j] = UT + (size_t)(erw[j] & 0x3fffu) * 512 + 16 * (hpos ^ (r & 15)); } \
        { const GAS u32x2_t* sp_ = SC2 + (M.ent & 0x3fffu); const GAS float* gp_ = GATE + (size_t)(TOK0) * 128 + ((M.ent >> 14) & 1023u); \
          asm volatile("global_load_dwordx2 %0, %1, off" : "=v"(M.sc) : "v"(sp_) : "memory"); asm volatile("global_load_dword %0, %1, off" : "=v"(M.gate) : "v"(gp_) : "memory"); } }
#define EU_PIECE(j) { __builtin_amdgcn_sched_barrier(0); __builtin_amdgcn_global_load_lds((const GAS unsigned*)usrc[j], (LAS unsigned*)(at + 1024 * (j)), 16, 0, 0); __builtin_amdgcn_sched_barrier(0); }
#define EU_DMA(WL, G, TOK0, M) { EU_PREP(WL, G, TOK0, M) EU_PIECE(0) EU_PIECE(1) EU_PIECE(2) EU_PIECE(3) EU_PIECE(4) EU_PIECE(5) EU_PIECE(6) EU_PIECE(7) }
#define EU_MM(st) { const v8i_t bb = {(int)bR[2 * (st)][0], (int)bR[2 * (st)][1], (int)bR[2 * (st)][2], (int)bR[2 * (st)][3], (int)bR[2 * (st) + 1][0], (int)bR[2 * (st) + 1][1], (int)bR[2 * (st) + 1][2], (int)bR[2 * (st) + 1][3]}; \
        const v8i_t aa = {(int)aR[st][0], (int)aR[st][1], (int)aR[st][2], (int)aR[st][3], 0, 0, 0, 0}; \
        d = __builtin_amdgcn_mfma_scale_f32_16x16x128_f8f6f4(aa, bb, d, 4, 0, 0, 0x7f7f7f7f, 0, 0x7f7f7f7f); }
#define EU_LOADB() { _Pragma("unroll") for (int st = 0; st < 8; ++st) { bR[2 * st] = *(const LAS v4u*)(((st) & 1 ? p10 : p00) + 256 * ((st) >> 1)); bR[2 * st + 1] = *(const LAS v4u*)(((st) & 1 ? p11 : p01) + 256 * ((st) >> 1)); } \
        asm volatile("s_waitcnt lgkmcnt(0)" ::: "memory"); }
#define EU_UNIT(CUR, NXT) { \
        asm volatile("s_waitcnt vmcnt(0)" : "+v"(CUR.sc), "+v"(CUR.gate) :: "memory");     \
        v4u aR[8]; \
        _Pragma("unroll") for (int st = 0; st < 8; ++st) aR[st] = *(const LAS v4u*)((((st) & 3) == 0 ? pa0 : (((st) & 3) == 1 ? pa1 : (((st) & 3) == 2 ? pa2 : pa3))) + 256 * ((st) >> 2)); \
        asm volatile("s_waitcnt lgkmcnt(0)" ::: "memory"); \
        const bool last = g + 1 >= ng; const bool nextblk = last && hasn; \
        if (nextblk) nn = eu_build(EN, wl + (par ^ 1) * EU_CAP, lane); \
        { const LAS unsigned* wln = wl + (nextblk ? par ^ 1 : par) * EU_CAP; const int gn = last ? 0 : g + 1; const int tokn = nextblk ? blkn * EU_TOK : tok0; \
          EU_PREP(wln, gn, tokn, NXT) }     \
        f32x4 d = (f32x4){0.f, 0.f, 0.f, 0.f}; \
        EU_MM(0) asm volatile("" : "+v"(d)); EU_PIECE(0) EU_PIECE(1) EU_MM(1) asm volatile("" : "+v"(d)); EU_PIECE(2) EU_PIECE(3) EU_MM(2) asm volatile("" : "+v"(d)); EU_PIECE(4) EU_PIECE(5) EU_MM(3) asm volatile("" : "+v"(d)); EU_PIECE(6) EU_PIECE(7) \
        EU_MM(4) asm volatile("" : "+v"(d)); EU_MM(5) asm volatile("" : "+v"(d)); EU_MM(6) asm volatile("" : "+v"(d)); EU_MM(7) asm volatile("" : "+v"(d));     \
        const unsigned ent = CUR.ent; const unsigned idx = (ent >> 14) & 1023u; \
        const int slot = (int)(ent >> 21) & 3; \
        const int src = (slot + 16 * (i16 >> 2)) << 2; \
        const float v0 = __int_as_float(__builtin_amdgcn_ds_bpermute(src, __float_as_int(d[0]))), v1 = __int_as_float(__builtin_amdgcn_ds_bpermute(src, __float_as_int(d[1]))); \
        const float v2 = __int_as_float(__builtin_amdgcn_ds_bpermute(src, __float_as_int(d[2]))), v3 = __int_as_float(__builtin_amdgcn_ds_bpermute(src, __float_as_int(d[3]))); \
        const int r4 = i16 & 3; const float val = r4 == 0 ? v0 : (r4 == 1 ? v1 : (r4 == 2 ? v2 : v3)); \
        const float rs = __int_as_float(__builtin_amdgcn_ds_bpermute(slot << 2, __float_as_int(rsl))); \
        const float coef = CUR.gate * __uint_as_float(CUR.sc.y) * gelu1(val * rs * __uint_as_float(CUR.sc.x)); \
        { const float c64 = __builtin_amdgcn_fmed3f(coef * 64.0f, -448.0f, 448.0f); const int c8 = __builtin_amdgcn_cvt_pk_fp8_f32(c64, c64, 0, false); \
          const unsigned pos = idx & 127u; \
          if (lane < 16 && (int)ent >= 0) COEF[(size_t)(tok0 + (idx >> 7)) * 128 + 16 * (pos & 7u) + (pos >> 3)] = (unsigned char)c8; } \
        asm volatile("s_waitcnt lgkmcnt(0)" ::: "memory"); \
        if (!last) ++g; \
        else { if (!hasn) break; \
              \
            _Pragma("unroll") for (int s = 0; s < EU_TOK; ++s) *(LAS v4u*)(xq + s * 1024 + 16 * (lane ^ ((s & 3) << 2))) = XN[s]; \
            EU_LOADB() rsl = eu_rstd(rsn); blk = blkn; tok0 = blk * EU_TOK; ng = nn > 16 ? (nn + 15) >> 4 : 1; g = 0; par ^= 1; \
            blkn = blk + NWC; hasn = blkn < NBLK; \
            if (hasn) eu_block_loads(EN, XN, rsn, EID, XQ, SSQ, blkn, lane); } }
    int par = 0, nn = 0, g = 0;
    int ng; { const int n0 = eu_build(EN, wl, lane); ng = n0 > 16 ? (n0 + 15) >> 4 : 1; }
#pragma unroll
    for (int s = 0; s < EU_TOK; ++s) *(LAS v4u*)(xq + s * 1024 + 16 * (lane ^ ((s & 3) << 2))) = XN[s];
    v4u bR[16]; EU_LOADB()
    float rsl = eu_rstd(rsn); int tok0 = blk * EU_TOK;
    int blkn = blk + NWC; bool hasn = blkn < NBLK;
    if (hasn) eu_block_loads(EN, XN, rsn, EID, XQ, SSQ, blkn, lane);
    UMeta MA, MB;
    EU_DMA(wl, 0, tok0, MA)
    while (true) {
        EU_UNIT(MA, MB)
        EU_UNIT(MB, MA)
    }
#undef EU_UNIT
#undef EU_MM
#undef EU_LOADB
#undef EU_DMA
#undef EU_PIECE
#undef EU_PREP
}

typedef int v2i_t __attribute__((ext_vector_type(2)));
__device__ __forceinline__ void ev_dma(LAS unsigned char* tile, const GAS unsigned char* VTl, const v4u e0, const v4u e1) {
#pragma unroll
    for (int it = 0; it < 4; ++it) __builtin_amdgcn_global_load_lds((const GAS unsigned*)(VTl + (size_t)(e0[it] << 6)), (LAS unsigned*)(tile + 1024 * it), 16, 0, 0);
#pragma unroll
    for (int it = 0; it < 4; ++it) __builtin_amdgcn_global_load_lds((const GAS unsigned*)(VTl + (size_t)(e1[it] << 6)), (LAS unsigned*)(tile + 1024 * (4 + it)), 16, 0, 0);
}
#define EV_TR(dst, base, off) asm volatile("ds_read_b64_tr_b4 %0, %1 offset:" #off : "=v"(dst) : "v"(base) : "memory")
#define EV_MMA(ct, T0, T1) { const v8i_t aa = {T0.x, T0.y, T1.x, T1.y, 0, 0, 0, 0}; \
        sel = __builtin_amdgcn_mfma_scale_f32_16x16x128_f8f6f4(aa, bb, sel, 4, 0, 0, 0x7f7f7f7f, 0, jc == (ct) ? 0x79797979 : 0); }
__device__ __forceinline__ void phase_experts_v(Ctx C, const Args& A, const bf16* hin, bf16* hbout, float* ssq_out) {
    PHASE_ENTER(C);
    const int lane = C.lane; const int ncls = C.G >> 3;
    if (C.bid >= ncls * 8) return;
    const int x = C.bid & 7; const int wi = (C.bid >> 3) * NWAVES + C.wave, NWC = ncls * NWAVES;
    const int ps = lane >> 2, q4 = lane & 3, r16 = lane & 15, kg = lane >> 4, jc = lane & 7;
    const GAS unsigned char* VTl = (const GAS unsigned char*)(C.ws + WS_VT4) + (size_t)x * 16384 * 64 + 16 * (q4 ^ ((ps >> 2) & 3));
    const GAS int* EID = (const GAS int*)WSP(int, WS_EID) + 8 * ps; const GAS unsigned char* COEF = (const GAS unsigned char*)(C.ws + WS_COEF) + 16 * kg;
    const int hoff = 128 * x + 16 * jc + 4 * kg;
    LAS unsigned char* tile0 = C.lds + C.wave * 16384;
    const int fsw = (r16 >> 2) & 3; const int rowoff = 64 * (32 * kg + r16);
    int t = wi; if (t >= NT) return;
    v4u ea0, ea1, eb0, eb1, cb0, cb1; u32x2_t hres, ypk = {0u, 0u}; float yss = 0.f; int tp = -1;
    { const GAS v4u* p = (const GAS v4u*)(EID + (size_t)t * 128); ea0 = p[0]; ea1 = p[1]; }
    ev_dma(tile0, VTl, ea0, ea1);
    { const GAS unsigned char* cp = COEF + (size_t)t * 128; cb0 = *(const GAS v4u*)cp; cb1 = *(const GAS v4u*)(cp + 64); hres = *(const GAS u32x2_t*)(hin + (size_t)t * DM + hoff); }
    int t1 = t + NWC < NT ? t + NWC : t;
    { const GAS v4u* p = (const GAS v4u*)(EID + (size_t)t1 * 128); eb0 = p[0]; eb1 = p[1]; }
    int par = 0;
    while (true) {
        asm volatile("s_waitcnt vmcnt(0)" ::: "memory");
        const v8i_t bb = {(int)cb0[0], (int)cb0[1], (int)cb0[2], (int)cb0[3], (int)cb1[0], (int)cb1[1], (int)cb1[2], (int)cb1[3]};
        const u32x2_t hcur = hres;
        LAS unsigned char* tile = tile0 + 8192 * par;
        const bool more = t + NWC < NT;
        const GAS unsigned char* dsrc[8];
#pragma unroll
        for (int it = 0; it < 4; ++it) { dsrc[it] = VTl + (size_t)(eb0[it] << 6); dsrc[4 + it] = VTl + (size_t)(eb1[it] << 6); }
#pragma unroll
        for (int it = 0; it < 8; ++it) asm volatile("" : "+v"(dsrc[it]));
        if (tp >= 0) { if ((lane & 8) == 0) *(GAS u32x2_t*)(hbout + (size_t)tp * DM + hoff) = ypk;
                       if (lane < 2) ((GAS float*)ssq_out)[(size_t)tp * 16 + 2 * x + lane] = lane == 0 ? yss : 0.f; }
        { const GAS unsigned char* cp = COEF + (size_t)t1 * 128; cb0 = *(const GAS v4u*)cp; cb1 = *(const GAS v4u*)(cp + 64); hres = *(const GAS u32x2_t*)(hin + (size_t)t1 * DM + hoff); }
        const int t2 = t1 + NWC < NT ? t1 + NWC : t1;
        { const GAS v4u* p = (const GAS v4u*)(EID + (size_t)t2 * 128); eb0 = p[0]; eb1 = p[1]; }
        LAS unsigned char* tilen = tile0 + 8192 * (par ^ 1);
        const unsigned o0 = (unsigned)(size_t)(tile + rowoff + 16 * (0 ^ fsw)), o1 = (unsigned)(size_t)(tile + rowoff + 16 * (1 ^ fsw));
        const unsigned o2 = (unsigned)(size_t)(tile + rowoff + 16 * (2 ^ fsw)), o3 = (unsigned)(size_t)(tile + rowoff + 16 * (3 ^ fsw));
        v2i_t a00, a01, a10, a11, a20, a21, a30, a31, a40, a41, a50, a51, a60, a61, a70, a71;
        EV_TR(a00, o0, 0); EV_TR(a01, o0, 1024); EV_TR(a10, o0, 8); EV_TR(a11, o0, 1032);
        EV_TR(a20, o1, 0); EV_TR(a21, o1, 1024); EV_TR(a30, o1, 8); EV_TR(a31, o1, 1032);
        EV_TR(a40, o2, 0); EV_TR(a41, o2, 1024); EV_TR(a50, o2, 8); EV_TR(a51, o2, 1032);
        EV_TR(a60, o3, 0); EV_TR(a61, o3, 1024); EV_TR(a70, o3, 8); EV_TR(a71, o3, 1032);
        asm volatile("s_waitcnt lgkmcnt(0)" : "+v"(a00), "+v"(a01), "+v"(a10), "+v"(a11), "+v"(a20), "+v"(a21), "+v"(a30), "+v"(a31), "+v"(a40), "+v"(a41), "+v"(a50), "+v"(a51), "+v"(a60), "+v"(a61), "+v"(a70), "+v"(a71) :: "memory");
        f32x4 sel = (f32x4){0.f, 0.f, 0.f, 0.f};
#define EV_PIECE(it, E) { asm volatile("" : "+v"(sel)); __builtin_amdgcn_sched_barrier(0); __builtin_amdgcn_global_load_lds((const GAS unsigned*)dsrc[it], (LAS unsigned*)(tilen + 1024 * (it)), 16, 0, 0); __builtin_amdgcn_sched_barrier(0); }
        EV_MMA(0, a00, a01) EV_PIECE(0, ec0[0]) EV_MMA(1, a10, a11) EV_PIECE(1, ec0[1]) EV_MMA(2, a20, a21) EV_PIECE(2, ec0[2]) EV_MMA(3, a30, a31) EV_PIECE(3, ec0[3])
        EV_MMA(4, a40, a41) EV_PIECE(4, ec1[0]) EV_MMA(5, a50, a51) EV_PIECE(5, ec1[1]) EV_MMA(6, a60, a61) EV_PIECE(6, ec1[2]) EV_MMA(7, a70, a71) EV_PIECE(7, ec1[3])
#undef EV_PIECE
        const float y0 = bflo(hcur.x) + sel[0], y1 = bfhi(hcur.x) + sel[1], y2 = bflo(hcur.y) + sel[2], y3 = bfhi(hcur.y) + sel[3];
        ypk.x = pg8::cvt_pk_bf16(y0, y1); ypk.y = pg8::cvt_pk_bf16(y2, y3);
        const float s2 = (lane & 8) == 0 ? (y0 * y0 + y1 * y1) + (y2 * y2 + y3 * y3) : 0.f;
        yss = wave_sum_fast(s2); tp = t;
        asm volatile("s_waitcnt lgkmcnt(0)" ::: "memory");
        if (!more) break;
        t = t1; t1 = t2; par ^= 1;
    }
    if ((lane & 8) == 0) *(GAS u32x2_t*)(hbout + (size_t)tp * DM + hoff) = ypk;
    if (lane < 2) ((GAS float*)ssq_out)[(size_t)tp * 16 + 2 * x + lane] = lane == 0 ? yss : 0.f;
}

template <int WIN> __device__ __forceinline__ void pool_run(const bf16* U, bf16* Y, int b, int p0, int cp) {
    const unsigned* ub = (const unsigned*)(U + (size_t)b * SEQ * DM + 2 * cp);
    unsigned w[16 + WIN - 1];
#pragma unroll
    for (int i = 0; i < 16 + WIN - 1; ++i) { const int pos = p0 - (WIN - 1) + i; w[i] = pos >= 0 ? ub[(size_t)pos * (DM / 2)] : 0u; }
    float s0 = 0.f, s1 = 0.f;
#pragma unroll
    for (int i = 0; i < WIN - 1; ++i) { s0 += bflo(w[i]); s1 += bfhi(w[i]); }
    unsigned* yb = (unsigned*)(Y + (size_t)b * SEQ * DM + 2 * cp);
#pragma unroll
    for (int t = 0; t < 16; ++t) { const int pos = p0 + t; const float c0 = bflo(w[WIN - 1 + t]), c1 = bfhi(w[WIN - 1 + t]); s0 += c0; s1 += c1;
        const float inv = 1.0f / (float)(pos + 1 < WIN ? pos + 1 : WIN);
        yb[(size_t)pos * (DM / 2)] = pk2(s0 * inv - c0, s1 * inv - c1);
        s0 -= bflo(w[t]); s1 -= bfhi(w[t]); }
}
__device__ __forceinline__ void phase_pool(Ctx C, const Args& A) {
    PHASE_ENTER(C);
    const bf16* U = WSP(bf16, WS_U); bf16* Y = WSP(bf16, WS_A1);
    const int cp = C.tid & 255, th = C.tid >> 8, grp = (C.wave & 3);
    for (int it = C.bid; it < 1024; it += C.G) { const int b = it >> 8, p0 = (it & 255) * 32 + th * 16;
        if (grp == 0) pool_run<2>(U, Y, b, p0, cp); else if (grp == 1) pool_run<4>(U, Y, b, p0, cp); else if (grp == 2) pool_run<8>(U, Y, b, p0, cp); else pool_run<16>(U, Y, b, p0, cp); }
}
__device__ __forceinline__ void s5_wave_consts(const Ctx& C, int g, int lane, float& abr, float& abi, bf16x8 (&bfr)[8]) {
    const float* s5 = WSP(float, WS_S5C); const int idx = g * 64 + lane, fr = lane & 15, fq = lane >> 4;
    abr = s5[S5_ABAR / 4 + 2 * idx]; abi = s5[S5_ABAR / 4 + 2 * idx + 1];
    const bf16* BB = (const bf16*)(C.ws + WS_S5C + S5_BB16) + (size_t)g * 128 * 16;
#pragma unroll
    for (int ct = 0; ct < 8; ++ct) { bf16x8 z = {0, 0, 0, 0, 0, 0, 0, 0}; if (fq < 2) z = *(const bf16x8*)(BB + (16 * ct + fr) * 16 + 8 * fq); bfr[ct] = z; }
}
__device__ __forceinline__ void s5_bu_tile(const bf16x8 afr, const bf16x8 (&bfr)[8], LAS float* BUL, int fr, int fq) {
#pragma unroll
    for (int ct = 0; ct < 8; ++ct) { const f32x4 d = __builtin_amdgcn_mfma_f32_16x16x32_bf16(afr, bfr[ct], (f32x4){0.f, 0.f, 0.f, 0.f}, 0, 0, 0);
#pragma unroll
        for (int r = 0; r < 4; ++r) BUL[(4 * fq + r) * 132 + (ct >> 2) * 64 + (ct & 3) * 16 + fr] = d[r]; }
}
__device__ __forceinline__ void phase_s5_local(Ctx C, const Args& A) {
    PHASE_ENTER(C);
    const int lane = C.lane, fr = lane & 15, fq = lane >> 4; const int gw = C.bid * NWAVES + C.wave, NGW = C.G * NWAVES;
    LAS float* BUL = (LAS float*)(C.lds + C.wave * 8448);
    int gprev = -1; float abr = 0.f, abi = 0.f; bf16x8 bfr[8];
    for (int it = gw; it < 16384; it += NGW) { const int g = it & 31, bn = it >> 5;
        if (g != gprev) { s5_wave_consts(C, g, lane, abr, abi, bfr); gprev = g; }
        const bf16* ubase = WSP(bf16, WS_U) + (size_t)bn * 64 * DM + 512 + g * 16;
        bf16x8 afr[4];
#pragma unroll
        for (int sub = 0; sub < 4; ++sub) { bf16x8 z = {0, 0, 0, 0, 0, 0, 0, 0}; if (fq < 2) z = *(const bf16x8*)(ubase + (size_t)(sub * 16 + fr) * DM + 8 * fq); afr[sub] = z; }
        float xr = 0.f, xi = 0.f;
#pragma unroll
        for (int sub = 0; sub < 4; ++sub) {
            s5_bu_tile(afr[sub], bfr, BUL, fr, fq);
            asm volatile("s_waitcnt lgkmcnt(0)" ::: "memory");
#pragma unroll
            for (int tt = 0; tt < 16; ++tt) { const float br = BUL[tt * 132 + lane], bi = BUL[tt * 132 + 64 + lane]; const float nr = abr * xr - abi * xi + br, ni = abr * xi + abi * xr + bi; xr = nr; xi = ni; }
            asm volatile("s_waitcnt lgkmcnt(0)" ::: "memory");
        }
        float* e = WSP(float, WS_E) + ((size_t)(bn * 32 + g) * 64 + lane) * 2; e[0] = xr; e[1] = xi; }
}
__device__ __forceinline__ void phase_s5_carry(Ctx C, const Args& A) {
    PHASE_ENTER(C);
    for (int gid = C.bid * NTHREADS + C.tid; gid < 8192; gid += C.G * NTHREADS) { const int p = gid & 63, g = (gid >> 6) & 31, b = gid >> 11;
        const float* s5 = WSP(float, WS_S5C); const float ar = s5[S5_A64 / 4 + 2 * (g * 64 + p)], ai = s5[S5_A64 / 4 + 2 * (g * 64 + p) + 1];
        float2* e = (float2*)WSP(float, WS_E) + ((size_t)(b * 128) * 32 + g) * 64 + p; float cr = 0.f, ci = 0.f;
#pragma unroll 8
        for (int n = 0; n < NCHUNK; ++n) { const float2 tv = e[(size_t)n * 2048]; e[(size_t)n * 2048] = make_float2(cr, ci); const float nr = ar * cr - ai * ci + tv.x, ni = ar * ci + ai * cr + tv.y; cr = nr; ci = ni; } }
}
__device__ __forceinline__ void phase_s5_out(Ctx C, const Args& A) {
    PHASE_ENTER(C);
    const int lane = C.lane, fr = lane & 15, fq = lane >> 4; const int gw = C.bid * NWAVES + C.wave, NGW = C.G * NWAVES;
    LAS float* BUL = (LAS float*)(C.lds + C.wave * 12800);
    LAS bf16* XL = (LAS bf16*)(C.lds + C.wave * 12800 + 8448);
    int gprev = -1; float abr = 0.f, abi = 0.f; bf16x8 bfr[8]; bf16x8 cm[4]; float dsk = 0.f;
    for (int it = gw; it < 16384; it += NGW) { const int g = it & 31, bn = it >> 5;
        if (g != gprev) { s5_wave_consts(C, g, lane, abr, abi, bfr); gprev = g;
            const bf16* CM = (const bf16*)(C.ws + WS_S5C + S5_CM) + (size_t)(g * 16 + fr) * 128;
#pragma unroll
            for (int kk = 0; kk < 4; ++kk) cm[kk] = *(const bf16x8*)(CM + kk * 32 + 8 * fq);
            dsk = IN(I_DSK)[g * 16 + fr]; }
        const bf16* ubase = WSP(bf16, WS_U) + (size_t)bn * 64 * DM + 512 + g * 16;
        bf16x8 afr[4];
#pragma unroll
        for (int sub = 0; sub < 4; ++sub) { bf16x8 z = {0, 0, 0, 0, 0, 0, 0, 0}; if (fq < 2) z = *(const bf16x8*)(ubase + (size_t)(sub * 16 + fr) * DM + 8 * fq); afr[sub] = z; }
        const float* e = WSP(float, WS_E) + ((size_t)(bn * 32 + g) * 64 + lane) * 2; float xr = e[0], xi = e[1];
        unsigned short uskip[4][4];
#pragma unroll
        for (int sub = 0; sub < 4; ++sub)
#pragma unroll
            for (int r = 0; r < 4; ++r) uskip[sub][r] = ubase[(size_t)(sub * 16 + 4 * fq + r) * DM + fr];
#pragma unroll
        for (int sub = 0; sub < 4; ++sub) {
            s5_bu_tile(afr[sub], bfr, BUL, fr, fq);
            asm volatile("s_waitcnt lgkmcnt(0)" ::: "memory");
#pragma unroll
            for (int tt = 0; tt < 16; ++tt) { const float br = BUL[tt * 132 + lane], bi = BUL[tt * 132 + 64 + lane]; const float nr = abr * xr - abi * xi + br, ni = abr * xi + abi * xr + bi; xr = nr; xi = ni;
                XL[tt * 136 + lane] = (bf16)f2bf(xr); XL[tt * 136 + 64 + lane] = (bf16)f2bf(xi); }
            asm volatile("s_waitcnt lgkmcnt(0)" ::: "memory");
            f32x4 acc = (f32x4){0.f, 0.f, 0.f, 0.f};
#pragma unroll
            for (int kk = 0; kk < 4; ++kk) { const bf16x8 a = *(const LAS bf16x8*)(XL + fr * 136 + kk * 32 + 8 * fq); acc = __builtin_amdgcn_mfma_f32_16x16x32_bf16(a, cm[kk], acc, 0, 0, 0); }
#pragma unroll
            for (int r = 0; r < 4; ++r) { const size_t tok = (size_t)bn * 64 + sub * 16 + 4 * fq + r; const float uv = bf2f(uskip[sub][r]);
                WSP(bf16, WS_Z)[tok * 512 + g * 16 + fr] = (bf16)f2bf(gelu1(acc[r] + dsk * uv)); }
            asm volatile("s_waitcnt lgkmcnt(0)" ::: "memory");
        } }
}
__device__ __forceinline__ void phase_final_norm(Ctx C, const Args& A, const bf16* hin) {
    PHASE_ENTER(C);
    const int lane = C.lane; const int gw = C.bid * NWAVES + C.wave, NGW = C.G * NWAVES; const f32x4* wv = (const f32x4*)IN(I_FNW) + 4 * lane;
#pragma unroll 4
    for (int m = gw; m < NT; m += NGW) { const v4u* hr = (const v4u*)(hin + (size_t)m * DM + 16 * lane); f32x4 v[4]; float s = 0.f;
#pragma unroll
        for (int c = 0; c < 2; ++c) { const v4u hw = hr[c]; v[2 * c] = (f32x4){bflo(hw[0]), bfhi(hw[0]), bflo(hw[1]), bfhi(hw[1])}; v[2 * c + 1] = (f32x4){bflo(hw[2]), bfhi(hw[2]), bflo(hw[3]), bfhi(hw[3])}; }
#pragma unroll
        for (int j = 0; j < 4; ++j) s += (v[j][0] * v[j][0] + v[j][1] * v[j][1]) + (v[j][2] * v[j][2] + v[j][3] * v[j][3]);
        const float rs = 1.0f / sqrtf(wave_sum(s) * (1.0f / DM) + EPS);
        f32x4* o = (f32x4*)(C.h + (size_t)m * DM + 16 * lane);
#pragma unroll
        for (int j = 0; j < 4; ++j) o[j] = v[j] * rs * wv[j]; }
}

constexpr int CW_BAR = 1024;

__global__ void __launch_bounds__(NTHREADS, 2) mk_fwd(Args A) {
    extern __shared__ __attribute__((aligned(16))) unsigned char lds_raw[];
    Ctx C;
    C.lds = (LAS unsigned char*)lds_raw; C.tid = threadIdx.x; C.lane = C.tid & 63; C.wave = __builtin_amdgcn_readfirstlane(C.tid >> 6); C.G = gridDim.x; C.bid = blockIdx.x;
    C.h = A.out; C.ws = A.ws;
    volatile LAS unsigned* MISC = (volatile LAS unsigned*)(C.lds + MISC_OFF);
    for (int u = C.tid; u < (LDS_BYTES - RING_BYTES) / 4; u += NTHREADS) ((LAS unsigned*)(C.lds + RING_BYTES))[u] = 0u;
    __syncthreads();
    if (C.tid == 0) {
#pragma unroll
        for (int i = 0; i < N_IN; ++i) ((LAS unsigned long long*)(C.lds + PTR_OFF))[i] = (unsigned long long)A.in[i];
    }
    __syncthreads();
    XcdBarrier bar = xcd_barrier_post((unsigned*)(C.ws + WS_CTL) + CW_BAR, MISC + 8);
#define GBAR() xcd_barrier(bar)
#define FRESH() do { asm volatile("" : "+s"(C.ws), "+s"(C.h)); C.ws = (unsigned char*)(GAS unsigned char*)C.ws; C.h = (float*)(GAS float*)C.h; } while (0)
#define GEMM(EpiT, E, Ap, Bp, Mv, Nv, Kv) do { pg8::Gemm g_{(const pg8::bf16_t*)(Ap), (const pg8::bf16_t*)(Bp), Mv, Nv, Kv}; pg8::StaticOrder S_; S_.init(Mv, Nv, C.G, C.bid); \
        pg8::gemm_phase<EpiT, pg8::StaticOrder, true, true>(C.lds, g_, S_, E); } while (0)
    float* SSQ0 = WSP(float, WS_SSQ0); float* SSQ1 = WSP(float, WS_SSQ1);
    bf16* A0 = WSP(bf16, WS_A0); bf16* A1 = WSP(bf16, WS_A1);

#ifndef PROBE_MASK
#define PROBE_MASK 0
#endif
#define REP(k) for (int rep_ = 0; rep_ < (((PROBE_MASK) >> (k)) & 1 ? 2 : 1); ++rep_)
    REP(4) phase_prologue(C, A);
    GBAR();
    REP(0) { FRESH(); { pg8::EpiBf16<0> E{(pg8::bf16_t*)WSP(bf16, WS_PROJ), PROJW, nullptr, 0, 0, 1.f}; GEMM(pg8::EpiBf16<0>, E, A0, WSP(bf16, WS_WIN0), NT, PROJW, DM); } }
    GBAR();
    REP(1) phase_kv(C, A);
    GBAR();
    phase_scan(C, A); GBAR();
    REP(1) phase_mix0_out(C, A);
    GBAR();
    REP(0) { FRESH(); { pg8::EpiRes E{IN(I_X), nullptr, (pg8::bf16_t*)A0, SSQ0, C.ws + WS_XQ}; GEMM(pg8::EpiRes, E, A1, WSP(bf16, WS_WOUT0), NT, DM, DM); } }
    GBAR();
    REP(0) { FRESH(); { pg8::EpiScoreKey E{(pg8::bf16_t*)WSP(bf16, WS_SC), 2048, SSQ0}; GEMM(pg8::EpiScoreKey, E, A0, WSP(bf16, WS_WEFF) + (size_t)0 * 2048 * 1024, NT, 2048, DM); } }
    GBAR();
    REP(2) phase_topk(C, A);
    REP(5) phase_convert_peer(C, A, 0, 0, C.G);
    GBAR();
    REP(8) phase_experts_u(C, A);
    GBAR();
    REP(9) phase_experts_v(C, A, A0, A1, SSQ1);
    __syncthreads();
    REP(0) { FRESH(); { pg8::EpiBf16<0> E{(pg8::bf16_t*)WSP(bf16, WS_PP), DM, nullptr, 0, 0, 1.f}; GEMM(pg8::EpiBf16<0>, E, WSP(bf16, WS_PB), WSP(bf16, WS_WP) + (size_t)0 * 1024 * 256, NT, DM, 256); } }
    GBAR();
    FRESH(); { pg8::EpiPle E{(const pg8::bf16_t*)A1, (const pg8::bf16_t*)WSP(bf16, WS_PP), (pg8::bf16_t*)A0, SSQ1, SSQ0}; GEMM(pg8::EpiPle, E, A1, WSP(bf16, WS_WG) + (size_t)0 * 1024 * 1024, NT, DM, DM); }
    GBAR();

    REP(0) { FRESH(); { pg8::EpiScaleBf16 E{(pg8::bf16_t*)WSP(bf16, WS_U), DM, SSQ0}; GEMM(pg8::EpiScaleBf16, E, A0, WSP(bf16, WS_WIN1), NT, DM, DM); } }
    GBAR();
    REP(6) { phase_s5_local(C, A); phase_pool(C, A); }
    GBAR();
    phase_s5_carry(C, A);
    phase_convert_peer(C, A, 1, 16, C.G - 16); GBAR();
    REP(7) phase_s5_out(C, A);
    GBAR();
    REP(0) { FRESH(); { pg8::EpiGlu E{(const pg8::bf16_t*)WSP(bf16, WS_Z), 512, IN(I_BGLU), (pg8::bf16_t*)A1, DM, 512}; GEMM(pg8::EpiGlu, E, WSP(bf16, WS_Z), WSP(bf16, WS_WGLU), NT, 512, 512); } }
    GBAR();
    FRESH(); { pg8::EpiRes E{nullptr, (const pg8::bf16_t*)A0, (pg8::bf16_t*)A0, SSQ0, C.ws + WS_XQ}; GEMM(pg8::EpiRes, E, A1, WSP(bf16, WS_WOUT1), NT, DM, DM); }
    GBAR();

    REP(0) { FRESH(); { pg8::EpiScoreKey E{(pg8::bf16_t*)WSP(bf16, WS_SC), 2048, SSQ0}; GEMM(pg8::EpiScoreKey, E, A0, WSP(bf16, WS_WEFF) + (size_t)1 * 2048 * 1024, NT, 2048, DM); } }
    GBAR();
    REP(2) phase_topk(C, A);
    GBAR();
    REP(8) phase_experts_u(C, A);
    GBAR();
    REP(9) phase_experts_v(C, A, A0, A1, SSQ1);
    __syncthreads();
    REP(0) { FRESH(); { pg8::EpiBf16<0> E{(pg8::bf16_t*)WSP(bf16, WS_PP), DM, nullptr, 0, 0, 1.f}; GEMM(pg8::EpiBf16<0>, E, WSP(bf16, WS_PB), WSP(bf16, WS_WP) + (size_t)1 * 1024 * 256, NT, DM, 256); } }
    GBAR();
    FRESH(); { pg8::EpiPle E{(const pg8::bf16_t*)A1, (const pg8::bf16_t*)WSP(bf16, WS_PP), (pg8::bf16_t*)A0, SSQ1, SSQ0}; GEMM(pg8::EpiPle, E, A1, WSP(bf16, WS_WG) + (size_t)1 * 1024 * 1024, NT, DM, DM); }
    GBAR();

    phase_final_norm(C, A, A0);
}

extern "C" void kernel_launch(void* const* d_in, const int* in_sizes, int n_in, void* d_out, int out_size, void* d_ws, size_t ws_size, hipStream_t stream) {
    static int grid = 0;
    if (grid == 0) {
        if (n_in != N_IN || out_size != NT * DM || ws_size < WS_END) { fprintf(stderr, "kernel_launch: unexpected shapes (n_in %d, out %d, ws %zu, need %zu)\n", n_in, out_size, ws_size, (size_t)WS_END); grid = -1; return; }
        int dev = 0, cus = 0, per_cu = 0;
        if (hipGetDevice(&dev) != hipSuccess || hipDeviceGetAttribute(&cus, hipDeviceAttributeMultiprocessorCount, dev) != hipSuccess) { grid = -1; return; }
        if (hipFuncSetAttribute((const void*)mk_fwd, hipFuncAttributeMaxDynamicSharedMemorySize, LDS_BYTES) != hipSuccess) { fprintf(stderr, "kernel_launch: hipFuncSetAttribute failed\n"); grid = -1; return; }
        if (hipOccupancyMaxActiveBlocksPerMultiprocessor(&per_cu, (const void*)mk_fwd, NTHREADS, LDS_BYTES) != hipSuccess || per_cu < 1) { fprintf(stderr, "kernel_launch: occupancy query says %d blocks per CU\n", per_cu); grid = -1; return; }
        grid = cus;
    }
    if (grid < 0) return;
    if (hipMemsetAsync((char*)d_ws + WS_CTL, 0, CTL_ZERO_BYTES, stream) != hipSuccess) return;
    Args a{};
    for (int i = 0; i < N_IN; ++i) a.in[i] = d_in[i];
    a.out = (float*)d_out; a.ws = (unsigned char*)d_ws;
    void* kargs[] = {&a};
    const hipError_t le = hipLaunchCooperativeKernel((const void*)mk_fwd, dim3(grid), dim3(NTHREADS), kargs, LDS_BYTES, stream);
    if (le != hipSuccess) fprintf(stderr, "kernel_launch: cooperative launch failed: %s (grid %d)\n", hipGetErrorString(le), grid);
}
```
